# Optimizing an MI355X kernel written in HIP

```python
import math
import jax, jax.numpy as jnp
from jax import lax
import numpy as np

D_MODEL = 2048
BATCH = 2
SEQ = 16384
DEPTH = 1

CHUNK = 64
Q_BLOCK = 128
EPS = 1e-6
D_SSM = D_MODEL // 2
SSM_GROUP = 16
N_SSM_GROUPS = D_SSM // SSM_GROUP
SSM_STATE = 64
DT_MIN = 0.001
DT_MAX = 0.1
N_MLA_HEADS = 8
QK_NOPE = 128
QK_ROPE = 64
V_HEAD = 128
D_MLA = N_MLA_HEADS * V_HEAD
Q_LORA = 512
KV_LORA = 256
ROPE_BASE = 10000.0
D_IN = 2 * D_SSM + Q_LORA + KV_LORA + QK_ROPE
D_MIX = D_SSM + D_MLA
N_EXPERTS = 32
TOP_K = 4
D_FF = D_MODEL
SWIGLU_LIMIT = 7.0
SWIGLU_ALPHA = 1.702
MOE_BLOCK = 256
N_MOD = 6

kernel_name = 'hybrid_s5_mla_moe_adaln_block'


def rms_norm(x, g):
    xf = x.astype(jnp.float32)
    y = xf * lax.rsqrt(jnp.mean(xf * xf, axis=-1, keepdims=True) + EPS)
    return (y * g.astype(jnp.float32)).astype(x.dtype)


def rope(x, cos, sin):
    half = x.shape[-1] // 2
    x1, x2 = x[..., :half], x[..., half:]
    c, s = cos.astype(x.dtype), sin.astype(x.dtype)
    return jnp.concatenate([x1 * c - x2 * s, x2 * c + x1 * s], axis=-1)


def s5_mixer(u, A_re, A_im, B_re, B_im, C_re, C_im, D, log_dt):
    Bsz, L, _ = u.shape
    f32 = jnp.float32
    G, P, H = N_SSM_GROUPS, SSM_STATE, SSM_GROUP
    A = lax.complex(A_re.astype(f32), A_im.astype(f32))
    dtA = A * jnp.exp(log_dt.astype(f32))[:, None]
    A_bar = jnp.exp(dtA)
    Bc = lax.complex(B_re.astype(f32), B_im.astype(f32))
    B_bar = ((A_bar - 1.0) / A)[..., None] * Bc
    Cc = lax.complex(C_re.astype(f32), C_im.astype(f32))
    powers = jnp.exp(jnp.arange(1, CHUNK + 1, dtype=f32)[:, None, None] * dtA[None])
    a_chunk = jnp.broadcast_to(A_bar, (Bsz, CHUNK, G, P))

    def combine(left, right):
        a_l, b_l = left
        a_r, b_r = right
        return a_r * a_l, a_r * b_l + b_r

    def step(state, u_c):
        bu = jnp.einsum('gph,blgh->blgp', B_bar, u_c.astype(jnp.complex64))
        _, local = lax.associative_scan(combine, (a_chunk, bu), axis=1)
        states = local + powers[None] * state[:, None]
        y = jnp.einsum('ghp,blgp->blgh', Cc, states).real
        return states[:, -1], y

    u_chunks = jnp.moveaxis(u.astype(f32).reshape(Bsz, L // CHUNK, CHUNK, G, H), 1, 0)
    state0 = jnp.zeros((Bsz, G, P), jnp.complex64)
    _, ys = lax.scan(step, state0, u_chunks)
    y = jnp.moveaxis(ys, 0, 1).reshape(Bsz, L, D_SSM)
    return y + D.astype(f32) * u.astype(f32)


def mla_mixer(q_lat, kv_lat, k_rope, cos, sin, q_lat_g, kv_lat_g, w_uq, w_ukv,
              q_nope_g, q_rope_g, k_nope_g, k_rope_g):
    Bsz, L, _ = q_lat.shape
    H = N_MLA_HEADS
    q = (rms_norm(q_lat, q_lat_g) @ w_uq).reshape(Bsz, L, H, QK_NOPE + QK_ROPE)
    kv = (rms_norm(kv_lat, kv_lat_g) @ w_ukv).reshape(Bsz, L, H, QK_NOPE + V_HEAD)
    q_nope = rms_norm(q[..., :QK_NOPE], q_nope_g)
    q_rp = rope(rms_norm(q[..., QK_NOPE:], q_rope_g), cos[:, :, None], sin[:, :, None])
    k_nope = rms_norm(kv[..., :QK_NOPE], k_nope_g)
    v = kv[..., QK_NOPE:]
    k_rp = rope(rms_norm(k_rope, k_rope_g), cos, sin)
    scale = (QK_NOPE + QK_ROPE) ** -0.5
    n_blk = L // Q_BLOCK
    qn_b = jnp.swapaxes(q_nope.reshape(Bsz, n_blk, Q_BLOCK, H, QK_NOPE), 0, 1)
    qr_b = jnp.swapaxes(q_rp.reshape(Bsz, n_blk, Q_BLOCK, H, QK_ROPE), 0, 1)
    key_chunk = jnp.arange(L) // CHUNK

    def attend(args):
        blk, qn, qr = args
        s = (jnp.einsum('bqhd,bkhd->bhqk', qn, k_nope, preferred_element_type=jnp.float32)
             + jnp.einsum('bqhr,bkr->bhqk', qr, k_rp, preferred_element_type=jnp.float32)) * scale
        q_chunk = (blk * Q_BLOCK + jnp.arange(Q_BLOCK)) // CHUNK
        mask = key_chunk[None, :] <= q_chunk[:, None]
        s = jnp.where(mask[None, None], s, -jnp.inf)
        p = jax.nn.softmax(s, axis=-1)
        return jnp.einsum('bhqk,bkhd->bqhd', p.astype(v.dtype), v)

    out = lax.map(attend, (jnp.arange(n_blk), qn_b, qr_b))
    return jnp.swapaxes(out, 0, 1).reshape(Bsz, L, D_MLA)


def moe_ffn(h, w_router, b_router, w_gate_up, b_gate_up, w_down, b_down):
    Bsz, L, D = h.shape
    T = Bsz * L
    E, K, M = N_EXPERTS, TOP_K, MOE_BLOCK
    xt = h.reshape(T, D)
    logits = (xt @ w_router).astype(jnp.float32) + b_router.astype(jnp.float32)
    top_val, top_idx = lax.top_k(logits, K)
    gates = jax.nn.softmax(top_val, axis=-1)
    flat_e = top_idx.reshape(-1)
    flat_tok = jnp.arange(T * K, dtype=jnp.int32) // K
    flat_gate = gates.reshape(-1)
    order = jnp.argsort(flat_e)
    sorted_e = flat_e[order]
    counts = jnp.bincount(flat_e, length=E)
    starts = jnp.cumsum(counts) - counts
    padded = ((counts + M - 1) // M) * M
    pad_ends = jnp.cumsum(padded)
    pad_starts = pad_ends - padded
    dest = pad_starts[sorted_e] + (jnp.arange(T * K) - starts[sorted_e])
    n_blocks = -(-(T * K) // M) + E
    n_rows = n_blocks * M
    row_tok = jnp.zeros((n_rows,), jnp.int32).at[dest].set(flat_tok[order])
    row_gate = jnp.zeros((n_rows,), jnp.float32).at[dest].set(flat_gate[order])
    block_e = jnp.minimum(jnp.searchsorted(pad_ends, jnp.arange(n_blocks) * M, side='right'), E - 1)

    def expert_block(y, args):
        e, tok, g = args
        xb = xt[tok]
        gu = xb @ w_gate_up[e] + b_gate_up[e]
        gate = jnp.minimum(gu[:, 0::2], SWIGLU_LIMIT)
        up = jnp.clip(gu[:, 1::2], -SWIGLU_LIMIT, SWIGLU_LIMIT)
        act = (up + 1.0) * (gate * jax.nn.sigmoid(SWIGLU_ALPHA * gate))
        yb = (act @ w_down[e] + b_down[e]) * g[:, None].astype(xt.dtype)
        return y.at[tok].add(yb), None

    y0 = jnp.zeros((T, D), xt.dtype)
    y, _ = lax.scan(expert_block, y0,
                    (block_e, row_tok.reshape(n_blocks, M), row_gate.reshape(n_blocks, M)))
    return y.reshape(Bsz, L, D)


def setup_inputs(seed: int = 0) -> dict:
    key = jax.random.key(seed)
    ks = jax.random.split(key, 40)
    f32 = jnp.float32
    nrm = lambda k, shape, s: jax.random.normal(k, shape, f32) * s
    gain = lambda k, shape: 1.0 + 0.02 * jax.random.normal(k, shape, f32)
    G, P, H = N_SSM_GROUPS, SSM_STATE, SSM_GROUP
    offsets = jax.random.randint(ks[2], (BATCH, 1), 0, 1024, dtype=jnp.int32) * CHUNK
    positions = offsets + jnp.arange(SEQ, dtype=jnp.int32)[None, :]
    A_im = math.pi * jnp.arange(P, dtype=f32)[None, None, :] + nrm(ks[7], (DEPTH, G, P), 0.01)
    log_dt = jax.random.uniform(ks[14], (DEPTH, G), f32, math.log(DT_MIN), math.log(DT_MAX))
    return {
        'x': nrm(ks[0], (BATCH, SEQ, D_MODEL), 1.0),
        'c': nrm(ks[1], (BATCH, D_MODEL), 1.0),
        'positions': positions,
        'w_ada': nrm(ks[3], (DEPTH, D_MODEL, N_MOD * D_MODEL), 0.5 * D_MODEL ** -0.5),
        'b_ada': nrm(ks[4], (DEPTH, N_MOD * D_MODEL), 0.01),
        'norm_mix_g': gain(ks[5], (DEPTH, D_MODEL)),
        'w_in': nrm(ks[6], (DEPTH, D_MODEL, D_IN), D_MODEL ** -0.5),
        'ssm_A_re': -0.5 + nrm(ks[8], (DEPTH, G, P), 0.01),
        'ssm_A_im': A_im,
        'ssm_B_re': nrm(ks[9], (DEPTH, G, P, H), (2 * H) ** -0.5),
        'ssm_B_im': nrm(ks[10], (DEPTH, G, P, H), (2 * H) ** -0.5),
        'ssm_C_re': nrm(ks[11], (DEPTH, G, H, P), (2 * P) ** -0.5),
        'ssm_C_im': nrm(ks[12], (DEPTH, G, H, P), (2 * P) ** -0.5),
        'ssm_D': nrm(ks[13], (DEPTH, D_SSM), 1.0),
        'ssm_log_dt': log_dt,
        'q_lat_g': gain(ks[15], (DEPTH, Q_LORA)),
        'kv_lat_g': gain(ks[16], (DEPTH, KV_LORA)),
        'w_uq': nrm(ks[17], (DEPTH, Q_LORA, N_MLA_HEADS * (QK_NOPE + QK_ROPE)), Q_LORA ** -0.5),
        'w_ukv': nrm(ks[18], (DEPTH, KV_LORA, N_MLA_HEADS * (QK_NOPE + V_HEAD)), KV_LORA ** -0.5),
        'q_nope_g': gain(ks[19], (DEPTH, QK_NOPE)),
        'q_rope_g': gain(ks[20], (DEPTH, QK_ROPE)),
        'k_nope_g': gain(ks[21], (DEPTH, QK_NOPE)),
        'k_rope_g': gain(ks[22], (DEPTH, QK_ROPE)),
        'out_ssm_g': gain(ks[23], (DEPTH, D_SSM)),
        'out_mla_g': gain(ks[24], (DEPTH, D_MLA)),
        'w_out': nrm(ks[25], (DEPTH, D_MIX, D_MODEL), D_MIX ** -0.5),
        'norm_ffn_g': gain(ks[26], (DEPTH, D_MODEL)),
        'w_router': nrm(ks[27], (DEPTH, D_MODEL, N_EXPERTS), D_MODEL ** -0.5),
        'b_router': nrm(ks[28], (DEPTH, N_EXPERTS), 0.01),
        'w_gate_up': nrm(ks[29], (DEPTH, N_EXPERTS, D_MODEL, 2 * D_FF), D_MODEL ** -0.5),
        'b_gate_up': nrm(ks[30], (DEPTH, N_EXPERTS, 2 * D_FF), 0.01),
        'w_down': nrm(ks[31], (DEPTH, N_EXPERTS, D_FF, D_MODEL), D_FF ** -0.5),
        'b_down': nrm(ks[32], (DEPTH, N_EXPERTS, D_MODEL), 0.01),
    }


def reference(x, c, positions, w_ada, b_ada, norm_mix_g, w_in, ssm_A_re, ssm_A_im, ssm_B_re,
              ssm_B_im, ssm_C_re, ssm_C_im, ssm_D, ssm_log_dt, q_lat_g, kv_lat_g, w_uq, w_ukv,
              q_nope_g, q_rope_g, k_nope_g, k_rope_g, out_ssm_g, out_mla_g, w_out, norm_ffn_g,
              w_router, b_router, w_gate_up, b_gate_up, w_down, b_down):
    inv_freq = ROPE_BASE ** (-jnp.arange(0, QK_ROPE, 2, dtype=jnp.float32) / QK_ROPE)
    ang = positions.astype(jnp.float32)[..., None] * inv_freq
    cos, sin = jnp.cos(ang), jnp.sin(ang)
    c_act = jax.nn.silu(c)
    s1, s2, s3 = 2 * D_SSM, 2 * D_SSM + Q_LORA, 2 * D_SSM + Q_LORA + KV_LORA
    for l in range(DEPTH):
        mod = c_act @ w_ada[l] + b_ada[l]
        sh1, sc1, g1, sh2, sc2, g2 = [m[:, None, :] for m in jnp.split(mod, N_MOD, axis=-1)]
        h = rms_norm(x, norm_mix_g[l]) * (1.0 + sc1) + sh1
        z = h @ w_in[l]
        u, g_ssm = z[..., :D_SSM], z[..., D_SSM:s1]
        q_lat, kv_lat, k_rope = z[..., s1:s2], z[..., s2:s3], z[..., s3:]
        y_s5 = s5_mixer(u, ssm_A_re[l], ssm_A_im[l], ssm_B_re[l], ssm_B_im[l],
                        ssm_C_re[l], ssm_C_im[l], ssm_D[l], ssm_log_dt[l])
        y_s5 = (jax.nn.gelu(y_s5) * jax.nn.sigmoid(g_ssm.astype(jnp.float32))).astype(x.dtype)
        y_mla = mla_mixer(q_lat, kv_lat, k_rope, cos, sin, q_lat_g[l], kv_lat_g[l], w_uq[l],
                          w_ukv[l], q_nope_g[l], q_rope_g[l], k_nope_g[l], k_rope_g[l])
        mix = jnp.concatenate([rms_norm(y_s5, out_ssm_g[l]), rms_norm(y_mla, out_mla_g[l])], axis=-1)
        x = x + g1 * (mix @ w_out[l])
        h2 = rms_norm(x, norm_ffn_g[l]) * (1.0 + sc2) + sh2
        x = x + g2 * moe_ffn(h2, w_router[l], b_router[l], w_gate_up[l], b_gate_up[l],
                             w_down[l], b_down[l])
    return x
```

```cpp
#include <hip/hip_runtime.h>
#include <cstdio>
#include <cstdint>

#ifndef ATT_PV8
#define ATT_PV8 1
#endif
#ifndef ATT_FP8
#define ATT_FP8 1
#endif
#ifndef MOE_FP8
#define MOE_FP8 1
#endif
#ifndef MK_N_LAUNCHES
#define MK_N_LAUNCHES 1
#endif

#define LAS __attribute__((address_space(3)))
#define GAS __attribute__((address_space(1)))
typedef unsigned short bf16_t;
typedef short bf16x8 __attribute__((ext_vector_type(8)));
typedef short s16x4 __attribute__((ext_vector_type(4)));
typedef float f32x4 __attribute__((ext_vector_type(4)));
typedef float f32x2 __attribute__((ext_vector_type(2)));
typedef float f32x16 __attribute__((ext_vector_type(16)));
typedef unsigned u32x4 __attribute__((ext_vector_type(4)));
typedef unsigned u32x2 __attribute__((ext_vector_type(2)));

constexpr int NB = 2, SEQ = 16384, NTOK = NB * SEQ, DM = 2048;
constexpr int DSSM = 1024, NG = 64, SG = 16, SP = 64, NCH = NTOK / 64;
constexpr int NH = 8, QL = 512, KVL = 256;
constexpr int DIN = 2880, DINP = 3072;
constexpr int NE = 32, DFF = 2048;
constexpr int AGW = 1152;
constexpr int MAXBLK = 544, MAXROWS = MAXBLK * 256;
constexpr float EPS = 1e-6f;
constexpr int NPHASE = 13;

constexpr size_t MiB = 1u << 20;
constexpr size_t WS_CTL = 0, CTL_BYTES = 1 * MiB;
constexpr size_t WS_MOD = 1 * MiB;
constexpr size_t WS_FAB2 = WS_MOD + 512 * 1024;
constexpr size_t WS_APOW = 2 * MiB;
constexpr size_t WS_A64 = 5 * MiB;
constexpr size_t WS_A1024 = WS_A64 + 64 * 1024;
constexpr size_t WS_BB = WS_A64 + 128 * 1024;
constexpr size_t WS_KC = 6 * MiB;
constexpr size_t WS_COS = 10 * MiB, WS_SIN = 14 * MiB;
constexpr size_t WS_RIDX = 18 * MiB;
constexpr size_t WS_RGATE = WS_RIDX + 512 * 1024;
constexpr size_t WS_RPOS = WS_RGATE + 512 * 1024;
constexpr size_t WS_SLOT = WS_RPOS + 512 * 1024;
constexpr size_t WS_ROWGATE = 20 * MiB;
constexpr size_t WS_WRT = 21 * MiB;
constexpr size_t WS_WUQ = 22 * MiB, WS_WUKV = 25 * MiB, WS_WIN = 30 * MiB, WS_WOUT = 42 * MiB, WS_WG = 50 * MiB, WS_SEND = 82 * MiB, WS_KR = 98 * MiB;
constexpr size_t WS_BTG = 104 * MiB, WS_AG = 248 * MiB, WS_GS = 320 * MiB, WS_Z2 = 384 * MiB, WS_H = 456 * MiB, WS_QRAW = 584 * MiB, WS_KVRAW = 680 * MiB;
constexpr size_t WS_Q = 808 * MiB, WS_KN = 904 * MiB, WS_V = 968 * MiB, WS_YS = 1032 * MiB, WS_YM = 1096 * MiB, WS_MIX = 1224 * MiB;
constexpr size_t WS_WGU = 1352 * MiB, WS_WDN = 1864 * MiB, WS_ACT = 2120 * MiB, WS_YB = 2664 * MiB, WS_END = 3208 * MiB;
constexpr size_t WS_XS = WS_QRAW;
static_assert(WS_XS + (size_t)MAXROWS * 2048 * 2 <= WS_MIX, "XS overlay must end before MIX");
constexpr int CW_CNT = 64;
constexpr int CW_BAR = 4096;
constexpr int CW_ATT = 128;

constexpr int RING_BYTES = 131072;
constexpr int MISC_OFF = RING_BYTES;
constexpr int LDS_BYTES = 147456;
constexpr int AUX_OFF = MISC_OFF + 4096;

__device__ __forceinline__ float wave_sum(float v) {
#pragma unroll
    for (int o = 1; o < 64; o <<= 1) v += __shfl_xor(v, o);
    return v;
}
__device__ __forceinline__ unsigned cvt_pk_bf16(float lo, float hi) { unsigned r; asm volatile("v_cvt_pk_bf16_f32 %0, %1, %2" : "=v"(r) : "v"(lo), "v"(hi)); return r; }
__device__ __forceinline__ float bf2f(unsigned short b) { return __uint_as_float(((unsigned)b) << 16); }
__device__ __forceinline__ float bflo(unsigned w) { return __uint_as_float(w << 16); }
__device__ __forceinline__ float bfhi(unsigned w) { return __uint_as_float(w & 0xffff0000u); }
__device__ __forceinline__ unsigned short f2bf(float f) { return (unsigned short)(cvt_pk_bf16(f, 0.f) & 0xffffu); }
__device__ __forceinline__ float sigmoidf_(float x) { return __builtin_amdgcn_rcpf(1.0f + __builtin_amdgcn_exp2f(-1.4426950408889634f * x)); }
__device__ __forceinline__ void sincos_d(double theta, float& c, float& s) {
    double t = theta * 0.15915494309189535; t -= rint(t);
    const double r = t * 6.283185307179586;
    const double q = rint(r * 0.6366197723675814);
    const double y = r - q * 1.5707963267948966, y2 = y * y;
    const double sn = y * (1.0 + y2 * (-1.0 / 6 + y2 * (1.0 / 120 + y2 * (-1.0 / 5040 + y2 * (1.0 / 362880 + y2 * (-1.0 / 39916800))))));
    const double cs = 1.0 + y2 * (-0.5 + y2 * (1.0 / 24 + y2 * (-1.0 / 720 + y2 * (1.0 / 40320 + y2 * (-1.0 / 3628800 + y2 * (1.0 / 479001600))))));
    const int qi = ((int)q) & 3;
    const double co = (qi == 0) ? cs : (qi == 1) ? -sn : (qi == 2) ? -cs : sn;
    const double si = (qi == 0) ? sn : (qi == 1) ? cs : (qi == 2) ? -sn : -cs;
    c = (float)co; s = (float)si;
}

#define XB_TMO      128
#define XB_XCNT(j)  (256  + 64 * (j))
#define XB_XSUB(j)  (1280 + 64 * (j))
#define XB_XGEN(j)  (2304 + 64 * (j))
#define XB_TOP      3328
#define XB_TOPGEN   3392
#define XCD_BAR_WORDS 3456
#define XB_SPIN_CAP (1u << 22)
__device__ __forceinline__ unsigned xb_ld(unsigned* p)              { return __hip_atomic_load(p, __ATOMIC_RELAXED, __HIP_MEMORY_SCOPE_AGENT); }
__device__ __forceinline__ unsigned xb_add(unsigned* p, unsigned v) { return __hip_atomic_fetch_add(p, v, __ATOMIC_RELAXED, __HIP_MEMORY_SCOPE_AGENT); }
__device__ __forceinline__ unsigned xb_xcc_id() { return (unsigned)__builtin_amdgcn_s_getreg((3 << 11) | 20) & 0xFu; }
#define XB_SPIN(cond, bar) do { unsigned _sp = 0; while (cond) { __builtin_amdgcn_s_sleep(1); \
    if ((++_sp & 255u) == 0u) { if (xb_ld(&(bar)[XB_TMO])) break; if (_sp > XB_SPIN_CAP) { atomicAdd(&(bar)[XB_TMO], 1u); break; } } } } while (0)
struct XcdBarrier { unsigned* bar; unsigned x; volatile LAS unsigned* st; };
__device__ __forceinline__ XcdBarrier xcd_barrier_post(unsigned* bar, volatile LAS unsigned* st) {
    XcdBarrier b; b.bar = bar; b.x = xb_xcc_id(); b.st = st;
    if (threadIdx.x == 0) (void)xb_add(&bar[XB_XCNT(b.x)], 1u);
    return b;
}
__device__ __forceinline__ void xcd_barrier_complete(unsigned* bar, unsigned x, unsigned& nloc, unsigned& nx) {
    const unsigned G = gridDim.x * gridDim.y * gridDim.z;
    unsigned sum, cnt, mine, sp = 0u;
    for (;;) {
        sum = 0u; cnt = 0u; mine = 0u;
#pragma unroll
        for (unsigned j = 0; j < 16; ++j) { const unsigned c = xb_ld(&bar[XB_XCNT(j)]); sum += c; cnt += (c > 0u) ? 1u : 0u; mine = (j == x) ? c : mine; }
        if (sum == G) break;
        __builtin_amdgcn_s_sleep(1);
        if ((++sp & 255u) == 0u) { if (xb_ld(&bar[XB_TMO])) break; if (sp > XB_SPIN_CAP) { atomicAdd(&bar[XB_TMO], 1u); break; } }
    }
    nloc = mine > 0u ? mine : 1u; nx = cnt > 0u ? cnt : 1u;
}
__device__ __forceinline__ void xcd_barrier(const XcdBarrier& b) {
    asm volatile("s_waitcnt vmcnt(0)" ::: "memory");
    __syncthreads();
    if (threadIdx.x == 0) {
        unsigned* bar = b.bar;
        __builtin_amdgcn_s_waitcnt(0);
        unsigned nloc = b.st[0], nx = b.st[1];
        if (nloc == 0u) { xcd_barrier_complete(bar, b.x, nloc, nx); b.st[0] = nloc; b.st[1] = nx; }
        const unsigned old = xb_add(&bar[XB_XSUB(b.x)], 1u);
        const unsigned gen = old / nloc;
        if (old + 1u == (gen + 1u) * nloc) {
            __builtin_amdgcn_fence(__ATOMIC_RELEASE, "agent");
            asm volatile("s_waitcnt vmcnt(0)" ::: "memory");
            const unsigned og = xb_add(&bar[XB_TOP], 1u);
            const unsigned tg = og / nx;
            if (og + 1u == (tg + 1u) * nx) xb_add(&bar[XB_TOPGEN], 1u);
            else XB_SPIN(xb_ld(&bar[XB_TOPGEN]) == tg, bar);
            __builtin_amdgcn_fence(__ATOMIC_ACQUIRE, "agent");
            xb_add(&bar[XB_XGEN(b.x)], 1u);
            asm volatile("s_waitcnt vmcnt(0)" ::: "memory");
        } else {
            XB_SPIN(xb_ld(&bar[XB_XGEN(b.x)]) == gen, bar);
            __builtin_amdgcn_fence(__ATOMIC_ACQUIRE, "agent");
            asm volatile("s_waitcnt vmcnt(0)" ::: "memory");
        }
    }
    __syncthreads();
}

namespace pg8 {
constexpr int BM = 256, BK = 64, HALF = 128, HTB = HALF * BK * 2, STAGE_BYTES = 8 * HTB, NXCD = 8, WGM = 8;
__host__ __device__ __forceinline__ int lds_byte(int r, int c) { const int st = (r >> 4) * 2 + (c >> 5), rr = r & 15, cc = c & 31, ob = rr * 64 + cc * 2; return st * 1024 + (ob ^ (((ob >> 9) & 1) << 5)); }
__host__ __device__ __forceinline__ void stage_rc(int b, int& R, int& C) { const int st = b / 1024, sb = b % 1024, swz = sb ^ (((sb >> 9) & 1) << 5); R = (st >> 1) * 16 + swz / 64; C = (st & 1) * 32 + (swz % 64) / 2; }
__host__ __device__ __forceinline__ int perm32(int rho) { const int n = rho >> 4, i = rho & 15; return 8 * (i >> 2) + 4 * n + (i & 3); }

struct Unit { const char* A; const char* B; int nt, pm, pn, aux; };

__device__ __forceinline__ void dense_map(int L, int nM, int nN, int& pm, int& pn) {
    const int nwg = nM * nN; int wgid = L;
    { const int q = nwg / NXCD, r = nwg % NXCD, xcd = wgid % NXCD, off = wgid / NXCD; wgid = (xcd < r ? xcd * (q + 1) : r * (q + 1) + (xcd - r) * q) + off; }
    const int nig = WGM * nN, gid = wgid / nig, fm = gid * WGM, gsz = (nM - fm) < WGM ? (nM - fm) : WGM;
    pm = fm + ((wgid % nig) % gsz); pn = (wgid % nig) / gsz;
}

typedef int v8i_t __attribute__((ext_vector_type(8)));
typedef int v4i_t __attribute__((ext_vector_type(4)));
template <class Epi, class Sched, bool FP8 = false, int PRB = 0>
__device__ __forceinline__ void gemm_phase(LAS unsigned char* lds, const unsigned lda, const unsigned ldb, const Sched& S, const Epi& E) {
    const int tid = threadIdx.x, wid = __builtin_amdgcn_readfirstlane(tid >> 6), lane = tid & 63, wr = wid >> 2, wc = wid & 3, fr = lane & 15, fq = lane >> 4;
    unsigned voffA[2], voffB[2];
#pragma unroll
    for (int i = 0; i < 2; ++i) { int R, C; stage_rc(tid * 16 + i * 8192, R, C); const int Rb = Epi::PERM ? ((R & ~31) + perm32(R & 31)) : R;
        voffA[i] = (unsigned)R * lda + (unsigned)C * 2u; voffB[i] = (unsigned)Rb * ldb + (unsigned)C * 2u; }
    const size_t kstep = (size_t)(BK * 2);
    const size_t hstepA = (size_t)HALF * lda, hstepB = (size_t)HALF * ldb;
    const unsigned ldsw = (unsigned)wid * 1024u;
    const int aoff = lds_byte(wr * 64 + fr, fq * 8), boff = lds_byte(wc * 32 + fr, fq * 8);
#define PG8_SA(b, h) (((b) * 2 + (h)) * HTB)
#define PG8_SB(b, h) ((4 + (b) * 2 + (h)) * HTB)
#define PG8_STAGE(bufoff, gbase, voff) do { if constexpr (PRB != 1) { _Pragma("unroll") for (int _i = 0; _i < 2; ++_i) \
        __builtin_amdgcn_global_load_lds((const unsigned*)((const char*)(gbase) + (voff)[_i]), (LAS unsigned*)(lds + (bufoff) + ldsw + _i * 8192), 16, 0, 0); } } while (0)
#define PG8_LDA(dst, b, h) do { _Pragma("unroll") for (int m = 0; m < 4; ++m) { const v4i_t lo_ = *(const LAS v4i_t*)(lds + PG8_SA(b, h) + aoff + m * 2048), hi_ = *(const LAS v4i_t*)(lds + PG8_SA(b, h) + aoff + m * 2048 + 1024); dst[m] = __builtin_shufflevector(lo_, hi_, 0, 1, 2, 3, 4, 5, 6, 7); } } while (0)
#define PG8_LDB(dst, b, h) do { _Pragma("unroll") for (int n = 0; n < 2; ++n) { const v4i_t lo_ = *(const LAS v4i_t*)(lds + PG8_SB(b, h) + boff + n * 2048), hi_ = *(const LAS v4i_t*)(lds + PG8_SB(b, h) + boff + n * 2048 + 1024); dst[n] = __builtin_shufflevector(lo_, hi_, 0, 1, 2, 3, 4, 5, 6, 7); } } while (0)
#define PG8_LO(x) __builtin_bit_cast(bf16x8, __builtin_shufflevector(x, x, 0, 1, 2, 3))
#define PG8_HI(x) __builtin_bit_cast(bf16x8, __builtin_shufflevector(x, x, 4, 5, 6, 7))
#define PG8_MMA(ai, bj, At, Bt) do { __builtin_amdgcn_s_setprio(1); \
        if constexpr (PRB == 2) {} else if constexpr (FP8) { _Pragma("unroll") for (int m = 0; m < 4; ++m) _Pragma("unroll") for (int n = 0; n < 2; ++n) \
            asm volatile("v_mfma_f32_16x16x128_f8f6f4 %0, %1, %2, %0" : "+v"(acc[ai][bj][m][n]) : "v"(Bt[n]), "v"(At[m])); \
            asm volatile("s_nop 7" ::: "memory"); } \
        else { _Pragma("unroll") for (int m = 0; m < 4; ++m) _Pragma("unroll") for (int n = 0; n < 2; ++n) { \
            acc[ai][bj][m][n] = __builtin_amdgcn_mfma_f32_16x16x32_bf16(PG8_LO(Bt[n]), PG8_LO(At[m]), acc[ai][bj][m][n], 0, 0, 0); \
            acc[ai][bj][m][n] = __builtin_amdgcn_mfma_f32_16x16x32_bf16(PG8_HI(Bt[n]), PG8_HI(At[m]), acc[ai][bj][m][n], 0, 0, 0); } } \
        __builtin_amdgcn_s_setprio(0); } while (0)
#define PG8_WAIT_V(n) asm volatile("s_waitcnt vmcnt(" #n ")" ::: "memory")
#define PG8_WAIT_L(n) asm volatile("s_waitcnt lgkmcnt(" #n ")" ::: "memory")
#define PG8_BAR __builtin_amdgcn_s_barrier()
#define PG8_SCHED __builtin_amdgcn_sched_barrier(0)
    Unit cur, nxt; int ui = 0;
    if (!S.next(0, cur)) return;
    if constexpr (Epi::AUXT) E.prefetch(cur, lds + AUX_OFF, wid, lane);
    f32x4 acc[2][2][4][2];
#pragma unroll
    for (int a = 0; a < 2; ++a)
#pragma unroll
        for (int b = 0; b < 2; ++b)
#pragma unroll
            for (int m = 0; m < 4; ++m)
#pragma unroll
                for (int n = 0; n < 2; ++n) acc[a][b][m][n] = (f32x4){0.f, 0.f, 0.f, 0.f};
    v8i_t At[4], B0[2], B1[2];
    const char* cA = cur.A; const char* cB = cur.B;
    PG8_STAGE(PG8_SB(0, 0), cB, voffB); PG8_STAGE(PG8_SA(0, 0), cA, voffA); PG8_STAGE(PG8_SB(0, 1), cB + hstepB, voffB); PG8_STAGE(PG8_SA(0, 1), cA + hstepA, voffA);
    if (wr == 1) PG8_BAR;
    PG8_WAIT_V(4); PG8_BAR;
    PG8_STAGE(PG8_SB(1, 0), cB + kstep, voffB); PG8_STAGE(PG8_SA(1, 0), cA + kstep, voffA); PG8_STAGE(PG8_SB(1, 1), cB + hstepB + kstep, voffB);
    PG8_WAIT_V(6); PG8_BAR;
    for (;;) {
        const bool has_next = S.next(ui + 1, nxt);
        const char* nA = has_next ? nxt.A : cA; const char* nB = has_next ? nxt.B : cB;
        const int nt = cur.nt;
        for (int t = 0; t < nt; t += 2) {
            const bool last = (t == nt - 2);
            if constexpr (Epi::AUXT) { if (last && has_next) E.prefetch(nxt, lds + AUX_OFF + ((ui + 1) & 1) * 2048, wid, lane); }
            const char* a1 = cA + (size_t)(t + 1) * kstep;
            const char* a2 = last ? nA : cA + (size_t)(t + 2) * kstep; const char* b2 = last ? nB : cB + (size_t)(t + 2) * kstep;
            const char* a3 = a2 + kstep; const char* b3 = b2 + kstep;
            PG8_LDB(B0, 0, 0); PG8_SCHED; PG8_LDA(At, 0, 0); PG8_STAGE(PG8_SA(1, 1), a1 + hstepA, voffA);
            PG8_WAIT_L(8); PG8_BAR; PG8_WAIT_L(0); PG8_MMA(0, 0, At, B0); PG8_BAR; PG8_SCHED;
            PG8_LDB(B1, 0, 1); PG8_STAGE(PG8_SB(0, 0), b2, voffB);
            PG8_BAR; PG8_WAIT_L(0); PG8_MMA(0, 1, At, B1); PG8_BAR;
            PG8_LDA(At, 0, 1); PG8_STAGE(PG8_SA(0, 0), a2, voffA);
            PG8_BAR; PG8_WAIT_L(0); PG8_MMA(1, 0, At, B0); PG8_BAR; PG8_SCHED;
            PG8_STAGE(PG8_SB(0, 1), b2 + hstepB, voffB);
            PG8_WAIT_V(6); PG8_BAR; PG8_MMA(1, 1, At, B1); PG8_BAR;
            PG8_LDB(B0, 1, 0); PG8_SCHED; PG8_LDA(At, 1, 0); PG8_STAGE(PG8_SA(0, 1), a2 + hstepA, voffA);
            PG8_WAIT_L(8); PG8_BAR; PG8_WAIT_L(0); PG8_MMA(0, 0, At, B0); PG8_BAR; PG8_SCHED;
            PG8_LDB(B1, 1, 1); PG8_STAGE(PG8_SB(1, 0), b3, voffB);
            PG8_BAR; PG8_WAIT_L(0); PG8_MMA(0, 1, At, B1); PG8_BAR;
            PG8_LDA(At, 1, 1); PG8_STAGE(PG8_SA(1, 0), a3, voffA);
            PG8_BAR; PG8_WAIT_L(0); PG8_MMA(1, 0, At, B0); PG8_BAR; PG8_SCHED;
            PG8_STAGE(PG8_SB(1, 1), b3 + hstepB, voffB);
            PG8_WAIT_V(6); PG8_BAR; PG8_MMA(1, 1, At, B1); PG8_BAR;
        }
        if constexpr (FP8) asm volatile("s_nop 15\n\ts_nop 15" ::: "memory");
        if constexpr (PRB == 0) { if constexpr (Epi::AUXT) E(acc, cur, wr, wc, fr, fq, lds + AUX_OFF + (ui & 1) * 2048); else E(acc, cur, wr, wc, fr, fq); }
        if (!has_next) break;
#pragma unroll
        for (int a = 0; a < 2; ++a)
#pragma unroll
            for (int b = 0; b < 2; ++b)
#pragma unroll
                for (int m = 0; m < 4; ++m)
#pragma unroll
                    for (int n = 0; n < 2; ++n) acc[a][b][m][n] = (f32x4){0.f, 0.f, 0.f, 0.f};
        cur = nxt; cA = nA; cB = nB; ++ui;
    }
    PG8_WAIT_V(0);
    if (wr == 0) PG8_BAR;
    PG8_BAR;
#undef PG8_SA
#undef PG8_SB
#undef PG8_STAGE
#undef PG8_LDA
#undef PG8_LDB
#undef PG8_LO
#undef PG8_HI
#undef PG8_MMA
#undef PG8_WAIT_V
#undef PG8_WAIT_L
#undef PG8_BAR
#undef PG8_SCHED
}
}
using pg8::Unit;

struct SchedDense {
    const char* A; const char* B; unsigned lda, ldb; int nM, nN, nt, G, c;
    __device__ __forceinline__ bool next(int i, Unit& u) const {
        const long L = (long)i * G + c; if (L >= (long)nM * nN) return false;
        int pm, pn; pg8::dense_map((int)L, nM, nN, pm, pn);
        u.A = A + (size_t)pm * 256 * lda; u.B = B + (size_t)pn * 256 * ldb; u.nt = nt; u.pm = pm; u.pn = pn; u.aux = 0; return true;
    }
};
struct SchedP3 {
    const char* AG; const char* WG; const char* Z2; const char* WUQ; const char* WUKV; int G, c;
    __device__ __forceinline__ bool next(int i, Unit& u) const {
        int kind, L;
        if (G == 256) {
            if (c < 128) { if (i == 0) { kind = 2; L = c; } else if (i <= 3) { kind = 0; L = (i - 1) * 256 + c; } else if (i == 4) { kind = 0; L = 2 * 256 + c + 128; } else if (i == 5) { kind = 1; L = 3 * 256 + c; } else return false; }
            else { if (i <= 1) { kind = 0; L = i * 256 + c; } else if (i <= 5) { kind = 1; L = (i - 2) * 256 + c; } else if (i <= 8) { kind = 1; L = (i - 6) * 256 + (c - 128); } else return false; }
        } else { const int Lg = i * G + c; if (Lg < 128) { kind = 2; L = Lg; } else if (Lg < 896) { kind = 0; L = Lg - 128; } else if (Lg < 1920) { kind = 1; L = Lg - 896; } else return false; }
        if (kind == 2) { const int g = L >> 1, pmm = L & 1; u.A = AG + ((size_t)(g * NCH + pmm * 256) * AGW + 128) * 2; u.B = WG + (size_t)g * 256 * 1024 * 2; u.nt = 16; u.pm = g * 2 + pmm; u.pn = 0; u.aux = 2; return true; }
        if (kind == 0) { int pm, pn; pg8::dense_map(L, 128, 6, pm, pn); u.A = Z2 + (size_t)pm * 256 * (AGW * 2); u.B = WUQ + (size_t)pn * 256 * 2048; u.nt = 8; u.pm = pm; u.pn = pn; u.aux = 0; return true; }
        { int pm, pn; pg8::dense_map(L, 128, 8, pm, pn); u.A = Z2 + (size_t)pm * 256 * (AGW * 2) + 1024; u.B = WUKV + (size_t)pn * 256 * 2048; u.nt = 4; u.pm = pm; u.pn = pn; u.aux = 1; return true; }
    }
};
struct SchedSsm {
    const char* AG; const char* BTG; int G, c;
    __device__ __forceinline__ bool next(int i, Unit& u) const {
        int pn, gp;
        if (G == 256) { if (i > 1) return false; pn = (i == 0) ? ((c < 128) ? 3 : 2) : ((c < 128) ? 0 : 1); gp = c & 127; }
        else { const int L = i * G + c; if (L >= 512) return false; pn = 3 - (L >> 7); gp = L & 127; }
        const int g = gp >> 1, pmm = gp & 1;
        u.A = AG + (size_t)(g * NCH + pmm * 256) * AGW * 2; u.B = BTG + ((size_t)g * 1024 + pn * 256) * AGW * 2; u.nt = 2 + 4 * (pn + 1); u.pm = pmm; u.pn = pn; u.aux = g; return true;
    }
};
struct SchedMoe {
    const char* A; const char* W; const volatile LAS int* tab; int NPN, G, c; size_t wstride; unsigned rowb; int nt;
    __device__ __forceinline__ bool next(int i, Unit& u) const {
        const int total = __builtin_amdgcn_readfirstlane(tab[64]);
        int grb, pn;
        if ((G & 255) == 0) {
            const int L = i * G + c, x = L & 7, j = (L >> 3) & 31, R = (L >> 8) * 8 + x;
            const int s = (NPN == 16) ? (R >> 1) : R;
            grb = 4 * s + (j & 3); pn = ((NPN == 16) ? 8 * (R & 1) : 0) + (j >> 2);
            if (4 * s >= total) return false;
            if (grb >= total) { grb = total - 1; u.aux = -1; }
        } else { const int L = i * G + c; if (L >= total * NPN) return false; grb = L / NPN; pn = L % NPN; }
        const int e = __builtin_amdgcn_readfirstlane(tab[128 + grb]);
        u.A = A + (size_t)grb * 256 * rowb; u.B = W + (size_t)e * wstride + (size_t)pn * 256 * rowb; u.nt = nt; u.pm = grb; u.pn = pn; u.aux = e; return true;
    }
};

struct EpiZ {
    static constexpr bool PERM = true; static constexpr bool AUXT = false;
    bf16_t* AG; bf16_t* GS; bf16_t* Z2;
    __device__ __forceinline__ void operator()(const f32x4 (&acc)[2][2][4][2], const Unit& u, int wr, int wc, int fr, int fq) const {
        const int row0 = u.pm * 256 + wr * 64 + fr, colt = u.pn * 256 + wc * 32 + 8 * fq;
#pragma unroll
        for (int ai = 0; ai < 2; ++ai)
#pragma unroll
            for (int m = 0; m < 4; ++m) { const int row = row0 + ai * 128 + m * 16; const int chunk = row >> 6, j = row & 63;
#pragma unroll
                for (int bj = 0; bj < 2; ++bj) { const int col = colt + bj * 128; const f32x4 v0 = acc[ai][bj][m][0], v1 = acc[ai][bj][m][1];
                    u32x4 w; w.x = cvt_pk_bf16(v0[0], v0[1]); w.y = cvt_pk_bf16(v0[2], v0[3]); w.z = cvt_pk_bf16(v1[0], v1[1]); w.w = cvt_pk_bf16(v1[2], v1[3]);
                    bf16_t* dst;
                    if (u.pn < 4) { const int g = col >> 4, h0 = col & 15; dst = AG + ((size_t)(g * NCH + chunk) * AGW + 128 + j * 16 + h0); }
                    else if (u.pn < 8) { const int ch = col - 1024, g = ch >> 4, h0 = ch & 15; dst = GS + ((size_t)(g * NCH + chunk) * 1024 + j * 16 + h0); }
                    else dst = Z2 + (size_t)row * AGW + (col - 2048);
                    *(u32x4*)dst = w; } }
    }
};
struct EpiP3 {
    static constexpr bool PERM = true; static constexpr bool AUXT = false;
    bf16_t* QRAW; bf16_t* KVRAW; float* SEND;
    __device__ __forceinline__ void operator()(const f32x4 (&acc)[2][2][4][2], const Unit& u, int wr, int wc, int fr, int fq) const {
        if (u.aux == 2) {
            const int row0 = u.pm * 256 + wr * 64 + fr, col0 = wc * 32 + 8 * fq;
#pragma unroll
            for (int ai = 0; ai < 2; ++ai)
#pragma unroll
                for (int m = 0; m < 4; ++m) { float* rowp = SEND + (size_t)(row0 + ai * 128 + m * 16) * 128 + col0;
                    *(f32x4*)rowp = acc[ai][0][m][0]; *(f32x4*)(rowp + 4) = acc[ai][0][m][1]; }
        } else {
            bf16_t* O = (u.aux == 0) ? QRAW : KVRAW; const int ldc = (u.aux == 0) ? 1536 : 2048;
            const int row0 = u.pm * 256 + wr * 64 + fr, col0 = u.pn * 256 + wc * 32 + 8 * fq;
#pragma unroll
            for (int ai = 0; ai < 2; ++ai)
#pragma unroll
                for (int m = 0; m < 4; ++m) { bf16_t* rowp = O + (size_t)(row0 + ai * 128 + m * 16) * ldc + col0;
#pragma unroll
                    for (int bj = 0; bj < 2; ++bj) { const f32x4 v0 = acc[ai][bj][m][0], v1 = acc[ai][bj][m][1];
                        u32x4 w; w.x = cvt_pk_bf16(v0[0], v0[1]); w.y = cvt_pk_bf16(v0[2], v0[3]); w.z = cvt_pk_bf16(v1[0], v1[1]); w.w = cvt_pk_bf16(v1[2], v1[3]);
                        *(u32x4*)(rowp + bj * 128) = w; } }
        }
    }
};
__device__ __forceinline__ float gelu_tanh(float x) { const float u = 0.7978845608028654f * (x + 0.044715f * x * x * x); return x * sigmoidf_(2.0f * u); }
struct EpiSsm {
    static constexpr bool PERM = true; static constexpr bool AUXT = false;
    const bf16_t* GS; bf16_t* YS;
    __device__ __forceinline__ void operator()(const f32x4 (&acc)[2][2][4][2], const Unit& u, int wr, int wc, int fr, int fq) const {
        const int g = u.aux, row0 = u.pm * 256 + wr * 64 + fr, colt = u.pn * 256 + wc * 32 + 8 * fq;
#pragma unroll
        for (int ai = 0; ai < 2; ++ai)
#pragma unroll
            for (int m = 0; m < 4; ++m) { const int chunk = row0 + ai * 128 + m * 16;
#pragma unroll
                for (int bj = 0; bj < 2; ++bj) { const int col = colt + bj * 128, l = col >> 4, h0 = col & 15;
                    const u32x4 gw = *(const u32x4*)(GS + ((size_t)(g * NCH + chunk) * 1024 + col));
                    const f32x4 v0 = acc[ai][bj][m][0], v1 = acc[ai][bj][m][1];
                    float o[8];
                    o[0] = gelu_tanh(v0[0]) * sigmoidf_(bflo(gw.x)); o[1] = gelu_tanh(v0[1]) * sigmoidf_(bfhi(gw.x));
                    o[2] = gelu_tanh(v0[2]) * sigmoidf_(bflo(gw.y)); o[3] = gelu_tanh(v0[3]) * sigmoidf_(bfhi(gw.y));
                    o[4] = gelu_tanh(v1[0]) * sigmoidf_(bflo(gw.z)); o[5] = gelu_tanh(v1[1]) * sigmoidf_(bfhi(gw.z));
                    o[6] = gelu_tanh(v1[2]) * sigmoidf_(bflo(gw.w)); o[7] = gelu_tanh(v1[3]) * sigmoidf_(bfhi(gw.w));
                    u32x4 w; w.x = cvt_pk_bf16(o[0], o[1]); w.y = cvt_pk_bf16(o[2], o[3]); w.z = cvt_pk_bf16(o[4], o[5]); w.w = cvt_pk_bf16(o[6], o[7]);
                    *(u32x4*)(YS + ((size_t)(chunk * 64 + l) * 1024 + g * 16 + h0)) = w; } }
    }
};
#ifndef OUT_FP8
#define OUT_FP8 0
#endif
struct EpiOut {
    static constexpr float OUT_SC = OUT_FP8 ? (1.0f / 64.0f) : 1.0f;
    static constexpr bool PERM = true; static constexpr bool AUXT = false;
    const float* X; bf16_t* X1B; const float* MOD;
    __device__ __forceinline__ void operator()(const f32x4 (&acc)[2][2][4][2], const Unit& u, int wr, int wc, int fr, int fq) const {
        const int row0 = u.pm * 256 + wr * 64 + fr, col0 = u.pn * 256 + wc * 32 + 8 * fq;
        const int b = (u.pm * 256) >> 14;
        f32x4 gv[2][2];
#pragma unroll
        for (int bj = 0; bj < 2; ++bj)
#pragma unroll
            for (int n = 0; n < 2; ++n) gv[bj][n] = *(const f32x4*)(MOD + b * 12288 + 4096 + col0 + bj * 128 + 4 * n);
#pragma unroll
        for (int ai = 0; ai < 2; ++ai)
#pragma unroll
            for (int m = 0; m < 4; ++m) { const size_t off = (size_t)(row0 + ai * 128 + m * 16) * DM + col0;
#pragma unroll
                for (int bj = 0; bj < 2; ++bj) { const f32x4 x0 = *(const f32x4*)(X + off + bj * 128), x1 = *(const f32x4*)(X + off + bj * 128 + 4);
                    const f32x4 v0 = x0 + gv[bj][0] * (acc[ai][bj][m][0] * OUT_SC), v1 = x1 + gv[bj][1] * (acc[ai][bj][m][1] * OUT_SC);
                    u32x4 w; w.x = cvt_pk_bf16(v0[0], v0[1]); w.y = cvt_pk_bf16(v0[2], v0[3]); w.z = cvt_pk_bf16(v1[0], v1[1]); w.w = cvt_pk_bf16(v1[2], v1[3]);
                    *(u32x4*)(X1B + off + bj * 128) = w; } }
    }
};
__device__ __forceinline__ unsigned pk4_fp8(float a, float b, float c, float d) { unsigned w = 0u; w = __builtin_amdgcn_cvt_pk_fp8_f32(a, b, w, false); w = __builtin_amdgcn_cvt_pk_fp8_f32(c, d, w, true); return w; }
constexpr float W8_SCALE = 64.0f, W8_INV = 1.0f / 64.0f;
struct EpiGu {
    static constexpr bool PERM = true; static constexpr bool AUXT = true;
    const float* BGU; unsigned char* ACT;
    __device__ __forceinline__ void prefetch(const Unit& u, LAS unsigned char* aux, int wid, int lane) const {
        if (wid == 0) __builtin_amdgcn_global_load_lds((const unsigned*)(BGU + (size_t)u.aux * 4096 + u.pn * 256 + lane * 4), (LAS unsigned*)aux, 16, 0, 0);
    }
    __device__ __forceinline__ void operator()(const f32x4 (&acc)[2][2][4][2], const Unit& u, int wr, int wc, int fr, int fq, const LAS unsigned char* aux) const {
        const int row0 = u.pm * 256 + wr * 64 + fr, j0 = u.pn * 128 + wc * 32 + 8 * fq;
        const LAS f32x4* bp = (const LAS f32x4*)(aux + (wc * 32 + 8 * fq) * 8);
        const f32x4 b0 = bp[0], b1 = bp[1], b2 = bp[2], b3 = bp[3];
        const float bg[8] = {b0[0], b0[2], b1[0], b1[2], b2[0], b2[2], b3[0], b3[2]}, bu[8] = {b0[1], b0[3], b1[1], b1[3], b2[1], b2[3], b3[1], b3[3]};
        constexpr float SC = MOE_FP8 ? W8_INV : 1.0f;
#pragma unroll
        for (int ai = 0; ai < 2; ++ai)
#pragma unroll
            for (int m = 0; m < 4; ++m) { float o[8];
#pragma unroll
                for (int n = 0; n < 2; ++n)
#pragma unroll
                    for (int e = 0; e < 4; ++e) { float gt = acc[ai][0][m][n][e] * SC + bg[4 * n + e], up = acc[ai][1][m][n][e] * SC + bu[4 * n + e];
                        gt = fminf(gt, 7.0f); up = fminf(fmaxf(up, -7.0f), 7.0f); o[4 * n + e] = (up + 1.0f) * gt * sigmoidf_(1.702f * gt); }
#if MOE_FP8
                u32x2 w; w.x = pk4_fp8(o[0], o[1], o[2], o[3]); w.y = pk4_fp8(o[4], o[5], o[6], o[7]);
                *(u32x2*)(ACT + (size_t)(row0 + ai * 128 + m * 16) * 2048 + j0) = w;
#else
                u32x4 w; w.x = cvt_pk_bf16(o[0], o[1]); w.y = cvt_pk_bf16(o[2], o[3]); w.z = cvt_pk_bf16(o[4], o[5]); w.w = cvt_pk_bf16(o[6], o[7]);
                *(u32x4*)((bf16_t*)ACT + (size_t)(row0 + ai * 128 + m * 16) * 2048 + j0) = w;
#endif
            }
    }
};
constexpr float YB_SCALE = 16.0f, YB_INV = 1.0f / 16.0f;
struct EpiDn {
    static constexpr bool PERM = true; static constexpr bool AUXT = true;
    const float* BD; const float* ROWGATE; unsigned char* YB;
    __device__ __forceinline__ void prefetch(const Unit& u, LAS unsigned char* aux, int wid, int lane) const {
        if (wid == 0) __builtin_amdgcn_global_load_lds((const unsigned*)(BD + (size_t)u.aux * 2048 + u.pn * 256 + lane * 4), (LAS unsigned*)aux, 16, 0, 0);
        if (wid == 1) __builtin_amdgcn_global_load_lds((const unsigned*)(ROWGATE + (size_t)u.pm * 256 + lane * 4), (LAS unsigned*)(aux + 1024), 16, 0, 0);
    }
    __device__ __forceinline__ void operator()(const f32x4 (&acc)[2][2][4][2], const Unit& u, int wr, int wc, int fr, int fq, const LAS unsigned char* aux) const {
        const int row0 = u.pm * 256 + wr * 64 + fr, col0 = u.pn * 256 + wc * 32 + 8 * fq;
        f32x4 bv[2][2];
#pragma unroll
        for (int bj = 0; bj < 2; ++bj)
#pragma unroll
            for (int n = 0; n < 2; ++n) bv[bj][n] = *(const LAS f32x4*)(aux + (wc * 32 + 8 * fq + bj * 128 + 4 * n) * 4);
        const LAS float* gp = (const LAS float*)(aux + 1024) + wr * 64 + fr;
#pragma unroll
        for (int ai = 0; ai < 2; ++ai)
#pragma unroll
            for (int m = 0; m < 4; ++m) { const int row = row0 + ai * 128 + m * 16; const float gt = gp[ai * 128 + m * 16] * YB_SCALE;
#pragma unroll
                for (int bj = 0; bj < 2; ++bj) { constexpr float SC = MOE_FP8 ? W8_INV : 1.0f; const f32x4 v0 = (acc[ai][bj][m][0] * SC + bv[bj][0]) * gt, v1 = (acc[ai][bj][m][1] * SC + bv[bj][1]) * gt;
                    u32x2 w; w.x = pk4_fp8(v0[0], v0[1], v0[2], v0[3]); w.y = pk4_fp8(v1[0], v1[1], v1[2], v1[3]);
                    *(u32x2*)(YB + (size_t)row * 2048 + col0 + bj * 128) = w; } }
    }
};

namespace att {
constexpr int D = 128, NW = 8, QBLK = 32, KVBLK = 64;
constexpr float SCALE = 0.07216878364870322f;
constexpr float THR = 8.f;
#ifndef ATT_SDEPTH
#define ATT_SDEPTH 2
#endif
constexpr int SDEPTH = ATT_SDEPTH;
constexpr int LDQ = 192, LDK = 128, LDR = 64, LDO = 1024;
constexpr int SHM_V = KVBLK * D * 2, SHM_K = KVBLK * D * 2, SHM_R = KVBLK * 64 * 2;
constexpr int OFF_V = 0, OFF_K = 2 * SHM_V, OFF_R = OFF_K + 2 * SHM_K, OFF_WS = OFF_R + 2 * SHM_R, SHM_ATTN = OFF_WS + NW * 64 * 4;
#define KSWZ(row, colB) ((row) * 256 + ((colB) ^ (((row) & 15) << 4)))
#define RSWZ(row, colB) ((row) * 128 + ((colB) ^ ((((row) >> 1) & 7) << 4)))
#define SBAR() __builtin_amdgcn_sched_barrier(0)
__device__ __forceinline__ int crow(int r, int hi) { return (r & 3) + 8 * (r >> 2) + 4 * hi; }

__device__ __forceinline__ void partialSM(f32x16& p0, f32x16& p1, float& m_reg, float& mn, float& alpha) {
  constexpr float C = SCALE * 1.4426950408889634f;
  float pmax = p0[0];
#pragma unroll
  for (int r = 1; r < 16; ++r) pmax = fmaxf(pmax, p0[r]);
#pragma unroll
  for (int r = 0; r < 16; ++r) pmax = fmaxf(pmax, p1[r]);
  { auto rr = __builtin_amdgcn_permlane32_swap(__float_as_uint(pmax), __float_as_uint(pmax), false, false);
    pmax = fmaxf(__uint_as_float(rr[0]), __uint_as_float(rr[1])); }
  if (__builtin_expect(__all(pmax - m_reg <= THR / SCALE), 1)) { mn = m_reg; alpha = 1.f; }
  else { mn = fmaxf(m_reg, pmax); alpha = __builtin_amdgcn_exp2f((m_reg - mn) * C); m_reg = mn; }
  float mnC = -mn * C;
#pragma unroll
  for (int r = 0; r < 16; ++r) p0[r] = fmaf(p0[r], C, mnC);
#pragma unroll
  for (int r = 0; r < 16; ++r) p1[r] = fmaf(p1[r], C, mnC);
#pragma unroll
  for (int r = 0; r < 16; ++r) p0[r] = __builtin_amdgcn_exp2f(p0[r]);
}
__device__ __forceinline__ void finishSM(f32x16& p0, f32x16& p1, float alpha, float& l_reg, bf16x8& pa0, bf16x8& pa1, bf16x8& pa2, bf16x8& pa3) {
#pragma unroll
  for (int r = 0; r < 16; ++r) p1[r] = __builtin_amdgcn_exp2f(p1[r]);
  float ps = 0;
#pragma unroll
  for (int r = 0; r < 16; ++r) ps += p0[r];
#pragma unroll
  for (int r = 0; r < 16; ++r) ps += p1[r];
  { auto rr = __builtin_amdgcn_permlane32_swap(__float_as_uint(ps), __float_as_uint(ps), false, false);
    ps = __uint_as_float(rr[0]) + __uint_as_float(rr[1]); }
  l_reg = l_reg * alpha + ps;
#define PK4(P, BASE, OUT) do { unsigned a0 = cvt_pk_bf16(P[BASE + 0], P[BASE + 1]), a1 = cvt_pk_bf16(P[BASE + 2], P[BASE + 3]);   \
    unsigned b0 = cvt_pk_bf16(P[BASE + 4], P[BASE + 5]), b1 = cvt_pk_bf16(P[BASE + 6], P[BASE + 7]);                              \
    auto r0 = __builtin_amdgcn_permlane32_swap(a0, b0, false, false); auto r1 = __builtin_amdgcn_permlane32_swap(a1, b1, false, false); \
    u32x4 w = {r0[0], r1[0], r0[1], r1[1]}; OUT = *reinterpret_cast<bf16x8*>(&w); } while (0)
  PK4(p0, 0, pa0); PK4(p0, 8, pa1); PK4(p1, 0, pa2); PK4(p1, 8, pa3);
#undef PK4
}
__device__ __forceinline__ void softmax_nomax(f32x16& p0, f32x16& p1, float& l_reg, bf16x8& pa0, bf16x8& pa1, bf16x8& pa2, bf16x8& pa3) {
#pragma unroll
  for (int r = 0; r < 16; ++r) p0[r] = __builtin_amdgcn_exp2f(p0[r]);
#pragma unroll
  for (int r = 0; r < 16; ++r) p1[r] = __builtin_amdgcn_exp2f(p1[r]);
  float ps = 0;
#pragma unroll
  for (int r = 0; r < 16; ++r) ps += p0[r];
#pragma unroll
  for (int r = 0; r < 16; ++r) ps += p1[r];
  l_reg += ps;
#define PK4(P, BASE, OUT) do { unsigned a0 = cvt_pk_bf16(P[BASE + 0], P[BASE + 1]), a1 = cvt_pk_bf16(P[BASE + 2], P[BASE + 3]);   \
    unsigned b0 = cvt_pk_bf16(P[BASE + 4], P[BASE + 5]), b1 = cvt_pk_bf16(P[BASE + 6], P[BASE + 7]);                              \
    auto r0 = __builtin_amdgcn_permlane32_swap(a0, b0, false, false); auto r1 = __builtin_amdgcn_permlane32_swap(a1, b1, false, false); \
    u32x4 w = {r0[0], r1[0], r0[1], r1[1]}; OUT = *reinterpret_cast<bf16x8*>(&w); } while (0)
  PK4(p0, 0, pa0); PK4(p0, 8, pa1); PK4(p1, 0, pa2); PK4(p1, 8, pa3);
#undef PK4
}
__device__ __forceinline__ void qkt(f32x16& p0, f32x16& p1, const char* Ks, const char* Rs, const bf16x8* qr, int r32, int hi, bool masked) {
  p0 = f32x16{}; p1 = f32x16{};
#pragma unroll
  for (int d0 = 0; d0 < 8; ++d0) { int cb = (d0 * 16 + hi * 8) * 2;
    bf16x8 b0 = *reinterpret_cast<const bf16x8*>(Ks + KSWZ(r32, cb));
    bf16x8 b1 = *reinterpret_cast<const bf16x8*>(Ks + KSWZ(32 + r32, cb));
    p0 = __builtin_amdgcn_mfma_f32_32x32x16_bf16(b0, qr[d0], p0, 0, 0, 0);
    p1 = __builtin_amdgcn_mfma_f32_32x32x16_bf16(b1, qr[d0], p1, 0, 0, 0); }
#pragma unroll
  for (int d0 = 0; d0 < 4; ++d0) { int cb = (d0 * 16 + hi * 8) * 2;
    bf16x8 b0 = *reinterpret_cast<const bf16x8*>(Rs + RSWZ(r32, cb));
    bf16x8 b1 = *reinterpret_cast<const bf16x8*>(Rs + RSWZ(32 + r32, cb));
    p0 = __builtin_amdgcn_mfma_f32_32x32x16_bf16(b0, qr[8 + d0], p0, 0, 0, 0);
    p1 = __builtin_amdgcn_mfma_f32_32x32x16_bf16(b1, qr[8 + d0], p1, 0, 0, 0); }
  (void)masked;
}
__device__ __forceinline__ int v_st(int k, int c) { const int kk = (k & ~0xC) | ((k & 4) << 1) | ((k & 8) >> 1); return ((kk >> 3) * 4 + (c >> 5)) * 512 + ((kk & 7) * 32 + (c & 31)) * 2; }
__device__ __forceinline__ int v_rd_base(int lane) { return ((lane & 3) << 3) | (((lane >> 2) & 3) << 6) | (((lane >> 4) & 1) << 5) | (((lane >> 5) & 1) << 8); }
constexpr int v_rd_off(int d0, int ks, int half) { return d0 * 512 + ks * 4096 + half * 2048; }
template <int OFF> __device__ __forceinline__ s16x4 tr_read(int vb) {
  s16x4 r; asm volatile("ds_read_b64_tr_b16 %0, %1 offset:%2" : "=&v"(r) : "v"(vb), "i"(OFF) : "memory"); return r;
}
template <int D0> __device__ __forceinline__ void pv_one(f32x16& od, int vb, bf16x8 pa0, bf16x8 pa1, bf16x8 pa2, bf16x8 pa3) {
  const s16x4 l0 = tr_read<v_rd_off(D0, 0, 0)>(vb), h0 = tr_read<v_rd_off(D0, 0, 1)>(vb), l1 = tr_read<v_rd_off(D0, 1, 0)>(vb), h1 = tr_read<v_rd_off(D0, 1, 1)>(vb);
  const s16x4 l2 = tr_read<v_rd_off(D0, 2, 0)>(vb), h2 = tr_read<v_rd_off(D0, 2, 1)>(vb), l3 = tr_read<v_rd_off(D0, 3, 0)>(vb), h3 = tr_read<v_rd_off(D0, 3, 1)>(vb);
  asm volatile("s_waitcnt lgkmcnt(0)" ::: "memory"); SBAR();
#define PK(L, H) (bf16x8){L[0], L[1], L[2], L[3], H[0], H[1], H[2], H[3]}
  od = __builtin_amdgcn_mfma_f32_32x32x16_bf16(pa0, PK(l0, h0), od, 0, 0, 0);
  od = __builtin_amdgcn_mfma_f32_32x32x16_bf16(pa1, PK(l1, h1), od, 0, 0, 0);
  od = __builtin_amdgcn_mfma_f32_32x32x16_bf16(pa2, PK(l2, h2), od, 0, 0, 0);
  od = __builtin_amdgcn_mfma_f32_32x32x16_bf16(pa3, PK(l3, h3), od, 0, 0, 0);
#undef PK
}
__device__ __forceinline__ void pv_d0(f32x16* o, int vb, bf16x8 pa0, bf16x8 pa1, bf16x8 pa2, bf16x8 pa3) {
  pv_one<0>(o[0], vb, pa0, pa1, pa2, pa3); pv_one<1>(o[1], vb, pa0, pa1, pa2, pa3); pv_one<2>(o[2], vb, pa0, pa1, pa2, pa3); pv_one<3>(o[3], vb, pa0, pa1, pa2, pa3);
}

#define PK(L, H) (bf16x8){L[0], L[1], L[2], L[3], H[0], H[1], H[2], H[3]}
#define PV_READ(D0, S) const s16x4 l0##S = tr_read<v_rd_off(D0, 0, 0)>(vb), h0##S = tr_read<v_rd_off(D0, 0, 1)>(vb), l1##S = tr_read<v_rd_off(D0, 1, 0)>(vb), h1##S = tr_read<v_rd_off(D0, 1, 1)>(vb), \
    l2##S = tr_read<v_rd_off(D0, 2, 0)>(vb), h2##S = tr_read<v_rd_off(D0, 2, 1)>(vb), l3##S = tr_read<v_rd_off(D0, 3, 0)>(vb), h3##S = tr_read<v_rd_off(D0, 3, 1)>(vb)
#define PV_MMA(D0, S) do { o[D0] = __builtin_amdgcn_mfma_f32_32x32x16_bf16(pa0, PK(l0##S, h0##S), o[D0], 0, 0, 0); o[D0] = __builtin_amdgcn_mfma_f32_32x32x16_bf16(pa1, PK(l1##S, h1##S), o[D0], 0, 0, 0); \
    o[D0] = __builtin_amdgcn_mfma_f32_32x32x16_bf16(pa2, PK(l2##S, h2##S), o[D0], 0, 0, 0); o[D0] = __builtin_amdgcn_mfma_f32_32x32x16_bf16(pa3, PK(l3##S, h3##S), o[D0], 0, 0, 0); } while (0)
__device__ __forceinline__ void pv_pipe(f32x16* o, int vb, bf16x8 pa0, bf16x8 pa1, bf16x8 pa2, bf16x8 pa3) {
  PV_READ(0, a); PV_READ(1, b);
  asm volatile("s_waitcnt lgkmcnt(8)" ::: "memory"); SBAR(); PV_MMA(0, a); SBAR();
  PV_READ(2, c);
  asm volatile("s_waitcnt lgkmcnt(8)" ::: "memory"); SBAR(); PV_MMA(1, b); SBAR();
  PV_READ(3, d);
  asm volatile("s_waitcnt lgkmcnt(8)" ::: "memory"); SBAR(); PV_MMA(2, c); SBAR();
  asm volatile("s_waitcnt lgkmcnt(0)" ::: "memory"); SBAR(); PV_MMA(3, d);
}
#undef PV_READ
#undef PV_MMA
#undef PK

constexpr int STG = SHM_V + SHM_K + SHM_R;
constexpr int OFF_WS3 = 3 * STG;
__device__ __forceinline__ void attn_block(const bf16_t* __restrict__ Qb, const bf16_t* __restrict__ Kh, const bf16_t* __restrict__ Vh, const bf16_t* __restrict__ Rh,
                                           float* __restrict__ Ob, int qb, char* lds) {
  const int tid = threadIdx.x, wid = __builtin_amdgcn_readfirstlane(tid >> 6), lane = tid & 63, r32 = lane & 31, hi = lane >> 5;
  float* ws = (float*)(lds + OFF_WS3) + wid * 64; float* li_l = ws; float* al_l = ws + 32;
  float l_reg = 0; f32x16 o[4] = {}; bf16x8 qr[12];
  const bf16_t* Qw = Qb + (long)(wid * QBLK + r32) * LDQ + hi * 8;
#pragma unroll
  for (int d0 = 0; d0 < 12; ++d0) qr[d0] = *reinterpret_cast<const bf16x8*>(Qw + d0 * 16);
  unsigned kof[2], vof[2], rof;
#pragma unroll
  for (int u = 0; u < 2; ++u) { const int c = 2 * wid + u;
    { const int row = 4 * c + (lane >> 4), slot = lane & 15; kof[u] = (unsigned)(row * 256 + ((slot ^ (row & 15)) << 4)); }
    { const int sub = 2 * c + (lane >> 5), i5 = lane & 31, kk = (sub >> 2) * 8 + (i5 >> 2), col = (sub & 3) * 32 + (i5 & 3) * 8, k = (kk & ~0xC) | ((kk & 4) << 1) | ((kk & 8) >> 1); vof[u] = (unsigned)(k * 256 + col * 2); } }
  { const int row = 8 * wid + (lane >> 3), slot = lane & 7; rof = (unsigned)(row * 128 + ((slot ^ ((row >> 1) & 7)) << 4)); }
  const int wchunk = wid >> 1, t0 = 4 * qb, NT = 4 * qb + 4;
  const LAS unsigned char* ldsb = (const LAS unsigned char*)lds;
#define DMA(tile, st) do { const char* kp = (const char*)Kh + (size_t)(tile) * (KVBLK * 256); const char* vp = (const char*)Vh + (size_t)(tile) * (KVBLK * 256); const char* rp = (const char*)Rh + (size_t)(tile) * (KVBLK * 128); \
    LAS unsigned char* sb = (LAS unsigned char*)ldsb + (st) * STG; \
    __builtin_amdgcn_global_load_lds((const unsigned*)(vp + vof[0]), (LAS unsigned*)(sb + (2 * wid) * 1024), 16, 0, 0); __builtin_amdgcn_global_load_lds((const unsigned*)(vp + vof[1]), (LAS unsigned*)(sb + (2 * wid + 1) * 1024), 16, 0, 0); \
    __builtin_amdgcn_global_load_lds((const unsigned*)(kp + kof[0]), (LAS unsigned*)(sb + SHM_V + (2 * wid) * 1024), 16, 0, 0); __builtin_amdgcn_global_load_lds((const unsigned*)(kp + kof[1]), (LAS unsigned*)(sb + SHM_V + (2 * wid + 1) * 1024), 16, 0, 0); \
    __builtin_amdgcn_global_load_lds((const unsigned*)(rp + rof), (LAS unsigned*)(sb + SHM_V + SHM_K + wid * 1024), 16, 0, 0); } while (0)
#define RESC(a) do { if (__any((a) < 1.f)) { if (hi == 0) al_l[r32] = (a); asm volatile("s_waitcnt lgkmcnt(0)" ::: "memory"); \
    _Pragma("unroll") for (int d = 0; d < 4; ++d) _Pragma("unroll") for (int r = 0; r < 16; ++r) o[d][r] *= al_l[crow(r, hi)]; } } while (0)
#define MASKED(j) (((j) - t0) > wchunk)
  f32x16 p0, p1; bf16x8 pa0, pa1, pa2, pa3;
  DMA(0, 0); DMA(1, 1);
  asm volatile("s_waitcnt vmcnt(5)" ::: "memory"); __builtin_amdgcn_s_barrier(); asm volatile("" ::: "memory");
  int st = 0;
#pragma unroll 1
  for (int j = 0; j < NT; ++j) {
    const bool more = (j + 2 < NT);
    if (more) { const int st2 = (st >= 1) ? st - 1 : 2; DMA(j + 2, st2); }
    char* sb = lds + st * STG;
    if (!MASKED(j)) {
      SBAR(); qkt(p0, p1, sb + SHM_V, sb + SHM_V + SHM_K, qr, r32, hi, false);
      softmax_nomax(p0, p1, l_reg, pa0, pa1, pa2, pa3); SBAR();
      pv_pipe(o, (int)(uintptr_t)sb + v_rd_base(lane), pa0, pa1, pa2, pa3);
    }
    if (more) asm volatile("s_waitcnt vmcnt(5)" ::: "memory"); else asm volatile("s_waitcnt vmcnt(0)" ::: "memory");
    __builtin_amdgcn_s_barrier(); asm volatile("" ::: "memory");
    st = (st == 2) ? 0 : st + 1;
  }
  { auto rr = __builtin_amdgcn_permlane32_swap(__float_as_uint(l_reg), __float_as_uint(l_reg), false, false); l_reg = __uint_as_float(rr[0]) + __uint_as_float(rr[1]); }
  if (hi == 0) li_l[r32] = l_reg; asm volatile("s_waitcnt lgkmcnt(0)" ::: "memory");
  float rli[16];
#pragma unroll
  for (int r = 0; r < 16; ++r) rli[r] = __builtin_amdgcn_rcpf(li_l[crow(r, hi)]);
  float* Ow = Ob + (long)(wid * QBLK) * LDO;
#pragma unroll
  for (int r = 0; r < 16; ++r) { int orow = crow(r, hi);
#pragma unroll
    for (int d0 = 0; d0 < 4; ++d0) Ow[(long)orow * LDO + d0 * 32 + r32] = o[d0][r] * rli[r]; }
#undef DMA
#undef RESC
#undef MASKED
}

constexpr int S8_V = 16384, S8_K = 8192, S8_R = 4096, STG8 = S8_V + S8_K + S8_R, OFF_WS8 = 3 * STG8;
#define KS8(row, b) ((row) * 128 + ((b) ^ ((((row) >> 1) & 7) << 4)))
#define RS8(row, b) ((row) * 64 + ((b) ^ ((((row) >> 2) & 3) << 4)))
typedef int v8i_a __attribute__((ext_vector_type(8)));
typedef int v4i_a __attribute__((ext_vector_type(4)));
__device__ __forceinline__ v8i_a ld32(const char* p0, const char* p1) { const v4i_a a = *reinterpret_cast<const v4i_a*>(p0), b = *reinterpret_cast<const v4i_a*>(p1); return __builtin_shufflevector(a, b, 0, 1, 2, 3, 4, 5, 6, 7); }
__device__ __forceinline__ void qkt8(f32x16& p0, f32x16& p1, const char* Ks, const char* Rs, const v8i_a* qf, int r32, int hi, float init = 0.f) {
#pragma unroll
  for (int r = 0; r < 16; ++r) { p0[r] = init; p1[r] = init; }
#pragma unroll
  for (int s = 0; s < 2; ++s) { const int b0 = 64 * s + 32 * hi;
    const v8i_a a0 = ld32(Ks + KS8(r32, b0), Ks + KS8(r32, b0 + 16)), a1 = ld32(Ks + KS8(32 + r32, b0), Ks + KS8(32 + r32, b0 + 16));
    p0 = __builtin_amdgcn_mfma_scale_f32_32x32x64_f8f6f4(a0, qf[s], p0, 0, 0, 0, 0, 0, 0);
    p1 = __builtin_amdgcn_mfma_scale_f32_32x32x64_f8f6f4(a1, qf[s], p1, 0, 0, 0, 0, 0, 0); }
  { const int b0 = 32 * hi;
    const v8i_a a0 = ld32(Rs + RS8(r32, b0), Rs + RS8(r32, b0 + 16)), a1 = ld32(Rs + RS8(32 + r32, b0), Rs + RS8(32 + r32, b0 + 16));
    p0 = __builtin_amdgcn_mfma_scale_f32_32x32x64_f8f6f4(a0, qf[2], p0, 0, 0, 0, 0, 0, 0);
    p1 = __builtin_amdgcn_mfma_scale_f32_32x32x64_f8f6f4(a1, qf[2], p1, 0, 0, 0, 0, 0, 0); }
}
__device__ __forceinline__ void attn_block8(const unsigned char* __restrict__ Qb, const unsigned char* __restrict__ Kh, const bf16_t* __restrict__ Vh, const unsigned char* __restrict__ Rh,
                                            float* __restrict__ Ob, int qb, char* lds) {
  const int tid = threadIdx.x, wid = __builtin_amdgcn_readfirstlane(tid >> 6), lane = tid & 63, r32 = lane & 31, hi = lane >> 5;
  float* ws = (float*)(lds + OFF_WS8) + wid * 64; float* li_l = ws;
  float l_reg = 0; f32x16 o[4] = {}; v8i_a qf[3];
  { const unsigned char* Qw = Qb + (long)(wid * QBLK + r32) * 192 + 32 * hi;
#pragma unroll
    for (int s = 0; s < 3; ++s) { const v4i_a a = *reinterpret_cast<const v4i_a*>(Qw + 64 * s), b = *reinterpret_cast<const v4i_a*>(Qw + 64 * s + 16); qf[s] = __builtin_shufflevector(a, b, 0, 1, 2, 3, 4, 5, 6, 7); } }
  unsigned vof[2], kof, rof;
#pragma unroll
  for (int u = 0; u < 2; ++u) { const int c = 2 * wid + u;
    const int sub = 2 * c + (lane >> 5), i5 = lane & 31, kk = (sub >> 2) * 8 + (i5 >> 2), col = (sub & 3) * 32 + (i5 & 3) * 8, k = (kk & ~0xC) | ((kk & 4) << 1) | ((kk & 8) >> 1); vof[u] = (unsigned)(k * 256 + col * 2); }
  { const int row = 8 * wid + (lane >> 3), slot = lane & 7; kof = (unsigned)(row * 128 + ((slot ^ ((row >> 1) & 7)) << 4)); }
  { const int row = 16 * (wid & 3) + (lane >> 2), slot = lane & 3; rof = (unsigned)(row * 64 + ((slot ^ ((row >> 2) & 3)) << 4)); }
  const int wchunk = wid >> 1, t0 = 4 * qb, NT = 4 * qb + 4;
  const LAS unsigned char* ldsb = (const LAS unsigned char*)lds;
#define DMA8(tile, st) do { const char* kp = (const char*)Kh + (size_t)(tile) * (KVBLK * 128); const char* vp = (const char*)Vh + (size_t)(tile) * (KVBLK * 256); const char* rp = (const char*)Rh + (size_t)(tile) * (KVBLK * 64); \
    LAS unsigned char* sb_ = (LAS unsigned char*)ldsb + (st) * STG8; \
    __builtin_amdgcn_global_load_lds((const unsigned*)(vp + vof[0]), (LAS unsigned*)(sb_ + (2 * wid) * 1024), 16, 0, 0); __builtin_amdgcn_global_load_lds((const unsigned*)(vp + vof[1]), (LAS unsigned*)(sb_ + (2 * wid + 1) * 1024), 16, 0, 0); \
    __builtin_amdgcn_global_load_lds((const unsigned*)(kp + kof), (LAS unsigned*)(sb_ + S8_V + wid * 1024), 16, 0, 0); \
    __builtin_amdgcn_global_load_lds((const unsigned*)(rp + rof), (LAS unsigned*)(sb_ + S8_V + S8_K + (wid & 3) * 1024), 16, 0, 0); } while (0)
#define MASKED(j) (((j) - t0) > wchunk)
  f32x16 p0, p1; bf16x8 pa0, pa1, pa2, pa3;
  DMA8(0, 0); DMA8(1, 1);
  asm volatile("s_waitcnt vmcnt(4)" ::: "memory"); __builtin_amdgcn_s_barrier(); asm volatile("" ::: "memory");
  int st = 0;
#pragma unroll 1
  for (int j = 0; j < NT; ++j) {
    const bool more = (j + 2 < NT);
    if (more) { const int st2 = (st >= 1) ? st - 1 : 2; DMA8(j + 2, st2); }
    char* sb = lds + st * STG8;
    if (!MASKED(j)) {
      SBAR(); qkt8(p0, p1, sb + S8_V, sb + S8_V + S8_K, qf, r32, hi);
      softmax_nomax(p0, p1, l_reg, pa0, pa1, pa2, pa3); SBAR();
      pv_pipe(o, (int)(uintptr_t)sb + v_rd_base(lane), pa0, pa1, pa2, pa3);
    }
    if (more) asm volatile("s_waitcnt vmcnt(4)" ::: "memory"); else asm volatile("s_waitcnt vmcnt(0)" ::: "memory");
    __builtin_amdgcn_s_barrier(); asm volatile("" ::: "memory");
    st = (st == 2) ? 0 : st + 1;
  }
  { auto rr = __builtin_amdgcn_permlane32_swap(__float_as_uint(l_reg), __float_as_uint(l_reg), false, false); l_reg = __uint_as_float(rr[0]) + __uint_as_float(rr[1]); }
  if (hi == 0) li_l[r32] = l_reg; asm volatile("s_waitcnt lgkmcnt(0)" ::: "memory");
  float rli[16];
#pragma unroll
  for (int r = 0; r < 16; ++r) rli[r] = __builtin_amdgcn_rcpf(li_l[crow(r, hi)]);
  float* Ow = Ob + (long)(wid * QBLK) * LDO;
#pragma unroll
  for (int r = 0; r < 16; ++r) { int orow = crow(r, hi);
#pragma unroll
    for (int d0 = 0; d0 < 4; ++d0) Ow[(long)orow * LDO + d0 * 32 + r32] = o[d0][r] * rli[r]; }
#undef DMA8
#undef MASKED
}

constexpr int T8_V = 8192, T8_K = 8192, T8_R = 4096, STG9 = T8_V + T8_K + T8_R, OFF_WS9 = 3 * STG9;
#define VS8(d, b) ((d) * 64 + ((b) ^ ((((d) >> 2) & 3) << 4)))
template <int ABL = 0> __device__ __forceinline__ void attn_block9(const unsigned char* __restrict__ Qb, const unsigned char* __restrict__ Kh, const unsigned char* __restrict__ Vt, const unsigned char* __restrict__ Rh,
                                            float* __restrict__ Ob, int qb, char* lds) {
  const int tid = threadIdx.x, wid = __builtin_amdgcn_readfirstlane(tid >> 6), lane = tid & 63, r32 = lane & 31, hi = lane >> 5;
  float* ws = (float*)(lds + OFF_WS9) + wid * 64; float* li_l = ws;
  float l_reg = 0; f32x16 o[4] = {}; v8i_a qf[3];
  { const unsigned char* Qw = Qb + (long)(wid * QBLK + r32) * 192 + 32 * hi;
#pragma unroll
    for (int s = 0; s < 3; ++s) { const v4i_a a = *reinterpret_cast<const v4i_a*>(Qw + 64 * s), b = *reinterpret_cast<const v4i_a*>(Qw + 64 * s + 16); qf[s] = __builtin_shufflevector(a, b, 0, 1, 2, 3, 4, 5, 6, 7); } }
  unsigned kof, rof; const unsigned vof = (unsigned)(wid * 1024 + lane * 16);
  { const int row = 8 * wid + (lane >> 3), slot = lane & 7; kof = (unsigned)(row * 128 + ((slot ^ ((row >> 1) & 7)) << 4)); }
  { const int row = 16 * (wid & 3) + (lane >> 2), slot = lane & 3; rof = (unsigned)(row * 64 + ((slot ^ ((row >> 2) & 3)) << 4)); }
  const int wchunk = wid >> 1, t0 = 4 * qb, NT = 4 * qb + 4;
  const LAS unsigned char* ldsb = (const LAS unsigned char*)lds;
#define DMA9(tile, st) do { const char* kp = (const char*)Kh + (size_t)(tile) * (KVBLK * 128); const char* vp = (const char*)Vt + (size_t)(tile) * 8192; const char* rp = (const char*)Rh + (size_t)(tile) * (KVBLK * 64); \
    LAS unsigned char* sb_ = (LAS unsigned char*)ldsb + (st) * STG9; \
    __builtin_amdgcn_global_load_lds((const unsigned*)(vp + vof), (LAS unsigned*)(sb_ + wid * 1024), 16, 0, 0); \
    __builtin_amdgcn_global_load_lds((const unsigned*)(kp + kof), (LAS unsigned*)(sb_ + T8_V + wid * 1024), 16, 0, 0); \
    __builtin_amdgcn_global_load_lds((const unsigned*)(rp + rof), (LAS unsigned*)(sb_ + T8_V + T8_K + (wid & 3) * 1024), 16, 0, 0); } while (0)
#define MASKED(j) (((j) - t0) > wchunk)
  f32x16 p0, p1; v8i_a P8 = {0, 0, 0, 0, 0, 0, 0, 0};
#ifndef ATT_DEPHASE
#define ATT_DEPHASE 0
#endif
#if ATT_DEPHASE
  const int half = wid >> 2;
  DMA9(0, 0); DMA9(1, 1);
  asm volatile("s_waitcnt vmcnt(3)" ::: "memory"); __builtin_amdgcn_s_barrier(); asm volatile("" ::: "memory");
  f32x16 cinit;
#pragma unroll
  for (int r = 0; r < 16; ++r) cinit[r] = -2.0f;
  asm volatile("" : "+v"(cinit));
  if (half == 1) { __builtin_amdgcn_s_barrier(); asm volatile("" ::: "memory"); }
  int st = 0;
#pragma unroll 1
  for (int j = 0; j < NT; ++j) {
    char* sb = lds + st * STG9; const bool live = !MASKED(j);
    v8i_a vf[4];
    if (live) {
      const char* Ks = sb + T8_V; const char* Rs = sb + T8_V + T8_K;
      SBAR();
      v8i_a kf[6];
#pragma unroll
      for (int s2 = 0; s2 < 2; ++s2) { const int b0 = 64 * s2 + 32 * hi;
        kf[2 * s2] = ld32(Ks + KS8(r32, b0), Ks + KS8(r32, b0 + 16)); kf[2 * s2 + 1] = ld32(Ks + KS8(32 + r32, b0), Ks + KS8(32 + r32, b0 + 16)); }
      kf[4] = ld32(Rs + RS8(r32, 32 * hi), Rs + RS8(r32, 32 * hi + 16)); kf[5] = ld32(Rs + RS8(32 + r32, 32 * hi), Rs + RS8(32 + r32, 32 * hi + 16));
      SBAR();
      p0 = __builtin_amdgcn_mfma_scale_f32_32x32x64_f8f6f4(kf[0], qf[0], cinit, 0, 0, 0, 0, 0, 0);
      p1 = __builtin_amdgcn_mfma_scale_f32_32x32x64_f8f6f4(kf[1], qf[0], cinit, 0, 0, 0, 0, 0, 0);
      p0 = __builtin_amdgcn_mfma_scale_f32_32x32x64_f8f6f4(kf[2], qf[1], p0, 0, 0, 0, 0, 0, 0);
      p1 = __builtin_amdgcn_mfma_scale_f32_32x32x64_f8f6f4(kf[3], qf[1], p1, 0, 0, 0, 0, 0, 0);
      p0 = __builtin_amdgcn_mfma_scale_f32_32x32x64_f8f6f4(kf[4], qf[2], p0, 0, 0, 0, 0, 0, 0);
      p1 = __builtin_amdgcn_mfma_scale_f32_32x32x64_f8f6f4(kf[5], qf[2], p1, 0, 0, 0, 0, 0, 0);
      SBAR();
#pragma unroll
      for (int d0 = 0; d0 < 4; ++d0) { const int d = d0 * 32 + r32; vf[d0] = ld32(sb + VS8(d, 32 * hi), sb + VS8(d, 32 * hi + 16)); }
      SBAR();
      float ps = 0;
#pragma unroll
      for (int r = 0; r < 16; ++r) { p0[r] = fminf(__builtin_amdgcn_exp2f(p0[r]), 448.0f); ps += p0[r]; }
      l_reg += ps;
      P8[0] = (int)pk4_fp8(p0[0], p0[1], p0[2], p0[3]); P8[1] = (int)pk4_fp8(p0[4], p0[5], p0[6], p0[7]); P8[2] = (int)pk4_fp8(p0[8], p0[9], p0[10], p0[11]); P8[3] = (int)pk4_fp8(p0[12], p0[13], p0[14], p0[15]);
      SBAR(); }
    asm volatile("s_waitcnt vmcnt(0)" ::: "memory");
    __builtin_amdgcn_s_barrier(); asm volatile("" ::: "memory");
    if (j + 2 < NT) { const int st2 = (st >= 1) ? st - 1 : 2; DMA9(j + 2, st2); }
    if (live) {
      SBAR();
      float ps = 0;
#pragma unroll
      for (int r = 0; r < 16; ++r) { p1[r] = fminf(__builtin_amdgcn_exp2f(p1[r]), 448.0f); ps += p1[r]; }
      l_reg += ps;
      P8[4] = (int)pk4_fp8(p1[0], p1[1], p1[2], p1[3]); P8[5] = (int)pk4_fp8(p1[4], p1[5], p1[6], p1[7]); P8[6] = (int)pk4_fp8(p1[8], p1[9], p1[10], p1[11]); P8[7] = (int)pk4_fp8(p1[12], p1[13], p1[14], p1[15]);
      SBAR();
#pragma unroll
      for (int d0 = 0; d0 < 4; ++d0) o[d0] = __builtin_amdgcn_mfma_scale_f32_32x32x64_f8f6f4(P8, vf[d0], o[d0], 0, 0, 0, 0, 0, 0);
      SBAR(); }
    __builtin_amdgcn_s_barrier(); asm volatile("" ::: "memory");
    st = (st == 2) ? 0 : st + 1;
  }
  if (half == 0) { __builtin_amdgcn_s_barrier(); asm volatile("" ::: "memory"); }
#else
#define DMA9V(tile, st) __builtin_amdgcn_global_load_lds((const unsigned*)((const char*)Vt + (size_t)(tile) * 8192 + vof), (LAS unsigned*)((LAS unsigned char*)ldsb + (st) * STG9 + wid * 1024), 16, 0, 0)
#define DMA9K(tile, st) __builtin_amdgcn_global_load_lds((const unsigned*)((const char*)Kh + (size_t)(tile) * (KVBLK * 128) + kof), (LAS unsigned*)((LAS unsigned char*)ldsb + (st) * STG9 + T8_V + wid * 1024), 16, 0, 0)
#define DMA9R(tile, st) __builtin_amdgcn_global_load_lds((const unsigned*)((const char*)Rh + (size_t)(tile) * (KVBLK * 64) + rof), (LAS unsigned*)((LAS unsigned char*)ldsb + (st) * STG9 + T8_V + T8_K + (wid & 3) * 1024), 16, 0, 0)
  const bool rdma = (wid < 4);
  DMA9V(0, 0); DMA9K(0, 0); if (rdma) DMA9R(0, 0);
  DMA9V(1, 1); DMA9K(1, 1); if (rdma) DMA9R(1, 1);
  if (rdma) asm volatile("s_waitcnt vmcnt(3)" ::: "memory"); else asm volatile("s_waitcnt vmcnt(2)" ::: "memory");
  __builtin_amdgcn_s_barrier(); asm volatile("" ::: "memory");
  f32x16 osum = {};
  v8i_a ones = {0x38383838, 0x38383838, 0x38383838, 0x38383838, 0x38383838, 0x38383838, 0x38383838, 0x38383838};
  asm volatile("" : "+v"(ones));
  int st = 0, j = 0;
#pragma unroll 1
  for (; j < t0; ++j) {
    const int st2 = (st >= 1) ? st - 1 : 2;
    if constexpr (ABL != 2) DMA9V(j + 2, st2);
    char* sb = lds + st * STG9;
      { const char* Ks = sb + T8_V; const char* Rs = sb + T8_V + T8_K;
      SBAR();
      v8i_a kf[6];
#pragma unroll
      for (int s2 = 0; s2 < 2; ++s2) { const int b0 = 64 * s2 + 32 * hi;
        kf[2 * s2] = ld32(Ks + KS8(r32, b0), Ks + KS8(r32, b0 + 16)); kf[2 * s2 + 1] = ld32(Ks + KS8(32 + r32, b0), Ks + KS8(32 + r32, b0 + 16)); }
      kf[4] = ld32(Rs + RS8(r32, 32 * hi), Rs + RS8(r32, 32 * hi + 16)); kf[5] = ld32(Rs + RS8(32 + r32, 32 * hi), Rs + RS8(32 + r32, 32 * hi + 16));
      SBAR();
#pragma unroll
      for (int r = 0; r < 16; ++r) { p0[r] = 40.25f; p1[r] = 40.25f; }
      p0 = __builtin_amdgcn_mfma_scale_f32_32x32x64_f8f6f4(kf[0], qf[0], p0, 0, 0, 0, 0, 0, 0);
      p1 = __builtin_amdgcn_mfma_scale_f32_32x32x64_f8f6f4(kf[1], qf[0], p1, 0, 0, 0, 0, 0, 0);
      p0 = __builtin_amdgcn_mfma_scale_f32_32x32x64_f8f6f4(kf[2], qf[1], p0, 0, 0, 0, 0, 0, 0);
      p1 = __builtin_amdgcn_mfma_scale_f32_32x32x64_f8f6f4(kf[3], qf[1], p1, 0, 0, 0, 0, 0, 0);
      p0 = __builtin_amdgcn_mfma_scale_f32_32x32x64_f8f6f4(kf[4], qf[2], p0, 0, 0, 0, 0, 0, 0);
      p1 = __builtin_amdgcn_mfma_scale_f32_32x32x64_f8f6f4(kf[5], qf[2], p1, 0, 0, 0, 0, 0, 0);
      SBAR();
      if constexpr (ABL != 2) { if (true) DMA9K(j + 2, st2); }
      v8i_a vf[4];
#pragma unroll
      for (int d0 = 0; d0 < 4; ++d0) { const int d = d0 * 32 + r32; vf[d0] = ld32(sb + VS8(d, 32 * hi), sb + VS8(d, 32 * hi + 16)); }
      SBAR();
#pragma unroll
      for (int k = 0; k < 4; ++k) { unsigned w0, w1; asm volatile("" : "=v"(w0), "=v"(w1));
#pragma unroll
        for (int b = 0; b < 4; ++b) { w0 = __builtin_amdgcn_cvt_pk_u8_f32(__builtin_amdgcn_fmed3f(p0[4 * k + b], 0.0f, 126.0f), b, w0); w1 = __builtin_amdgcn_cvt_pk_u8_f32(__builtin_amdgcn_fmed3f(p1[4 * k + b], 0.0f, 126.0f), b, w1); }
        P8[k] = (int)w0; P8[4 + k] = (int)w1; }
      SBAR();
      if constexpr (ABL != 2) { if (true && rdma) DMA9R(j + 2, st2); }
#pragma unroll
      for (int d0 = 0; d0 < 4; ++d0) o[d0] = __builtin_amdgcn_mfma_scale_f32_32x32x64_f8f6f4(P8, vf[d0], o[d0], 0, 0, 0, 0, 0, 0);
      osum = __builtin_amdgcn_mfma_scale_f32_32x32x64_f8f6f4(P8, ones, osum, 0, 0, 0, 0, 0, 0); }
    if (rdma) asm volatile("s_waitcnt vmcnt(3)" ::: "memory"); else asm volatile("s_waitcnt vmcnt(2)" ::: "memory");
    __builtin_amdgcn_s_barrier(); asm volatile("" ::: "memory");
    st = (st == 2) ? 0 : st + 1;
  }
#pragma unroll 1
  for (; j < NT; ++j) {
    const bool more = (j + 2 < NT); const int st2 = (st >= 1) ? st - 1 : 2;
    if constexpr (ABL != 2) { if (more) DMA9V(j + 2, st2); }
    char* sb = lds + st * STG9;
    if (!MASKED(j)) {
      { const char* Ks = sb + T8_V; const char* Rs = sb + T8_V + T8_K;
      SBAR();
      v8i_a kf[6];
#pragma unroll
      for (int s2 = 0; s2 < 2; ++s2) { const int b0 = 64 * s2 + 32 * hi;
        kf[2 * s2] = ld32(Ks + KS8(r32, b0), Ks + KS8(r32, b0 + 16)); kf[2 * s2 + 1] = ld32(Ks + KS8(32 + r32, b0), Ks + KS8(32 + r32, b0 + 16)); }
      kf[4] = ld32(Rs + RS8(r32, 32 * hi), Rs + RS8(r32, 32 * hi + 16)); kf[5] = ld32(Rs + RS8(32 + r32, 32 * hi), Rs + RS8(32 + r32, 32 * hi + 16));
      SBAR();
#pragma unroll
      for (int r = 0; r < 16; ++r) { p0[r] = 40.25f; p1[r] = 40.25f; }
      p0 = __builtin_amdgcn_mfma_scale_f32_32x32x64_f8f6f4(kf[0], qf[0], p0, 0, 0, 0, 0, 0, 0);
      p1 = __builtin_amdgcn_mfma_scale_f32_32x32x64_f8f6f4(kf[1], qf[0], p1, 0, 0, 0, 0, 0, 0);
      p0 = __builtin_amdgcn_mfma_scale_f32_32x32x64_f8f6f4(kf[2], qf[1], p0, 0, 0, 0, 0, 0, 0);
      p1 = __builtin_amdgcn_mfma_scale_f32_32x32x64_f8f6f4(kf[3], qf[1], p1, 0, 0, 0, 0, 0, 0);
      p0 = __builtin_amdgcn_mfma_scale_f32_32x32x64_f8f6f4(kf[4], qf[2], p0, 0, 0, 0, 0, 0, 0);
      p1 = __builtin_amdgcn_mfma_scale_f32_32x32x64_f8f6f4(kf[5], qf[2], p1, 0, 0, 0, 0, 0, 0);
      SBAR();
      if constexpr (ABL != 2) { if (more) DMA9K(j + 2, st2); }
      v8i_a vf[4];
#pragma unroll
      for (int d0 = 0; d0 < 4; ++d0) { const int d = d0 * 32 + r32; vf[d0] = ld32(sb + VS8(d, 32 * hi), sb + VS8(d, 32 * hi + 16)); }
      SBAR();
#pragma unroll
      for (int k = 0; k < 4; ++k) { unsigned w0, w1; asm volatile("" : "=v"(w0), "=v"(w1));
#pragma unroll
        for (int b = 0; b < 4; ++b) { w0 = __builtin_amdgcn_cvt_pk_u8_f32(__builtin_amdgcn_fmed3f(p0[4 * k + b], 0.0f, 126.0f), b, w0); w1 = __builtin_amdgcn_cvt_pk_u8_f32(__builtin_amdgcn_fmed3f(p1[4 * k + b], 0.0f, 126.0f), b, w1); }
        P8[k] = (int)w0; P8[4 + k] = (int)w1; }
      SBAR();
      if constexpr (ABL != 2) { if (more && rdma) DMA9R(j + 2, st2); }
#pragma unroll
      for (int d0 = 0; d0 < 4; ++d0) o[d0] = __builtin_amdgcn_mfma_scale_f32_32x32x64_f8f6f4(P8, vf[d0], o[d0], 0, 0, 0, 0, 0, 0);
      osum = __builtin_amdgcn_mfma_scale_f32_32x32x64_f8f6f4(P8, ones, osum, 0, 0, 0, 0, 0, 0); }
    } else {
      if constexpr (ABL != 2) { if (more) { DMA9K(j + 2, st2); if (rdma) DMA9R(j + 2, st2); } }
    }
    if (more) { if (rdma) asm volatile("s_waitcnt vmcnt(3)" ::: "memory"); else asm volatile("s_waitcnt vmcnt(2)" ::: "memory"); } else asm volatile("s_waitcnt vmcnt(0)" ::: "memory");
    __builtin_amdgcn_s_barrier(); asm volatile("" ::: "memory");
    st = (st == 2) ? 0 : st + 1;
  }
#undef DMA9V
#undef DMA9K
#undef DMA9R
#endif
#if ATT_DEPHASE
  { auto rr = __builtin_amdgcn_permlane32_swap(__float_as_uint(l_reg), __float_as_uint(l_reg), false, false); l_reg = __uint_as_float(rr[0]) + __uint_as_float(rr[1]); }
  if (hi == 0) li_l[r32] = l_reg; asm volatile("s_waitcnt lgkmcnt(0)" ::: "memory");
  float rli[16];
#pragma unroll
  for (int r = 0; r < 16; ++r) rli[r] = __builtin_amdgcn_rcpf(li_l[crow(r, hi)]);
#else
  float rli[16];
#pragma unroll
  for (int r = 0; r < 16; ++r) rli[r] = __builtin_amdgcn_rcpf(osum[r]);
  (void)li_l; (void)l_reg;
#endif
  float* Ow = Ob + (long)(wid * QBLK) * LDO;
  if (ABL == 0 || qb < 0) {
#pragma unroll
  for (int r = 0; r < 16; ++r) { int orow = crow(r, hi);
#pragma unroll
    for (int d0 = 0; d0 < 4; ++d0) Ow[(long)orow * LDO + d0 * 32 + r32] = o[d0][r] * rli[r]; } }
#undef DMA9
#undef MASKED
}
}

struct Ctx { int tid, lane, wave, vcu, G; LAS unsigned char* lds; };
#define LDS_FENCE() asm volatile("s_waitcnt lgkmcnt(0)" ::: "memory")

__device__ __forceinline__ void p0_mod_chunk(const Ctx& c, int chunk, const float* __restrict__ cvec, const float* __restrict__ w_ada, const float* __restrict__ b_ada, float* __restrict__ MOD) {
    const int n0 = chunk * 64, ncg = c.tid & 15, ks = c.tid >> 4;
    f32x4 a0 = {0.f, 0.f, 0.f, 0.f}, a1 = {0.f, 0.f, 0.f, 0.f};
#pragma unroll 8
    for (int k = ks; k < 2048; k += 32) {
        const f32x4 w = *(const f32x4*)(w_ada + (size_t)k * 12288 + n0 + 4 * ncg);
        const float c0 = cvec[k], c1 = cvec[2048 + k];
        const float s0 = c0 * sigmoidf_(c0), s1 = c1 * sigmoidf_(c1);
        a0 += s0 * w; a1 += s1 * w;
    }
    LAS float* red = (LAS float*)c.lds;
    *(LAS f32x4*)(red + (ks * 2 + 0) * 64 + 4 * ncg) = a0; *(LAS f32x4*)(red + (ks * 2 + 1) * 64 + 4 * ncg) = a1;
    __syncthreads();
    if (c.tid < 128) { const int b = c.tid >> 6, n = c.tid & 63; float s = 0.f;
#pragma unroll 8
        for (int k2 = 0; k2 < 32; ++k2) s += red[(k2 * 2 + b) * 64 + n];
        MOD[b * 12288 + n0 + n] = s + b_ada[n0 + n]; }
    __syncthreads();
}
__device__ __forceinline__ void p0_kc_item(const Ctx& c, int item, const float* __restrict__ A_re, const float* __restrict__ A_im, const float* __restrict__ B_re, const float* __restrict__ B_im,
                                           const float* __restrict__ C_re, const float* __restrict__ C_im, const float* __restrict__ Dv, const float* __restrict__ log_dt, float* __restrict__ KC, float* __restrict__ BB) {
    const int g = item >> 2, dq = item & 3;
    LAS float* Cre = (LAS float*)c.lds; LAS float* Cim = Cre + 1024; LAS float* Bre = Cim + 1024; LAS float* Bim = Bre + 1024; LAS float* Are = Bim + 1024; LAS float* Aim = Are + 1024;
    const float dt = expf(log_dt[g]);
    for (int idx = c.tid; idx < 1024; idx += 512) {
        { const int h = idx >> 6, p = idx & 63; Cre[idx] = C_re[(g * 16 + h) * 64 + p]; Cim[idx] = C_im[(g * 16 + h) * 64 + p]; }
        { const int p = idx >> 4, hh = idx & 15; const float are = A_re[g * 64 + p], aim = A_im[g * 64 + p];
          float cs, sn; sincos_d((double)dt * (double)aim, cs, sn); const float ex = expf(dt * are);
          const float nr = ex * cs - 1.0f, ni = ex * sn, den = are * are + aim * aim;
          const float cbr = (nr * are + ni * aim) / den, cbi = (ni * are - nr * aim) / den;
          const float br = B_re[(g * 64 + p) * 16 + hh], bi = B_im[(g * 64 + p) * 16 + hh];
          const float bbr = cbr * br - cbi * bi, bbi = cbr * bi + cbi * br;
          Bre[idx] = bbr; Bim[idx] = bbi;
          if (dq == 0) { BB[((size_t)(g * 64 + p) * 16 + hh) * 2] = bbr; BB[((size_t)(g * 64 + p) * 16 + hh) * 2 + 1] = bbi; } }
        { const int dd = idx >> 6, p = idx & 63, d = dq * 16 + dd; const float are = A_re[g * 64 + p], aim = A_im[g * 64 + p];
          float cs, sn; sincos_d((double)d * (double)dt * (double)aim, cs, sn); const float ex = expf((float)d * dt * are);
          Are[idx] = ex * cs; Aim[idx] = ex * sn; }
    }
    __syncthreads();
#pragma unroll 1
    for (int r = 0; r < 8; ++r) { const int e = c.tid + 512 * r, dd = e >> 8, h = (e >> 4) & 15, hh = e & 15; float s = 0.f;
#pragma unroll 8
        for (int p = 0; p < 64; ++p) { const float ar = Are[dd * 64 + p], ai = Aim[dd * 64 + p], br = Bre[p * 16 + hh], bi = Bim[p * 16 + hh];
            const float er = ar * br - ai * bi, ei = ar * bi + ai * br; s += Cre[h * 64 + p] * er - Cim[h * 64 + p] * ei; }
        const int d = dq * 16 + dd; if (d == 0 && h == hh) s += Dv[g * 16 + h];
        KC[((size_t)(g * 64 + d) * 16 + h) * 16 + hh] = s; }
    __syncthreads();
}
template <int MAP> __device__ __forceinline__ int rowmap(int n) {
    if (MAP == 1) { const int h = n / 192, d = n - h * 192; return d < 128 ? h * 128 + d : 1024 + h * 64 + (d - 128); }
    if (MAP == 2) { const int j = n >> 1, s = n & 1; return (j >> 7) * 256 + s * 128 + (j & 127); }
    return n;
}
template <int MAP> __device__ __forceinline__ void tr_item(const float* __restrict__ W, int N, const float* __restrict__ kscale, bf16_t* __restrict__ WT, int ldt, int kb, int nb, int lane) {
    const int kgrp = lane >> 3, nc = lane & 7, k0 = kb * 64 + 8 * kgrp;
    f32x4 v[2][8];
#pragma unroll
    for (int nn = 0; nn < 2; ++nn)
#pragma unroll
        for (int i = 0; i < 8; ++i) v[nn][i] = *(const f32x4*)(W + (size_t)(k0 + i) * N + nb * 64 + 32 * nn + 4 * nc);
    float sc[8];
#pragma unroll
    for (int i = 0; i < 8; ++i) sc[i] = kscale ? kscale[k0 + i] : 1.0f;
#pragma unroll
    for (int nn = 0; nn < 2; ++nn)
#pragma unroll
        for (int j = 0; j < 4; ++j) { const int row = rowmap<MAP>(nb * 64 + 32 * nn + 4 * nc + j);
            u32x4 w; w.x = cvt_pk_bf16(v[nn][0][j] * sc[0], v[nn][1][j] * sc[1]); w.y = cvt_pk_bf16(v[nn][2][j] * sc[2], v[nn][3][j] * sc[3]);
            w.z = cvt_pk_bf16(v[nn][4][j] * sc[4], v[nn][5][j] * sc[5]); w.w = cvt_pk_bf16(v[nn][6][j] * sc[6], v[nn][7][j] * sc[7]);
            *(u32x4*)(WT + (size_t)row * ldt + k0) = w; }
}

struct RowRaw { f32x4 v[8]; };
__device__ __forceinline__ RowRaw hnorm_load(const float* __restrict__ xrow, int lane) { RowRaw r;
#pragma unroll
    for (int j = 0; j < 8; ++j) r.v[j] = __builtin_nontemporal_load((const f32x4*)(xrow + 4 * lane + 256 * j));
    return r; }
__device__ __forceinline__ float hnorm_proc(const RowRaw& r, bf16_t* __restrict__ hrow, const f32x4 (&fa)[8], const f32x4 (&fb)[8], int lane) {
    float ss = 0.f;
#pragma unroll
    for (int j = 0; j < 8; ++j) ss += (r.v[j][0] * r.v[j][0] + r.v[j][1] * r.v[j][1]) + (r.v[j][2] * r.v[j][2] + r.v[j][3] * r.v[j][3]);
    const float rstd = 1.0f / sqrtf(wave_sum(ss) * (1.0f / 2048.0f) + EPS);
#pragma unroll
    for (int j = 0; j < 8; ++j) { const f32x4 y = r.v[j] * rstd * fa[j] + fb[j]; u32x2 w; w.x = cvt_pk_bf16(y[0], y[1]); w.y = cvt_pk_bf16(y[2], y[3]);
        *(u32x2*)(hrow + 4 * lane + 256 * j) = w; }
    return rstd;
}
__device__ __forceinline__ float hnorm_row(const float* __restrict__ xrow, bf16_t* __restrict__ hrow, const f32x4 (&fa)[8], const f32x4 (&fb)[8], int lane) {
    const RowRaw r = hnorm_load(xrow, lane); return hnorm_proc(r, hrow, fa, fb, lane);
}

template <int MAP> __device__ __forceinline__ void tr_item8(const float* __restrict__ W, int N, unsigned char* __restrict__ WT, int ldt, int kb, int nb, int lane, const float* __restrict__ kscale = nullptr) {
    const int kgrp = lane >> 4, nc = lane & 15, k0 = kb * 128 + 32 * kgrp;
    f32x4 v[32];
#pragma unroll
    for (int i = 0; i < 32; ++i) v[i] = __builtin_nontemporal_load((const f32x4*)(W + (size_t)(k0 + i) * N + nb * 64 + 4 * nc));
    if (kscale) {
#pragma unroll
        for (int i = 0; i < 32; ++i) v[i] *= kscale[k0 + i]; }
#pragma unroll
    for (int j = 0; j < 4; ++j) { const int row = rowmap<MAP>(nb * 64 + 4 * nc + j);
#pragma unroll
        for (int hh = 0; hh < 2; ++hh) { const int q = 16 * hh;
            u32x4 w; w.x = pk4_fp8(v[q + 0][j] * W8_SCALE, v[q + 1][j] * W8_SCALE, v[q + 2][j] * W8_SCALE, v[q + 3][j] * W8_SCALE); w.y = pk4_fp8(v[q + 4][j] * W8_SCALE, v[q + 5][j] * W8_SCALE, v[q + 6][j] * W8_SCALE, v[q + 7][j] * W8_SCALE);
            w.z = pk4_fp8(v[q + 8][j] * W8_SCALE, v[q + 9][j] * W8_SCALE, v[q + 10][j] * W8_SCALE, v[q + 11][j] * W8_SCALE); w.w = pk4_fp8(v[q + 12][j] * W8_SCALE, v[q + 13][j] * W8_SCALE, v[q + 14][j] * W8_SCALE, v[q + 15][j] * W8_SCALE);
            *(u32x4*)(WT + (size_t)row * ldt + k0 + q) = w; } }
}
__device__ __forceinline__ float hnorm_row8(const float* __restrict__ xrow, unsigned char* __restrict__ hrow, const f32x4 (&fa)[8], const f32x4 (&fb)[8], int lane) {
    f32x4 v[8]; float ss = 0.f;
#pragma unroll
    for (int j = 0; j < 8; ++j) { v[j] = *(const f32x4*)(xrow + 4 * lane + 256 * j); ss += (v[j][0] * v[j][0] + v[j][1] * v[j][1]) + (v[j][2] * v[j][2] + v[j][3] * v[j][3]); }
    const float rstd = 1.0f / sqrtf(wave_sum(ss) * (1.0f / 2048.0f) + EPS);
#pragma unroll
    for (int j = 0; j < 8; ++j) { const f32x4 y = v[j] * rstd * fa[j] + fb[j]; *(unsigned*)(hrow + 4 * lane + 256 * j) = pk4_fp8(y[0], y[1], y[2], y[3]); }
    return rstd;
}

struct RowRawB { u32x4 w[4]; };
__device__ __forceinline__ RowRawB hnorm_b_load(const bf16_t* __restrict__ xrow, int lane) { RowRawB r;
#pragma unroll
    for (int j = 0; j < 4; ++j) r.w[j] = *(const u32x4*)(xrow + 8 * lane + 512 * j);
    return r; }
__device__ __forceinline__ float hnorm_b_proc(const RowRawB& r, unsigned char* __restrict__ hrow, const f32x4 (&fa)[4][2], const f32x4 (&fb)[4][2], int lane) {
    float v[4][8]; float ss = 0.f;
#pragma unroll
    for (int j = 0; j < 4; ++j) { const u32x4 w = r.w[j];
        v[j][0] = bflo(w[0]); v[j][1] = bfhi(w[0]); v[j][2] = bflo(w[1]); v[j][3] = bfhi(w[1]); v[j][4] = bflo(w[2]); v[j][5] = bfhi(w[2]); v[j][6] = bflo(w[3]); v[j][7] = bfhi(w[3]);
#pragma unroll
        for (int e = 0; e < 8; ++e) ss += v[j][e] * v[j][e]; }
    const float rstd = 1.0f / sqrtf(wave_sum(ss) * (1.0f / 2048.0f) + EPS);
#pragma unroll
    for (int j = 0; j < 4; ++j) { float y[8];
#pragma unroll
        for (int e = 0; e < 8; ++e) y[e] = v[j][e] * rstd * fa[j][e >> 2][e & 3] + fb[j][e >> 2][e & 3];
#if MOE_FP8
        u32x2 w; w.x = pk4_fp8(y[0], y[1], y[2], y[3]); w.y = pk4_fp8(y[4], y[5], y[6], y[7]); *(u32x2*)(hrow + 8 * lane + 512 * j) = w;
#else
        u32x4 w; w.x = cvt_pk_bf16(y[0], y[1]); w.y = cvt_pk_bf16(y[2], y[3]); w.z = cvt_pk_bf16(y[4], y[5]); w.w = cvt_pk_bf16(y[6], y[7]); *(u32x4*)((bf16_t*)hrow + 8 * lane + 512 * j) = w;
#endif
    }
    return rstd;
}

__device__ __forceinline__ void p4_carry_item(const Ctx& c, int item, const float* __restrict__ SEND, const float* __restrict__ A64, const float* __restrict__ A1024, bf16_t* __restrict__ AG) {
    const int g = item >> 2, b = (item >> 1) & 1, ph = item & 1, seg = c.tid >> 5, pl = c.tid & 31, p = ph * 32 + pl;
    const float ar = A64[(g * 64 + p) * 2], ai = A64[(g * 64 + p) * 2 + 1], qr = A1024[(g * 64 + p) * 2], qi = A1024[(g * 64 + p) * 2 + 1];
    float sre[16], sim[16];
#pragma unroll
    for (int i = 0; i < 16; ++i) { const size_t row = (size_t)(g * NCH + b * 256 + seg * 16 + i) * 128; sre[i] = SEND[row + p]; sim[i] = SEND[row + 64 + p]; }
    float lr = 0.f, li = 0.f;
#pragma unroll
    for (int i = 0; i < 16; ++i) { const float nr = ar * lr - ai * li + sre[i], ni = ar * li + ai * lr + sim[i]; lr = nr; li = ni; }
    LAS float* se = (LAS float*)c.lds;
    LAS float* ci = se + 1024;
    se[(seg * 32 + pl) * 2] = lr; se[(seg * 32 + pl) * 2 + 1] = li;
    __syncthreads();
    if (c.tid < 32) { float cr = 0.f, cim = 0.f;
#pragma unroll 1
        for (int s = 0; s < 16; ++s) { ci[(s * 32 + pl) * 2] = cr; ci[(s * 32 + pl) * 2 + 1] = cim; const float er = se[(s * 32 + pl) * 2], ei = se[(s * 32 + pl) * 2 + 1];
            const float nr = qr * cr - qi * cim + er, ni = qr * cim + qi * cr + ei; cr = nr; cim = ni; } }
    __syncthreads();
    float cr = ci[(seg * 32 + pl) * 2], cim = ci[(seg * 32 + pl) * 2 + 1];
#pragma unroll
    for (int i = 0; i < 16; ++i) { bf16_t* dst = AG + (size_t)(g * NCH + b * 256 + seg * 16 + i) * AGW; dst[p] = f2bf(cr); dst[64 + p] = f2bf(cim);
        const float nr = ar * cr - ai * cim + sre[i], ni = ar * cim + ai * cr + sim[i]; cr = nr; cim = ni; }
    __syncthreads();
}

constexpr float QSC = 0.07216878364870322f * 1.4426950408889634f;
constexpr float SQ8 = 0.3226727f;
constexpr float QMUL = ATT_FP8 ? (ATT_PV8 ? 8.0f * SQ8 : SQ8) : QSC, KMUL = ATT_FP8 ? SQ8 : 1.0f;
struct QkRaw { u32x4 zq; u32x2 zkv; unsigned zkr; u32x4 qn0, qn1, qr, kn0, kn1, v0, v1; f32x4 cq0, cq1, sq0, sq1; float ck, sk; };
struct QkGain { float qn[16], qr[8], kn[16], kr; };
__device__ __forceinline__ QkGain p4_gains(int lane, const float* __restrict__ q_nope_g, const float* __restrict__ q_rope_g, const float* __restrict__ k_nope_g, const float* __restrict__ k_rope_g) {
    QkGain g; const int s = lane & 7;
#pragma unroll
    for (int i = 0; i < 16; ++i) { g.qn[i] = q_nope_g[s * 16 + i] * QMUL; g.kn[i] = k_nope_g[s * 16 + i] * KMUL; }
#pragma unroll
    for (int i = 0; i < 8; ++i) g.qr[i] = q_rope_g[s * 8 + i] * QMUL;
    g.kr = k_rope_g[lane] * KMUL; return g;
}
__device__ __forceinline__ QkRaw p4_load(int t, int lane, const bf16_t* __restrict__ Z2, const bf16_t* __restrict__ QRAW, const bf16_t* __restrict__ KVRAW, const float* __restrict__ COS, const float* __restrict__ SIN) {
    QkRaw r; const int h = lane >> 3, s = lane & 7; const bf16_t* z = Z2 + (size_t)t * AGW;
    r.zq = *(const u32x4*)(z + lane * 8); r.zkv = *(const u32x2*)(z + 512 + lane * 4); r.zkr = z[768 + lane];
    const bf16_t* q = QRAW + (size_t)t * 1536; r.qn0 = __builtin_nontemporal_load((const u32x4*)(q + h * 128 + s * 16)); r.qn1 = __builtin_nontemporal_load((const u32x4*)(q + h * 128 + s * 16 + 8)); r.qr = __builtin_nontemporal_load((const u32x4*)(q + 1024 + h * 64 + s * 8));
    const bf16_t* kv = KVRAW + (size_t)t * 2048 + h * 256 + s * 16; r.kn0 = __builtin_nontemporal_load((const u32x4*)kv); r.kn1 = __builtin_nontemporal_load((const u32x4*)(kv + 8)); r.v0 = __builtin_nontemporal_load((const u32x4*)(kv + 128)); r.v1 = __builtin_nontemporal_load((const u32x4*)(kv + 136));
    const float* cp = COS + (size_t)t * 32; const float* sp = SIN + (size_t)t * 32;
    r.cq0 = *(const f32x4*)(cp + (s & 3) * 8); r.cq1 = *(const f32x4*)(cp + (s & 3) * 8 + 4); r.sq0 = *(const f32x4*)(sp + (s & 3) * 8); r.sq1 = *(const f32x4*)(sp + (s & 3) * 8 + 4);
    r.ck = cp[lane & 31]; r.sk = sp[lane & 31]; return r;
}
#define UNPK8(W_, X_, O_) do { const u32x4 w_ = (W_); X_[O_ + 0] = bflo(w_[0]); X_[O_ + 1] = bfhi(w_[0]); X_[O_ + 2] = bflo(w_[1]); X_[O_ + 3] = bfhi(w_[1]); X_[O_ + 4] = bflo(w_[2]); X_[O_ + 5] = bfhi(w_[2]); X_[O_ + 6] = bflo(w_[3]); X_[O_ + 7] = bfhi(w_[3]); } while (0)
__device__ __forceinline__ void p4_proc(int t, int lane, const QkRaw& r, const QkGain& g, bf16_t* __restrict__ Q, bf16_t* __restrict__ KN, bf16_t* __restrict__ V, bf16_t* __restrict__ KR, LAS unsigned char* vtile) {
    const int h = lane >> 3, s = lane & 7, b = t >> 14, l = t & (SEQ - 1);
    float rq, rkv;
    { float x[8]; UNPK8(r.zq, x, 0); float ss = 0.f;
#pragma unroll
      for (int i = 0; i < 8; ++i) ss += x[i] * x[i];
      rq = 1.0f / sqrtf(wave_sum(ss) * (1.0f / 512.0f) + EPS); }
    { const float ss = bflo(r.zkv.x) * bflo(r.zkv.x) + bfhi(r.zkv.x) * bfhi(r.zkv.x) + bflo(r.zkv.y) * bflo(r.zkv.y) + bfhi(r.zkv.y) * bfhi(r.zkv.y);
      rkv = 1.0f / sqrtf(wave_sum(ss) * (1.0f / 256.0f) + EPS); }
    { float x = bf2f((unsigned short)r.zkr); const float rr = 1.0f / sqrtf(wave_sum(x * x) * (1.0f / 64.0f) + EPS); x = x * rr * g.kr;
      const float other = __shfl_xor(x, 32); const float o = (lane < 32) ? (x * r.ck - other * r.sk) : (x * r.ck + other * r.sk);
#if ATT_FP8
      ((unsigned char*)KR)[(size_t)t * 64 + lane] = (unsigned char)(pk4_fp8(o, o, o, o) & 0xffu); }
#else
      KR[(size_t)t * 64 + lane] = f2bf(o); }
#endif
    { float x[16]; UNPK8(r.qn0, x, 0); UNPK8(r.qn1, x, 8); float ss = 0.f;
#pragma unroll
      for (int i = 0; i < 16; ++i) { x[i] *= rq; ss += x[i] * x[i]; }
      ss += __shfl_xor(ss, 1); ss += __shfl_xor(ss, 2); ss += __shfl_xor(ss, 4);
      const float rr = 1.0f / sqrtf(ss * (1.0f / 128.0f) + EPS); unsigned o[8];
#pragma unroll
#if ATT_FP8
      for (int i = 0; i < 16; ++i) x[i] = x[i] * rr * g.qn[i];
      (void)o;
      *(u32x4*)((unsigned char*)Q + ((size_t)((b * NH + h) * SEQ + l)) * 192 + s * 16) = (u32x4){pk4_fp8(x[0], x[1], x[2], x[3]), pk4_fp8(x[4], x[5], x[6], x[7]), pk4_fp8(x[8], x[9], x[10], x[11]), pk4_fp8(x[12], x[13], x[14], x[15])}; }
#else
      for (int i = 0; i < 8; ++i) o[i] = cvt_pk_bf16(x[2 * i] * rr * g.qn[2 * i], x[2 * i + 1] * rr * g.qn[2 * i + 1]);
      bf16_t* dst = Q + ((size_t)((b * NH + h) * SEQ + l)) * 192 + s * 16;
      *(u32x4*)dst = (u32x4){o[0], o[1], o[2], o[3]}; *(u32x4*)(dst + 8) = (u32x4){o[4], o[5], o[6], o[7]}; }
#endif
    { float x[8]; UNPK8(r.qr, x, 0); float ss = 0.f;
#pragma unroll
      for (int i = 0; i < 8; ++i) { x[i] *= rq; ss += x[i] * x[i]; }
      ss += __shfl_xor(ss, 1); ss += __shfl_xor(ss, 2); ss += __shfl_xor(ss, 4);
      const float rr = 1.0f / sqrtf(ss * (1.0f / 64.0f) + EPS); float y[8];
      const float cs[8] = {r.cq0[0], r.cq0[1], r.cq0[2], r.cq0[3], r.cq1[0], r.cq1[1], r.cq1[2], r.cq1[3]}, sn[8] = {r.sq0[0], r.sq0[1], r.sq0[2], r.sq0[3], r.sq1[0], r.sq1[1], r.sq1[2], r.sq1[3]};
#pragma unroll
      for (int i = 0; i < 8; ++i) x[i] = x[i] * rr * g.qr[i];
#pragma unroll
      for (int i = 0; i < 8; ++i) { const float other = __shfl_xor(x[i], 4); y[i] = (s < 4) ? (x[i] * cs[i] - other * sn[i]) : (x[i] * cs[i] + other * sn[i]); }
#if ATT_FP8
      *(u32x2*)((unsigned char*)Q + ((size_t)((b * NH + h) * SEQ + l)) * 192 + 128 + s * 8) = (u32x2){pk4_fp8(y[0], y[1], y[2], y[3]), pk4_fp8(y[4], y[5], y[6], y[7])}; }
#else
      bf16_t* dst = Q + ((size_t)((b * NH + h) * SEQ + l)) * 192 + 128 + s * 8;
      *(u32x4*)dst = (u32x4){cvt_pk_bf16(y[0], y[1]), cvt_pk_bf16(y[2], y[3]), cvt_pk_bf16(y[4], y[5]), cvt_pk_bf16(y[6], y[7])}; }
#endif
    { float x[16]; UNPK8(r.kn0, x, 0); UNPK8(r.kn1, x, 8); float ss = 0.f;
#pragma unroll
      for (int i = 0; i < 16; ++i) { x[i] *= rkv; ss += x[i] * x[i]; }
      ss += __shfl_xor(ss, 1); ss += __shfl_xor(ss, 2); ss += __shfl_xor(ss, 4);
      const float rr = 1.0f / sqrtf(ss * (1.0f / 128.0f) + EPS); unsigned o[8];
#pragma unroll
#if ATT_FP8
      for (int i = 0; i < 16; ++i) x[i] = x[i] * rr * g.kn[i];
      (void)o;
      *(u32x4*)((unsigned char*)KN + ((size_t)((b * NH + h) * SEQ + l)) * 128 + s * 16) = (u32x4){pk4_fp8(x[0], x[1], x[2], x[3]), pk4_fp8(x[4], x[5], x[6], x[7]), pk4_fp8(x[8], x[9], x[10], x[11]), pk4_fp8(x[12], x[13], x[14], x[15])}; }
#else
      for (int i = 0; i < 8; ++i) o[i] = cvt_pk_bf16(x[2 * i] * rr * g.kn[2 * i], x[2 * i + 1] * rr * g.kn[2 * i + 1]);
      bf16_t* dst = KN + ((size_t)((b * NH + h) * SEQ + l)) * 128 + s * 16;
      *(u32x4*)dst = (u32x4){o[0], o[1], o[2], o[3]}; *(u32x4*)(dst + 8) = (u32x4){o[4], o[5], o[6], o[7]}; }
#endif
#if ATT_PV8
    { const unsigned ww[8] = {r.v0[0], r.v0[1], r.v0[2], r.v0[3], r.v1[0], r.v1[1], r.v1[2], r.v1[3]}; unsigned q8[4];
#pragma unroll
      for (int i = 0; i < 4; ++i) q8[i] = pk4_fp8(bflo(ww[2 * i]) * rkv, bfhi(ww[2 * i]) * rkv, bflo(ww[2 * i + 1]) * rkv, bfhi(ww[2 * i + 1]) * rkv);
      const int k = t & 63, slot = 2 * ((k >> 2) & 1) + (k >> 5), bis = (k & 3) + 4 * ((k & 31) >> 3);
#pragma unroll
      for (int j = 0; j < 16; ++j) { const int d = s * 16 + j; vtile[(h * 128 + d) * 64 + ((slot ^ ((d >> 2) & 3)) << 4) + bis] = (unsigned char)((q8[j >> 2] >> (8 * (j & 3))) & 0xffu); } }
#else
    { unsigned o[8]; const unsigned ww[8] = {r.v0.x, r.v0.y, r.v0.z, r.v0.w, r.v1.x, r.v1.y, r.v1.z, r.v1.w};
#pragma unroll
      for (int i = 0; i < 8; ++i) o[i] = cvt_pk_bf16(bflo(ww[i]) * rkv, bfhi(ww[i]) * rkv);
      bf16_t* dst = V + ((size_t)((b * NH + h) * SEQ + l)) * 128 + s * 16;
      *(u32x4*)dst = (u32x4){o[0], o[1], o[2], o[3]}; *(u32x4*)(dst + 8) = (u32x4){o[4], o[5], o[6], o[7]}; }
    (void)vtile;
#endif
}

struct MixRaw { u32x4 s0, s1; f32x4 m[4]; };
__device__ __forceinline__ MixRaw p6_load(int t, int lane, const bf16_t* __restrict__ YS, const float* __restrict__ YM) {
    MixRaw r; const bf16_t* ys = YS + (size_t)t * 1024 + lane * 16; r.s0 = __builtin_nontemporal_load((const u32x4*)ys); r.s1 = __builtin_nontemporal_load((const u32x4*)(ys + 8));
    const float* ym = YM + (size_t)t * 1024 + lane * 16;
#pragma unroll
    for (int j = 0; j < 4; ++j) r.m[j] = __builtin_nontemporal_load((const f32x4*)(ym + 4 * j));
    return r;
}
__device__ __forceinline__ void p6_proc(int t, int lane, const MixRaw& r, bf16_t* __restrict__ MIX) {
    float x[16]; UNPK8(r.s0, x, 0); UNPK8(r.s1, x, 8);
    float ss = 0.f, sm = 0.f;
#pragma unroll
    for (int i = 0; i < 16; ++i) ss += x[i] * x[i];
#pragma unroll
    for (int j = 0; j < 4; ++j) sm += (r.m[j][0] * r.m[j][0] + r.m[j][1] * r.m[j][1]) + (r.m[j][2] * r.m[j][2] + r.m[j][3] * r.m[j][3]);
    const float rs = 1.0f / sqrtf(wave_sum(ss) * (1.0f / 1024.0f) + EPS), rm = 1.0f / sqrtf(wave_sum(sm) * (1.0f / 1024.0f) + EPS);
#if OUT_FP8
    unsigned char* d0 = (unsigned char*)MIX + (size_t)t * 2048 + lane * 16;
    *(u32x4*)d0 = (u32x4){pk4_fp8(x[0] * rs, x[1] * rs, x[2] * rs, x[3] * rs), pk4_fp8(x[4] * rs, x[5] * rs, x[6] * rs, x[7] * rs), pk4_fp8(x[8] * rs, x[9] * rs, x[10] * rs, x[11] * rs), pk4_fp8(x[12] * rs, x[13] * rs, x[14] * rs, x[15] * rs)};
    *(u32x4*)(d0 + 1024) = (u32x4){pk4_fp8(r.m[0][0] * rm, r.m[0][1] * rm, r.m[0][2] * rm, r.m[0][3] * rm), pk4_fp8(r.m[1][0] * rm, r.m[1][1] * rm, r.m[1][2] * rm, r.m[1][3] * rm),
                                   pk4_fp8(r.m[2][0] * rm, r.m[2][1] * rm, r.m[2][2] * rm, r.m[2][3] * rm), pk4_fp8(r.m[3][0] * rm, r.m[3][1] * rm, r.m[3][2] * rm, r.m[3][3] * rm)};
#else
    bf16_t* d0 = MIX + (size_t)t * 2048 + lane * 16; unsigned o[8];
#pragma unroll
    for (int i = 0; i < 8; ++i) o[i] = cvt_pk_bf16(x[2 * i] * rs, x[2 * i + 1] * rs);
    *(u32x4*)d0 = (u32x4){o[0], o[1], o[2], o[3]}; *(u32x4*)(d0 + 8) = (u32x4){o[4], o[5], o[6], o[7]};
    bf16_t* d1 = d0 + 1024;
#pragma unroll
    for (int j = 0; j < 4; ++j) { o[2 * j] = cvt_pk_bf16(r.m[j][0] * rm, r.m[j][1] * rm); o[2 * j + 1] = cvt_pk_bf16(r.m[j][2] * rm, r.m[j][3] * rm); }
    *(u32x4*)d1 = (u32x4){o[0], o[1], o[2], o[3]}; *(u32x4*)(d1 + 8) = (u32x4){o[4], o[5], o[6], o[7]};
#endif
}

__device__ __forceinline__ void p8_group(int grp, int lane, LAS float* wl  , const bf16_t* __restrict__ X1, const float* __restrict__ FA2, const float* __restrict__ FB2,
                                         const bf16_t* __restrict__ WRT_HI, const bf16_t* __restrict__ WRT_LO, const float* __restrict__ b_router, unsigned char* __restrict__ H8,
                                         int* __restrict__ RIDX, float* __restrict__ RGATE, int* __restrict__ RPOS, unsigned* __restrict__ CNT) {
    const int t0 = grp * 16, b = t0 >> 14, fr = lane & 15, fq = lane >> 4;
    float rstd_mine = 0.f;
    { f32x4 fa[4][2], fb[4][2];
#pragma unroll
      for (int j = 0; j < 4; ++j)
#pragma unroll
        for (int q = 0; q < 2; ++q) { fa[j][q] = *(const f32x4*)(FA2 + b * 2048 + 8 * lane + 512 * j + 4 * q); fb[j][q] = *(const f32x4*)(FB2 + b * 2048 + 8 * lane + 512 * j + 4 * q); }
#pragma unroll 1
      for (int i = 0; i < 16; i += 4) { constexpr int HB = MOE_FP8 ? 2048 : 4096;
          const RowRawB r0 = hnorm_b_load(X1 + (size_t)(t0 + i) * 2048, lane), r1 = hnorm_b_load(X1 + (size_t)(t0 + i + 1) * 2048, lane), r2 = hnorm_b_load(X1 + (size_t)(t0 + i + 2) * 2048, lane), r3 = hnorm_b_load(X1 + (size_t)(t0 + i + 3) * 2048, lane);
          const float q0 = hnorm_b_proc(r0, H8 + (size_t)(t0 + i) * HB, fa, fb, lane), q1 = hnorm_b_proc(r1, H8 + (size_t)(t0 + i + 1) * HB, fa, fb, lane), q2 = hnorm_b_proc(r2, H8 + (size_t)(t0 + i + 2) * HB, fa, fb, lane), q3 = hnorm_b_proc(r3, H8 + (size_t)(t0 + i + 3) * HB, fa, fb, lane);
          rstd_mine = (fr == i) ? q0 : (fr == i + 1) ? q1 : (fr == i + 2) ? q2 : (fr == i + 3) ? q3 : rstd_mine; } }
    f32x4 acc0 = {0.f, 0.f, 0.f, 0.f}, acc1 = {0.f, 0.f, 0.f, 0.f};
    const bf16_t* xrow = X1 + (size_t)(t0 + fr) * 2048 + fq * 8;
    const float* fap = FA2 + b * 2048 + fq * 8; const float* fbp = FB2 + b * 2048 + fq * 8;
    const bf16_t* wh0 = WRT_HI + (size_t)fr * 2048 + fq * 8; const bf16_t* wl0 = WRT_LO + (size_t)fr * 2048 + fq * 8;
#pragma unroll 4
    for (int ks = 0; ks < 64; ++ks) {
        const u32x4 xw = *(const u32x4*)(xrow + ks * 32); const f32x4 x0 = {bflo(xw.x), bfhi(xw.x), bflo(xw.y), bfhi(xw.y)}, x1 = {bflo(xw.z), bfhi(xw.z), bflo(xw.w), bfhi(xw.w)};
        const f32x4 a0 = *(const f32x4*)(fap + ks * 32), a1 = *(const f32x4*)(fap + ks * 32 + 4), c0 = *(const f32x4*)(fbp + ks * 32), c1 = *(const f32x4*)(fbp + ks * 32 + 4);
        const f32x4 h0 = x0 * rstd_mine * a0 + c0, h1 = x1 * rstd_mine * a1 + c1;
        u32x4 hh; hh.x = cvt_pk_bf16(h0[0], h0[1]); hh.y = cvt_pk_bf16(h0[2], h0[3]); hh.z = cvt_pk_bf16(h1[0], h1[1]); hh.w = cvt_pk_bf16(h1[2], h1[3]);
        u32x4 hl; hl.x = cvt_pk_bf16(h0[0] - bflo(hh.x), h0[1] - bfhi(hh.x)); hl.y = cvt_pk_bf16(h0[2] - bflo(hh.y), h0[3] - bfhi(hh.y));
        hl.z = cvt_pk_bf16(h1[0] - bflo(hh.z), h1[1] - bfhi(hh.z)); hl.w = cvt_pk_bf16(h1[2] - bflo(hh.w), h1[3] - bfhi(hh.w));
        const bf16x8 hhi = *reinterpret_cast<bf16x8*>(&hh), hlo = *reinterpret_cast<bf16x8*>(&hl);
        const bf16x8 whi0 = *(const bf16x8*)(wh0 + ks * 32), wlo0 = *(const bf16x8*)(wl0 + ks * 32);
        const bf16x8 whi1 = *(const bf16x8*)(wh0 + 16 * 2048 + ks * 32), wlo1 = *(const bf16x8*)(wl0 + 16 * 2048 + ks * 32);
        acc0 = __builtin_amdgcn_mfma_f32_16x16x32_bf16(whi0, hhi, acc0, 0, 0, 0); acc0 = __builtin_amdgcn_mfma_f32_16x16x32_bf16(wlo0, hhi, acc0, 0, 0, 0); acc0 = __builtin_amdgcn_mfma_f32_16x16x32_bf16(whi0, hlo, acc0, 0, 0, 0);
        acc1 = __builtin_amdgcn_mfma_f32_16x16x32_bf16(whi1, hhi, acc1, 0, 0, 0); acc1 = __builtin_amdgcn_mfma_f32_16x16x32_bf16(wlo1, hhi, acc1, 0, 0, 0); acc1 = __builtin_amdgcn_mfma_f32_16x16x32_bf16(whi1, hlo, acc1, 0, 0, 0);
    }
    LAS float* lg = wl; LAS unsigned* hist = (LAS unsigned*)(wl + 16 * 33); LAS unsigned* basel = hist + 32;
#pragma unroll
    for (int e = 0; e < 4; ++e) { lg[fr * 33 + 4 * fq + e] = acc0[e] + b_router[4 * fq + e]; lg[fr * 33 + 16 + 4 * fq + e] = acc1[e] + b_router[16 + 4 * fq + e]; }
    if (lane < 32) hist[lane] = 0u;
    LDS_FENCE();
    int ie[4] = {0, 0, 0, 0}; float gt[4] = {0.f, 0.f, 0.f, 0.f}; unsigned rk[4] = {0u, 0u, 0u, 0u};
    if (lane < 16) {
        float v0 = -3.0e38f, v1 = -3.0e38f, v2 = -3.0e38f, v3 = -3.0e38f; int i0 = 0, i1 = 0, i2 = 0, i3 = 0;
#pragma unroll 4
        for (int e = 0; e < 32; ++e) { const float x = lg[lane * 33 + e];
            if (x > v0) { v3 = v2; i3 = i2; v2 = v1; i2 = i1; v1 = v0; i1 = i0; v0 = x; i0 = e; }
            else if (x > v1) { v3 = v2; i3 = i2; v2 = v1; i2 = i1; v1 = x; i1 = e; }
            else if (x > v2) { v3 = v2; i3 = i2; v2 = x; i2 = e; }
            else if (x > v3) { v3 = x; i3 = e; } }
        const float e1 = __expf(v1 - v0), e2 = __expf(v2 - v0), e3 = __expf(v3 - v0), inv = 1.0f / (1.0f + e1 + e2 + e3);
        ie[0] = i0; ie[1] = i1; ie[2] = i2; ie[3] = i3; gt[0] = inv; gt[1] = e1 * inv; gt[2] = e2 * inv; gt[3] = e3 * inv;
#pragma unroll
        for (int k = 0; k < 4; ++k) rk[k] = __hip_atomic_fetch_add((LAS unsigned*)&hist[ie[k]], 1u, __ATOMIC_RELAXED, __HIP_MEMORY_SCOPE_WORKGROUP);
    }
    LDS_FENCE();
    if (lane < 32) { const unsigned cnt = hist[lane]; unsigned base = 0u; if (cnt) base = __hip_atomic_fetch_add(CNT + lane, cnt, __ATOMIC_RELAXED, __HIP_MEMORY_SCOPE_AGENT); basel[lane] = base; }
    LDS_FENCE();
    if (lane < 16) { const int t = t0 + lane;
#pragma unroll
        for (int k = 0; k < 4; ++k) { RIDX[t * 4 + k] = ie[k]; RGATE[t * 4 + k] = gt[k]; RPOS[t * 4 + k] = (int)(basel[ie[k]] + rk[k]); } }
    LDS_FENCE();
}

__device__ __forceinline__ void moe_tables(const Ctx& c, const unsigned* __restrict__ CNT, volatile LAS int* tab) {
    if (c.tid < 64) { const int e = c.tid & 31;
        const int n = (int)__hip_atomic_load(CNT + e, __ATOMIC_RELAXED, __HIP_MEMORY_SCOPE_AGENT); const int nb = (n + 255) >> 8;
        int incl = nb;
#pragma unroll
        for (int d = 1; d < 32; d <<= 1) { const int t = __shfl_up(incl, d, 32); if (e >= d) incl += t; }
        if (c.tid < 32) { const int excl = incl - nb; tab[e] = nb; tab[32 + e] = excl; tab[96 + e] = n; if (e == 31) tab[64] = incl;
            for (int i = 0; i < nb; ++i) tab[128 + excl + i] = e; } }
    __syncthreads();
}

__device__ const float INVF[32] = {1.0f, 0.7498942017555237f, 0.5623413324356079f, 0.4216965138912201f, 0.3162277638912201f, 0.23713737726211548f, 0.17782793939113617f, 0.1333521455526352f, 0.10000000149011612f, 0.0749894231557846f, 0.05623413249850273f, 0.04216964915394783f, 0.03162277489900589f, 0.023713737726211548f, 0.017782794311642647f, 0.013335213996469975f, 0.009999999776482582f, 0.007498942315578461f, 0.005623413249850273f, 0.0042169648222625256f, 0.003162277629598975f, 0.0023713738191872835f, 0.0017782794311642647f, 0.0013335214462131262f, 0.0010000000474974513f, 0.0007498941849917173f, 0.000562341301701963f, 0.0004216965171508491f, 0.0003162277571391314f, 0.00023713737027719617f, 0.00017782794020604342f, 0.0001333521504420787f};

struct Args { const void* in[33]; float* out; unsigned char* ws; int ph_lo, ph_hi; };

__global__ void __launch_bounds__(512, 2) mk_fwd(Args a) {
    extern __shared__ __attribute__((aligned(16))) unsigned char lds_raw[];
    Ctx c; c.lds = (LAS unsigned char*)lds_raw; c.tid = threadIdx.x; c.lane = c.tid & 63; c.wave = __builtin_amdgcn_readfirstlane(c.tid >> 6); c.G = gridDim.x;
    { const int bx = blockIdx.x; c.vcu = (c.G % 8 == 0) ? (bx % 8) * (c.G / 8) + bx / 8 : bx; }
    volatile LAS unsigned* MISC = (volatile LAS unsigned*)(c.lds + MISC_OFF);
    for (int u = c.tid; u < 1024; u += 512) MISC[u] = 0u;
    __syncthreads();
    unsigned char* ws = a.ws;
    unsigned* ctl = (unsigned*)(ws + WS_CTL);
    volatile LAS int* tab = (volatile LAS int*)(c.lds + MISC_OFF + 256);
#if MK_N_LAUNCHES == 1
    XcdBarrier bar = xcd_barrier_post(ctl + CW_BAR, MISC);
#define GRID_BAR() xcd_barrier(bar)
#else
#define GRID_BAR() do { } while (0)
#endif
    const int lo = a.ph_lo, hi = a.ph_hi;
#ifndef PHASE_MASK
#define PHASE_MASK 0xFFFF
#endif
#define IN(k) ((((PHASE_MASK) >> (k)) & 1) && lo <= (k) && (k) < hi)
#define BOTH(k) (IN(k) && IN((k) + 1))
#ifndef PROBE_ATT
#ifndef PROBE_ABL
#define PROBE_ABL 0
#endif
#ifndef PROBE_GU
#define PROBE_GU 0
#endif
#define PROBE_ATT 1
#endif
#ifndef PROBE_DUP
#define PROBE_DUP 0
#endif
#define NREP(k) (1 + (((PROBE_DUP) >> (k)) & 1))
#define REP_BEGIN(k) _Pragma("unroll 1") for (int rep_ = 0; rep_ < NREP(k); ++rep_) {
#define REP_END(k) if (rep_ + 1 < NREP(k)) GRID_BAR(); }
    const int gw = c.vcu * 8 + c.wave, NGW = c.G * 8, gtid = c.vcu * 512 + c.tid, NTHR = c.G * 512, lane = c.lane;
    const float* x = (const float*)a.in[0]; const float* cvec = (const float*)a.in[1]; const int* positions = (const int*)a.in[2];
    const float* w_ada = (const float*)a.in[3]; const float* b_ada = (const float*)a.in[4]; const float* norm_mix_g = (const float*)a.in[5]; const float* w_in = (const float*)a.in[6];
    const float* ssm_A_re = (const float*)a.in[7]; const float* ssm_A_im = (const float*)a.in[8]; const float* ssm_B_re = (const float*)a.in[9]; const float* ssm_B_im = (const float*)a.in[10];
    const float* ssm_C_re = (const float*)a.in[11]; const float* ssm_C_im = (const float*)a.in[12]; const float* ssm_D = (const float*)a.in[13]; const float* ssm_log_dt = (const float*)a.in[14];
    const float* q_lat_g = (const float*)a.in[15]; const float* kv_lat_g = (const float*)a.in[16]; const float* w_uq = (const float*)a.in[17]; const float* w_ukv = (const float*)a.in[18];
    const float* q_nope_g = (const float*)a.in[19]; const float* q_rope_g = (const float*)a.in[20]; const float* k_nope_g = (const float*)a.in[21]; const float* k_rope_g = (const float*)a.in[22];
    const float* out_ssm_g = (const float*)a.in[23]; const float* out_mla_g = (const float*)a.in[24]; const float* w_out = (const float*)a.in[25]; const float* norm_ffn_g = (const float*)a.in[26];
    const float* w_router = (const float*)a.in[27]; const float* b_router = (const float*)a.in[28]; const float* w_gate_up = (const float*)a.in[29]; const float* b_gate_up = (const float*)a.in[30];
    const float* w_down = (const float*)a.in[31]; const float* b_down = (const float*)a.in[32];
    float* out = a.out;
    float* MOD = (float*)(ws + WS_MOD); float* FA2 = (float*)(ws + WS_FAB2); float* FB2 = FA2 + 4096;
    float* APOW = (float*)(ws + WS_APOW); float* A64 = (float*)(ws + WS_A64); float* A1024 = (float*)(ws + WS_A1024); float* BB = (float*)(ws + WS_BB); float* KC = (float*)(ws + WS_KC);
    float* COS = (float*)(ws + WS_COS); float* SIN = (float*)(ws + WS_SIN);
    int* RIDX = (int*)(ws + WS_RIDX); float* RGATE = (float*)(ws + WS_RGATE); int* RPOS = (int*)(ws + WS_RPOS); int* SLOT = (int*)(ws + WS_SLOT); float* ROWGATE = (float*)(ws + WS_ROWGATE);
    bf16_t* WRT_HI = (bf16_t*)(ws + WS_WRT); bf16_t* WRT_LO = WRT_HI + 32 * 2048;
    bf16_t* WUQ = (bf16_t*)(ws + WS_WUQ); bf16_t* WUKV = (bf16_t*)(ws + WS_WUKV); bf16_t* WIN = (bf16_t*)(ws + WS_WIN); bf16_t* WOUT = (bf16_t*)(ws + WS_WOUT); bf16_t* WG = (bf16_t*)(ws + WS_WG);
    float* SEND = (float*)(ws + WS_SEND); bf16_t* KR = (bf16_t*)(ws + WS_KR); bf16_t* BTG = (bf16_t*)(ws + WS_BTG); bf16_t* AG = (bf16_t*)(ws + WS_AG); bf16_t* GS = (bf16_t*)(ws + WS_GS);
    bf16_t* Z2 = (bf16_t*)(ws + WS_Z2); bf16_t* H = (bf16_t*)(ws + WS_H); bf16_t* QRAW = (bf16_t*)(ws + WS_QRAW); bf16_t* KVRAW = (bf16_t*)(ws + WS_KVRAW);
    bf16_t* Q = (bf16_t*)(ws + WS_Q); bf16_t* KN = (bf16_t*)(ws + WS_KN); bf16_t* V = (bf16_t*)(ws + WS_V); bf16_t* YS = (bf16_t*)(ws + WS_YS); float* YM = (float*)(ws + WS_YM); bf16_t* MIX = (bf16_t*)(ws + WS_MIX);
    unsigned char* WGU = ws + WS_WGU; unsigned char* WDN = ws + WS_WDN; unsigned char* ACT = ws + WS_ACT; unsigned char* YB = ws + WS_YB; bf16_t* X1B = (bf16_t*)(ws + WS_YM);     unsigned char* XS = ws + WS_XS; unsigned char* H8 = ws + WS_H;
    unsigned* CNT = ctl + CW_CNT;

    if (IN(0)) {
        REP_BEGIN(0)
        for (int it = c.vcu; it < 192; it += c.G) p0_mod_chunk(c, it, cvec, w_ada, b_ada, MOD);
        for (int it = c.vcu; it < 256; it += c.G) p0_kc_item(c, it, ssm_A_re, ssm_A_im, ssm_B_re, ssm_B_im, ssm_C_re, ssm_C_im, ssm_D, ssm_log_dt, KC, BB);
        for (int i = gtid; i < 64 * 65 * 64; i += NTHR) { const int g = i / 4160, k = (i >> 6) % 65, p = i & 63; const float dt = expf(ssm_log_dt[g]), are = ssm_A_re[g * 64 + p], aim = ssm_A_im[g * 64 + p];
            float cs, sn; sincos_d((double)k * (double)dt * (double)aim, cs, sn); const float ex = expf((float)k * dt * are); APOW[2 * (size_t)i] = ex * cs; APOW[2 * (size_t)i + 1] = ex * sn; }
        for (int i = gtid; i < 4096; i += NTHR) { const int g = i >> 6; const float dt = expf(ssm_log_dt[g]), are = ssm_A_re[i], aim = ssm_A_im[i]; float cs, sn;
            sincos_d(64.0 * (double)dt * (double)aim, cs, sn); float ex = expf(64.0f * dt * are); A64[2 * i] = ex * cs; A64[2 * i + 1] = ex * sn;
            sincos_d(1024.0 * (double)dt * (double)aim, cs, sn); ex = expf(1024.0f * dt * are); A1024[2 * i] = ex * cs; A1024[2 * i + 1] = ex * sn; }
        for (int i = gtid; i < NTOK * 32; i += NTHR) { const int t = i >> 5, k = i & 31; const float ang = (float)positions[t] * INVF[k]; float cs, sn; sincos_d((double)ang, cs, sn); COS[i] = cs; SIN[i] = sn; }
        { const u32x4 z4 = {0u, 0u, 0u, 0u};
          u32x4* zw = (u32x4*)(WIN + (size_t)DIN * 2048); for (int i = gtid; i < (DINP - DIN) * 2048 / 8; i += NTHR) zw[i] = z4;
          for (int i = gtid; i < 64 * 128 * 1024 / 8; i += NTHR) { const int g = i >> 14, r = i & 16383; ((u32x4*)(WG + ((size_t)g * 256 + 128) * 1024))[r] = z4; } }
        for (int i = gtid; i < 32 * 2048; i += NTHR) { const int e = i >> 11, k = i & 2047; const float w = w_router[k * 32 + e]; const unsigned short hb = f2bf(w); WRT_HI[i] = hb; WRT_LO[i] = f2bf(w - bf2f(hb)); }
                constexpr int I_IN = 32 * 45, I_UQ = 8 * 24, I_UKV = 4 * 32, I_OUT = 32 * 32;
        constexpr int NIT = I_IN + I_UQ + I_UKV + I_OUT;
        for (int it = gw; it < NIT; it += NGW) {
            int r = it;
            if (r < I_IN) { tr_item<0>(w_in, DIN, nullptr, WIN, 2048, r / 45, r % 45, lane); continue; } r -= I_IN;
#if OUT_FP8
            if (r < I_OUT) { if (r < 16 * 32) { const int kb = r / 32; tr_item8<0>(w_out, 2048, (unsigned char*)WOUT, 2048, kb, r % 32, lane, kb < 8 ? out_ssm_g : out_mla_g - 1024); } continue; } r -= I_OUT;
#else
            if (r < I_OUT) { const int kb = r / 32; tr_item<0>(w_out, 2048, kb < 16 ? out_ssm_g : out_mla_g - 1024, WOUT, 2048, kb, r % 32, lane); continue; } r -= I_OUT;
#endif
            if (r < I_UQ) { tr_item<1>(w_uq, 1536, q_lat_g, WUQ, 1024, r / 24, r % 24, lane); continue; } r -= I_UQ;
            tr_item<0>(w_ukv, 2048, kv_lat_g, WUKV, 1024, r / 32, r % 32, lane);
        }
        REP_END(0)
        if (BOTH(0)) GRID_BAR();
    }
    if (IN(1)) {
        REP_BEGIN(1)
#pragma unroll 1
        for (int b = 0; b < 2; ++b) { f32x4 fa[8], fb[8];
#pragma unroll
            for (int j = 0; j < 8; ++j) { const int col = 4 * lane + 256 * j; const f32x4 g4 = *(const f32x4*)(norm_mix_g + col), sc4 = *(const f32x4*)(MOD + b * 12288 + 2048 + col); fa[j] = g4 * (1.0f + sc4); fb[j] = *(const f32x4*)(MOD + b * 12288 + col); }
#pragma unroll 1
            for (int row = b * SEQ + gw; row < (b + 1) * SEQ; row += 2 * NGW) { const int row1 = row + NGW; const bool two = row1 < (b + 1) * SEQ;
                const RowRaw ra = hnorm_load(x + (size_t)row * 2048, lane), rb = hnorm_load(x + (size_t)(two ? row1 : row) * 2048, lane);
                (void)hnorm_proc(ra, H + (size_t)row * 2048, fa, fb, lane); if (two) (void)hnorm_proc(rb, H + (size_t)row1 * 2048, fa, fb, lane); } }
        for (int i = gtid; i < 4096; i += NTHR) { const int b = i >> 11, k = i & 2047; FA2[i] = norm_ffn_g[k] * (1.0f + MOD[b * 12288 + 8192 + k]); FB2[i] = MOD[b * 12288 + 6144 + k]; }
        for (int i = gtid; i < 64 * 64 * 16 * 64 * 2; i += NTHR) { const int hh8 = i & 1, j = (i >> 1) & 63, h = (i >> 7) & 15, l = (i >> 11) & 63, g = i >> 17;
            if (j >= 16 * ((l >> 4) + 1)) continue;
            u32x4 w = {0u, 0u, 0u, 0u};
            if (j <= l) { const float* src = KC + ((size_t)(g * 64 + (l - j)) * 16 + h) * 16 + hh8 * 8; const f32x4 k0 = *(const f32x4*)src, k1 = *(const f32x4*)(src + 4);
                w.x = cvt_pk_bf16(k0[0], k0[1]); w.y = cvt_pk_bf16(k0[2], k0[3]); w.z = cvt_pk_bf16(k1[0], k1[1]); w.w = cvt_pk_bf16(k1[2], k1[3]); }
            *(u32x4*)(BTG + ((size_t)(g * 1024 + l * 16 + h)) * AGW + 128 + j * 16 + hh8 * 8) = w; }
        for (int i = gtid; i < 64 * 64 * 16 * 16; i += NTHR) { const int cg = i & 15, h = (i >> 4) & 15, l = (i >> 8) & 63, g = i >> 14, part = cg >> 3, p0 = (cg & 7) * 8; float v[8];
#pragma unroll
            for (int e = 0; e < 8; ++e) { const int p = p0 + e; const float cr = ssm_C_re[(g * 16 + h) * 64 + p], ci = ssm_C_im[(g * 16 + h) * 64 + p]; const float ar = APOW[((size_t)(g * 65 + l + 1) * 64 + p) * 2], ai = APOW[((size_t)(g * 65 + l + 1) * 64 + p) * 2 + 1];
                v[e] = part ? -(cr * ai + ci * ar) : (cr * ar - ci * ai); }
            u32x4 w; w.x = cvt_pk_bf16(v[0], v[1]); w.y = cvt_pk_bf16(v[2], v[3]); w.z = cvt_pk_bf16(v[4], v[5]); w.w = cvt_pk_bf16(v[6], v[7]);
            *(u32x4*)(BTG + ((size_t)(g * 1024 + l * 16 + h)) * AGW + cg * 8) = w; }
        for (int i = gtid; i < 64 * 128 * 64 * 2; i += NTHR) { const int hh8 = i & 1, j = (i >> 1) & 63, prow = (i >> 7) & 127, g = i >> 14, p = prow & 63, part = prow >> 6;
            const float ar = APOW[((size_t)(g * 65 + 63 - j) * 64 + p) * 2], ai = APOW[((size_t)(g * 65 + 63 - j) * 64 + p) * 2 + 1]; float v[8];
#pragma unroll
            for (int e = 0; e < 8; ++e) { const float br = BB[((size_t)(g * 64 + p) * 16 + hh8 * 8 + e) * 2], bi = BB[((size_t)(g * 64 + p) * 16 + hh8 * 8 + e) * 2 + 1]; v[e] = part ? (ar * bi + ai * br) : (ar * br - ai * bi); }
            u32x4 w; w.x = cvt_pk_bf16(v[0], v[1]); w.y = cvt_pk_bf16(v[2], v[3]); w.z = cvt_pk_bf16(v[4], v[5]); w.w = cvt_pk_bf16(v[6], v[7]);
            *(u32x4*)(WG + ((size_t)(g * 256 + prow)) * 1024 + j * 16 + hh8 * 8) = w; }
        REP_END(1)
        if (BOTH(1)) GRID_BAR();
    }
    if (IN(2)) {
        REP_BEGIN(2)
        SchedDense S{(const char*)H, (const char*)WIN, 4096u, 4096u, 128, 12, 32, c.G, (int)blockIdx.x}; EpiZ E{AG, GS, Z2};
        pg8::gemm_phase<EpiZ, SchedDense>(c.lds, 4096u, 4096u, S, E);
        REP_END(2)
        if (BOTH(2)) GRID_BAR();
    }
    if (IN(3)) {
        REP_BEGIN(3)
        SchedP3 S{(const char*)AG, (const char*)WG, (const char*)Z2, (const char*)WUQ, (const char*)WUKV, c.G, (int)blockIdx.x}; EpiP3 E{QRAW, KVRAW, SEND};
        pg8::gemm_phase<EpiP3, SchedP3>(c.lds, (unsigned)(AGW * 2), 2048u, S, E);
        REP_END(3)
        if (BOTH(3)) GRID_BAR();
    }
    if (IN(4)) {
        REP_BEGIN(4)
        for (int it = c.vcu; it < 256; it += c.G) p4_carry_item(c, it, SEND, A64, A1024, AG);
        { const QkGain gn = p4_gains(lane, q_nope_g, q_rope_g, k_nope_g, k_rope_g);
#if ATT_PV8
#pragma unroll 1
          for (int tile = c.vcu; tile < NTOK / 64; tile += c.G) {
#pragma unroll 1
              for (int i = 0; i < 8; i += 2) { const int t = tile * 64 + c.wave * 8 + i;
                  const QkRaw ra = p4_load(t, lane, Z2, QRAW, KVRAW, COS, SIN), rb = p4_load(t + 1, lane, Z2, QRAW, KVRAW, COS, SIN);
                  p4_proc(t, lane, ra, gn, Q, KN, V, KR, c.lds); p4_proc(t + 1, lane, rb, gn, Q, KN, V, KR, c.lds); }
              __syncthreads();
              { const int b = tile >> 8, tl = tile & 255; unsigned char* V8T = (unsigned char*)V;
#pragma unroll
                for (int q = 0; q < 8; ++q) { const int o = (c.tid + 512 * q) * 16, h = o >> 13, within = o & 8191;
                    *(u32x4*)(V8T + ((size_t)((b * NH + h) * 256 + tl)) * 8192 + within) = *(const LAS u32x4*)(c.lds + o); } }
              __syncthreads(); }
#else
#pragma unroll 1
          for (int t = gw; t < NTOK; t += 2 * NGW) { const int t1 = t + NGW; const bool two = t1 < NTOK;
              const QkRaw ra = p4_load(t, lane, Z2, QRAW, KVRAW, COS, SIN), rb = p4_load(two ? t1 : t, lane, Z2, QRAW, KVRAW, COS, SIN);
              p4_proc(t, lane, ra, gn, Q, KN, V, KR, c.lds); if (two) p4_proc(t1, lane, rb, gn, Q, KN, V, KR, c.lds); }
#endif
        }
        REP_END(4)
        if (BOTH(4)) GRID_BAR();
    }
    if (IN(5)) {
        REP_BEGIN(5)
#ifndef NO_SSM
        { SchedSsm S{(const char*)AG, (const char*)BTG, c.G, (int)blockIdx.x}; EpiSsm E{GS, YS};
          pg8::gemm_phase<EpiSsm, SchedSsm>(c.lds, (unsigned)(AGW * 2), (unsigned)(AGW * 2), S, E); }
#endif
        __syncthreads();
#ifndef NO_ATT
        { const bool spread = (c.G % 4 == 0); const bool conv = spread ? ((int)blockIdx.x < (c.G >> 1)) : true;
          if (conv) { const int gwc = spread ? (int)blockIdx.x * 8 + c.wave : gw, NGWC = spread ? (c.G >> 1) * 8 : NGW;
#if MOE_FP8
            constexpr int I_GU = 16 * 64, I_DN = 16 * 32;
#else
            constexpr int I_GU = 32 * 64, I_DN = 32 * 32;
#endif
#pragma unroll 1
            for (int it = gwc; it < 32 * (I_GU + I_DN); it += NGWC) {
                if (it < 32 * I_GU) { const int e = it / I_GU, q = it % I_GU;
#if MOE_FP8
                    tr_item8<2>(w_gate_up + (size_t)e * 2048 * 4096, 4096, WGU + (size_t)e * 4096 * 2048, 2048, q / 64, q % 64, lane);
#else
                    tr_item<2>(w_gate_up + (size_t)e * 2048 * 4096, 4096, nullptr, (bf16_t*)WGU + (size_t)e * 4096 * 2048, 2048, q / 64, q % 64, lane);
#endif
                } else { const int r = it - 32 * I_GU, e = r / I_DN, q = r % I_DN;
#if MOE_FP8
                    tr_item8<0>(w_down + (size_t)e * 2048 * 2048, 2048, WDN + (size_t)e * 2048 * 2048, 2048, q / 32, q % 32, lane);
#else
                    tr_item<0>(w_down + (size_t)e * 2048 * 2048, 2048, nullptr, (bf16_t*)WDN + (size_t)e * 2048 * 2048, 2048, q / 32, q % 32, lane);
#endif
                } } } }
#pragma unroll 1
        for (;;) {
            __syncthreads();
            if (c.tid == 0) MISC[16] = __hip_atomic_fetch_add(ctl + CW_ATT, 1u, __ATOMIC_RELAXED, __HIP_MEMORY_SCOPE_AGENT);
            __syncthreads();
            const unsigned u = MISC[16];
            if (u >= 1024u * PROBE_ATT) break;
            const int uu = (int)(u & 1023u), qb = 63 - (uu >> 4), bh = uu & 15, b = bh >> 3, h = bh & 7;
#if ATT_FP8 && ATT_PV8
#if PROBE_ABL
            if (u >= 1024u) att::attn_block9<PROBE_ABL>((const unsigned char*)Q + ((size_t)(b * NH + h) * SEQ + qb * 256) * 192, (const unsigned char*)KN + (size_t)(b * NH + h) * SEQ * 128, (const unsigned char*)V + (size_t)(b * NH + h) * 256 * 8192, (const unsigned char*)KR + (size_t)b * SEQ * 64,
                             YM + ((size_t)(b * SEQ + qb * 256)) * 1024 + h * 128, qb, (char*)lds_raw); else
#endif
            att::attn_block9((const unsigned char*)Q + ((size_t)(b * NH + h) * SEQ + qb * 256) * 192, (const unsigned char*)KN + (size_t)(b * NH + h) * SEQ * 128, (const unsigned char*)V + (size_t)(b * NH + h) * 256 * 8192, (const unsigned char*)KR + (size_t)b * SEQ * 64,
                             YM + ((size_t)(b * SEQ + qb * 256)) * 1024 + h * 128, qb, (char*)lds_raw);
#elif ATT_FP8
            att::attn_block8((const unsigned char*)Q + ((size_t)(b * NH + h) * SEQ + qb * 256) * 192, (const unsigned char*)KN + (size_t)(b * NH + h) * SEQ * 128, V + (size_t)(b * NH + h) * SEQ * 128, (const unsigned char*)KR + (size_t)b * SEQ * 64,
                             YM + ((size_t)(b * SEQ + qb * 256)) * 1024 + h * 128, qb, (char*)lds_raw);
#else
            att::attn_block(Q + ((size_t)(b * NH + h) * SEQ + qb * 256) * 192, KN + (size_t)(b * NH + h) * SEQ * 128, V + (size_t)(b * NH + h) * SEQ * 128, KR + (size_t)b * SEQ * 64,
                            YM + ((size_t)(b * SEQ + qb * 256)) * 1024 + h * 128, qb, (char*)lds_raw);
#endif
        }
#endif
        REP_END(5)
        if (BOTH(5)) GRID_BAR();
    }
    if (IN(6)) {
        REP_BEGIN(6)
#pragma unroll 1
        for (int t = gw; t < NTOK; t += 4 * NGW) { const int t1 = t + NGW, t2 = t + 2 * NGW, t3 = t + 3 * NGW;
            const MixRaw ra = p6_load(t, lane, YS, YM), rb = p6_load(t1 < NTOK ? t1 : t, lane, YS, YM), rc = p6_load(t2 < NTOK ? t2 : t, lane, YS, YM), rd = p6_load(t3 < NTOK ? t3 : t, lane, YS, YM);
            p6_proc(t, lane, ra, MIX); if (t1 < NTOK) p6_proc(t1, lane, rb, MIX); if (t2 < NTOK) p6_proc(t2, lane, rc, MIX); if (t3 < NTOK) p6_proc(t3, lane, rd, MIX); }
        REP_END(6)
        if (BOTH(6)) GRID_BAR();
    }
    if (IN(7)) {
        REP_BEGIN(7)
        constexpr unsigned OB = OUT_FP8 ? 2048u : 4096u;
        SchedDense S{(const char*)MIX, (const char*)WOUT, OB, OB, 128, 8, OUT_FP8 ? 16 : 32, c.G, (int)blockIdx.x}; EpiOut E{x, X1B, MOD};
        pg8::gemm_phase<EpiOut, SchedDense, OUT_FP8 != 0>(c.lds, OB, OB, S, E);
        REP_END(7)
        if (BOTH(7)) GRID_BAR();
    }
    if (IN(8)) {
        REP_BEGIN(8)
        for (int grp = gw; grp < NTOK / 16; grp += NGW) p8_group(grp, lane, (LAS float*)(c.lds + c.wave * 4096), X1B, FA2, FB2, WRT_HI, WRT_LO, b_router, H8, RIDX, RGATE, RPOS, CNT);
        REP_END(8)
        if (BOTH(8)) GRID_BAR();
    }
    if (IN(9)) {
        REP_BEGIN(9)
        moe_tables(c, CNT, tab);
#pragma unroll 1
        for (int t = gw; t < NTOK; t += NGW) { constexpr int RB = MOE_FP8 ? 2048 : 4096;
            const u32x4 ev = *(const u32x4*)(RIDX + t * 4), pv = *(const u32x4*)(RPOS + t * 4); const f32x4 gv = *(const f32x4*)(RGATE + t * 4);
            const u32x4* src = (const u32x4*)(H8 + (size_t)t * RB); u32x4 vv[RB / 1024];
#pragma unroll
            for (int j = 0; j < RB / 1024; ++j) vv[j] = src[lane + 64 * j];
            const int sl[4] = {tab[32 + (int)ev.x] * 256 + (int)pv.x, tab[32 + (int)ev.y] * 256 + (int)pv.y, tab[32 + (int)ev.z] * 256 + (int)pv.z, tab[32 + (int)ev.w] * 256 + (int)pv.w};
#pragma unroll
            for (int k = 0; k < 4; ++k) { u32x4* dst = (u32x4*)(XS + (size_t)sl[k] * RB);
#pragma unroll
                for (int j = 0; j < RB / 1024; ++j) dst[lane + 64 * j] = vv[j]; }
            if (lane == 0) { ROWGATE[sl[0]] = gv[0]; ROWGATE[sl[1]] = gv[1]; ROWGATE[sl[2]] = gv[2]; ROWGATE[sl[3]] = gv[3]; *(u32x4*)(SLOT + t * 4) = (u32x4){(unsigned)sl[0], (unsigned)sl[1], (unsigned)sl[2], (unsigned)sl[3]}; } }
        for (int it = gw; it < 32 * 256; it += NGW) { const int e = it >> 8, r = it & 255, n = tab[96 + e];
            if (n + r < tab[e] * 256) { const int slot = tab[32 + e] * 256 + n + r; constexpr int RB = MOE_FP8 ? 2048 : 4096; u32x4* dst = (u32x4*)(XS + (size_t)slot * RB); const u32x4 z4 = {0u, 0u, 0u, 0u};
#pragma unroll
                for (int j = 0; j < RB / 1024; ++j) dst[lane + 64 * j] = z4;
                if (lane == 0) ROWGATE[slot] = 0.f; } }
        REP_END(9)
        if (BOTH(9)) GRID_BAR();
    }
    if (IN(10)) {
        REP_BEGIN(10)
        moe_tables(c, CNT, tab);
        constexpr unsigned RB = MOE_FP8 ? 2048u : 4096u;
        SchedMoe S{(const char*)XS, (const char*)WGU, tab, 16, c.G, (int)blockIdx.x, (size_t)4096 * RB, RB, MOE_FP8 ? 16 : 32}; EpiGu E{b_gate_up, ACT};
        pg8::gemm_phase<EpiGu, SchedMoe, MOE_FP8 != 0>(c.lds, RB, RB, S, E);
#if PROBE_GU
        __syncthreads(); pg8::gemm_phase<EpiGu, SchedMoe, MOE_FP8 != 0, PROBE_GU>(c.lds, RB, RB, S, E); __syncthreads();
#endif
        REP_END(10)
        if (BOTH(10)) GRID_BAR();
    }
    if (IN(11)) {
        REP_BEGIN(11)
        moe_tables(c, CNT, tab);
        constexpr unsigned RB = MOE_FP8 ? 2048u : 4096u;
        SchedMoe S{(const char*)ACT, (const char*)WDN, tab, 8, c.G, (int)blockIdx.x, (size_t)2048 * RB, RB, MOE_FP8 ? 16 : 32}; EpiDn E{b_down, ROWGATE, YB};
        pg8::gemm_phase<EpiDn, SchedMoe, MOE_FP8 != 0>(c.lds, RB, RB, S, E);
        REP_END(11)
        if (BOTH(11)) GRID_BAR();
    }
    if (IN(12)) {
        typedef float f32x2_t __attribute__((ext_vector_type(2)));
        u32x4 slq = (gw < NTOK) ? *(const u32x4*)(SLOT + gw * 4) : (u32x4){0u, 0u, 0u, 0u};
#pragma unroll 1
        for (int t = gw; t < NTOK; t += NGW) { const int b = t >> 14; const int s0 = (int)slq[0], s1 = (int)slq[1], s2 = (int)slq[2], s3 = (int)slq[3];
            if (t + NGW < NTOK) slq = *(const u32x4*)(SLOT + (t + NGW) * 4);
#pragma unroll
            for (int j = 0; j < 4; ++j) { const int col = 8 * lane + 512 * j;
                const u32x2 y0 = __builtin_nontemporal_load((const u32x2*)(YB + (size_t)s0 * 2048 + col)), y1 = __builtin_nontemporal_load((const u32x2*)(YB + (size_t)s1 * 2048 + col)), y2 = __builtin_nontemporal_load((const u32x2*)(YB + (size_t)s2 * 2048 + col)), y3 = __builtin_nontemporal_load((const u32x2*)(YB + (size_t)s3 * 2048 + col));
                const f32x4 g0 = *(const f32x4*)(MOD + b * 12288 + 10240 + col) * YB_INV, g1 = *(const f32x4*)(MOD + b * 12288 + 10240 + col + 4) * YB_INV;
                const u32x4 xw = *(const u32x4*)(X1B + (size_t)t * 2048 + col);
                f32x4 o0 = {bflo(xw.x), bfhi(xw.x), bflo(xw.y), bfhi(xw.y)}, o1 = {bflo(xw.z), bfhi(xw.z), bflo(xw.w), bfhi(xw.w)};
#define SUM4(W, HI) (((__builtin_amdgcn_cvt_pk_f32_fp8((int)y0.W, HI) + __builtin_amdgcn_cvt_pk_f32_fp8((int)y1.W, HI)) + __builtin_amdgcn_cvt_pk_f32_fp8((int)y2.W, HI)) + __builtin_amdgcn_cvt_pk_f32_fp8((int)y3.W, HI))
                const f32x2_t a0 = SUM4(x, false), a1 = SUM4(x, true), a2 = SUM4(y, false), a3 = SUM4(y, true);
#undef SUM4
                o0[0] += g0[0] * a0[0]; o0[1] += g0[1] * a0[1]; o0[2] += g0[2] * a1[0]; o0[3] += g0[3] * a1[1];
                o1[0] += g1[0] * a2[0]; o1[1] += g1[1] * a2[1]; o1[2] += g1[2] * a3[0]; o1[3] += g1[3] * a3[1];
                float* op = out + (size_t)t * 2048 + col; __builtin_nontemporal_store(o0, (f32x4*)op); __builtin_nontemporal_store(o1, (f32x4*)(op + 4)); } }
    }
#undef IN
#undef BOTH
#undef GRID_BAR
}

extern "C" void kernel_launch(void* const* d_in, const int* in_sizes, int n_in, void* d_out, int out_size, void* d_ws, size_t ws_size, hipStream_t stream) {
    static int grid = 0;
    if (grid == 0) {
        if (n_in != 33 || out_size != NTOK * DM || ws_size < WS_END) { fprintf(stderr, "kernel_launch: unexpected shapes (n_in %d out %d ws %zu, need ws >= %zu)\n", n_in, out_size, ws_size, (size_t)WS_END); grid = -1; return; }
        int dev = 0, cus = 0, per_cu = 0;
        if (hipGetDevice(&dev) != hipSuccess || hipDeviceGetAttribute(&cus, hipDeviceAttributeMultiprocessorCount, dev) != hipSuccess) { grid = -1; return; }
        if (hipFuncSetAttribute((const void*)mk_fwd, hipFuncAttributeMaxDynamicSharedMemorySize, LDS_BYTES) != hipSuccess) { fprintf(stderr, "kernel_launch: hipFuncSetAttribute failed\n"); grid = -1; return; }
        if (hipOccupancyMaxActiveBlocksPerMultiprocessor(&per_cu, (const void*)mk_fwd, 512, LDS_BYTES) != hipSuccess || per_cu < 1) fprintf(stderr, "kernel_launch: occupancy query reports %d\n", per_cu);
        (void)hipGetLastError();
        grid = cus;
    }
    if (grid < 0) return;
    (void)hipMemsetAsync((char*)d_ws + WS_CTL, 0, CTL_BYTES, stream);
    Args a{};
    for (int i = 0; i < 33; ++i) a.in[i] = d_in[i];
    a.out = (float*)d_out; a.ws = (unsigned char*)d_ws;
#if MK_N_LAUNCHES == 1
    a.ph_lo = 0; a.ph_hi = NPHASE;
    hipLaunchKernelGGL(mk_fwd, dim3(grid), dim3(512), LDS_BYTES, stream, a);
#else
    for (int k = 0; k < NPHASE; ++k) { a.ph_lo = k; a.ph_hi = k + 1; hipLaunchKernelGGL(mk_fwd, dim3(grid), dim3(512), LDS_BYTES, stream, a); }
#endif
    const hipError_t le = hipPeekAtLastError();
    if (le != hipSuccess) fprintf(stderr, "kernel_launch: launch failed: %s\n", hipGetErrorName(le));
}
```

```cpp
#include <hip/hip_runtime.h>
#include <cstdio>
#include <cstdint>

#ifndef ATT_PV8
#define ATT_PV8 1
#endif
#ifndef ATT_FP8
#define ATT_FP8 1
#endif
#ifndef MOE_FP8
#define MOE_FP8 1
#endif
#ifndef MK_N_LAUNCHES
#define MK_N_LAUNCHES 1
#endif

#define LAS __attribute__((address_space(3)))
#define GAS __attribute__((address_space(1)))
typedef unsigned short bf16_t;
typedef short bf16x8 __attribute__((ext_vector_type(8)));
typedef short s16x4 __attribute__((ext_vector_type(4)));
typedef float f32x4 __attribute__((ext_vector_type(4)));
typedef float f32x2 __attribute__((ext_vector_type(2)));
typedef float f32x16 __attribute__((ext_vector_type(16)));
typedef unsigned u32x4 __attribute__((ext_vector_type(4)));
typedef unsigned u32x2 __attribute__((ext_vector_type(2)));

constexpr int NB = 2, SEQ = 16384, NTOK = NB * SEQ, DM = 2048;
constexpr int DSSM = 1024, NG = 64, SG = 16, SP = 64, NCH = NTOK / 64;
constexpr int NH = 8, QL = 512, KVL = 256;
constexpr int DIN = 2880, DINP = 3072;
constexpr int NE = 32, DFF = 2048;
constexpr int AGW = 1152;
constexpr int MAXBLK = 544, MAXROWS = MAXBLK * 256;
constexpr float EPS = 1e-6f;
constexpr int NPHASE = 13;

constexpr size_t MiB = 1u << 20;
constexpr size_t WS_CTL = 0, CTL_BYTES = 1 * MiB;
constexpr size_t WS_MOD = 1 * MiB;
constexpr size_t WS_FAB2 = WS_MOD + 512 * 1024;
constexpr size_t WS_APOW = 2 * MiB;
constexpr size_t WS_A64 = 5 * MiB;
constexpr size_t WS_A1024 = WS_A64 + 64 * 1024;
constexpr size_t WS_BB = WS_A64 + 128 * 1024;
constexpr size_t WS_KC = 6 * MiB;
constexpr size_t WS_COS = 10 * MiB, WS_SIN = 14 * MiB;
constexpr size_t WS_RIDX = 18 * MiB;
constexpr size_t WS_RGATE = WS_RIDX + 512 * 1024;
constexpr size_t WS_RPOS = WS_RGATE + 512 * 1024;
constexpr size_t WS_SLOT = WS_RPOS + 512 * 1024;
constexpr size_t WS_ROWGATE = 20 * MiB;
constexpr size_t WS_WRT = 21 * MiB;
constexpr size_t WS_WUQ = 22 * MiB, WS_WUKV = 25 * MiB, WS_WIN = 30 * MiB, WS_WOUT = 42 * MiB, WS_WG = 50 * MiB, WS_SEND = 82 * MiB, WS_KR = 98 * MiB;
constexpr size_t WS_BTG = 104 * MiB, WS_AG = 248 * MiB, WS_GS = 320 * MiB, WS_Z2 = 384 * MiB, WS_H = 456 * MiB, WS_QRAW = 584 * MiB, WS_KVRAW = 680 * MiB;
constexpr size_t WS_Q = 808 * MiB, WS_KN = 904 * MiB, WS_V = 968 * MiB, WS_YS = 1032 * MiB, WS_YM = 1096 * MiB, WS_MIX = 1224 * MiB;
constexpr size_t WS_WGU = 1352 * MiB, WS_WDN = 1864 * MiB, WS_ACT = 2120 * MiB, WS_YB = 2664 * MiB, WS_END = 3208 * MiB;
constexpr size_t WS_XS = WS_QRAW;
static_assert(WS_XS + (size_t)MAXROWS * 2048 * 2 <= WS_MIX, "XS overlay must end before MIX");
constexpr int CW_CNT = 64;
constexpr int CW_BAR = 4096;
constexpr int CW_ATT = 128;

constexpr int RING_BYTES = 131072;
constexpr int MISC_OFF = RING_BYTES;
constexpr int LDS_BYTES = 147456;
constexpr int AUX_OFF = MISC_OFF + 4096;

__device__ __forceinline__ float wave_sum(float v) {
#pragma unroll
    for (int o = 1; o < 64; o <<= 1) v += __shfl_xor(v, o);
    return v;
}
__device__ __forceinline__ unsigned cvt_pk_bf16(float lo, float hi) { unsigned r; asm volatile("v_cvt_pk_bf16_f32 %0, %1, %2" : "=v"(r) : "v"(lo), "v"(hi)); return r; }
__device__ __forceinline__ float bf2f(unsigned short b) { return __uint_as_float(((unsigned)b) << 16); }
__device__ __forceinline__ float bflo(unsigned w) { return __uint_as_float(w << 16); }
__device__ __forceinline__ float bfhi(unsigned w) { return __uint_as_float(w & 0xffff0000u); }
__device__ __forceinline__ unsigned short f2bf(float f) { return (unsigned short)(cvt_pk_bf16(f, 0.f) & 0xffffu); }
__device__ __forceinline__ float sigmoidf_(float x) { return __builtin_amdgcn_rcpf(1.0f + __builtin_amdgcn_exp2f(-1.4426950408889634f * x)); }
__device__ __forceinline__ void sincos_d(double theta, float& c, float& s) {
    double t = theta * 0.15915494309189535; t -= rint(t);
    const double r = t * 6.283185307179586;
    const double q = rint(r * 0.6366197723675814);
    const double y = r - q * 1.5707963267948966, y2 = y * y;
    const double sn = y * (1.0 + y2 * (-1.0 / 6 + y2 * (1.0 / 120 + y2 * (-1.0 / 5040 + y2 * (1.0 / 362880 + y2 * (-1.0 / 39916800))))));
    const double cs = 1.0 + y2 * (-0.5 + y2 * (1.0 / 24 + y2 * (-1.0 / 720 + y2 * (1.0 / 40320 + y2 * (-1.0 / 3628800 + y2 * (1.0 / 479001600))))));
    const int qi = ((int)q) & 3;
    const double co = (qi == 0) ? cs : (qi == 1) ? -sn : (qi == 2) ? -cs : sn;
    const double si = (qi == 0) ? sn : (qi == 1) ? cs : (qi == 2) ? -sn : -cs;
    c = (float)co; s = (float)si;
}

#define XB_TMO      128
#define XB_XCNT(j)  (256  + 64 * (j))
#define XB_XSUB(j)  (1280 + 64 * (j))
#define XB_XGEN(j)  (2304 + 64 * (j))
#define XB_TOP      3328
#define XB_TOPGEN   3392
#define XCD_BAR_WORDS 3456
#define XB_SPIN_CAP (1u << 22)
__device__ __forceinline__ unsigned xb_ld(unsigned* p)              { return __hip_atomic_load(p, __ATOMIC_RELAXED, __HIP_MEMORY_SCOPE_AGENT); }
__device__ __forceinline__ unsigned xb_add(unsigned* p, unsigned v) { return __hip_atomic_fetch_add(p, v, __ATOMIC_RELAXED, __HIP_MEMORY_SCOPE_AGENT); }
__device__ __forceinline__ unsigned xb_xcc_id() { return (unsigned)__builtin_amdgcn_s_getreg((3 << 11) | 20) & 0xFu; }
#define XB_SPIN(cond, bar) do { unsigned _sp = 0; while (cond) { __builtin_amdgcn_s_sleep(1); \
    if ((++_sp & 255u) == 0u) { if (xb_ld(&(bar)[XB_TMO])) break; if (_sp > XB_SPIN_CAP) { atomicAdd(&(bar)[XB_TMO], 1u); break; } } } } while (0)
struct XcdBarrier { unsigned* bar; unsigned x; volatile LAS unsigned* st; };
__device__ __forceinline__ XcdBarrier xcd_barrier_post(unsigned* bar, volatile LAS unsigned* st) {
    XcdBarrier b; b.bar = bar; b.x = xb_xcc_id(); b.st = st;
    if (threadIdx.x == 0) (void)xb_add(&bar[XB_XCNT(b.x)], 1u);
    return b;
}
__device__ __forceinline__ void xcd_barrier_complete(unsigned* bar, unsigned x, unsigned& nloc, unsigned& nx) {
    const unsigned G = gridDim.x * gridDim.y * gridDim.z;
    unsigned sum, cnt, mine, sp = 0u;
    for (;;) {
        sum = 0u; cnt = 0u; mine = 0u;
#pragma unroll
        for (unsigned j = 0; j < 16; ++j) { const unsigned c = xb_ld(&bar[XB_XCNT(j)]); sum += c; cnt += (c > 0u) ? 1u : 0u; mine = (j == x) ? c : mine; }
        if (sum == G) break;
        __builtin_amdgcn_s_sleep(1);
        if ((++sp & 255u) == 0u) { if (xb_ld(&bar[XB_TMO])) break; if (sp > XB_SPIN_CAP) { atomicAdd(&bar[XB_TMO], 1u); break; } }
    }
    nloc = mine > 0u ? mine : 1u; nx = cnt > 0u ? cnt : 1u;
}
__device__ __forceinline__ void xcd_barrier(const XcdBarrier& b) {
    asm volatile("s_waitcnt vmcnt(0)" ::: "memory");
    __syncthreads();
    if (threadIdx.x == 0) {
        unsigned* bar = b.bar;
        __builtin_amdgcn_s_waitcnt(0);
        unsigned nloc = b.st[0], nx = b.st[1];
        if (nloc == 0u) { xcd_barrier_complete(bar, b.x, nloc, nx); b.st[0] = nloc; b.st[1] = nx; }
        const unsigned old = xb_add(&bar[XB_XSUB(b.x)], 1u);
        const unsigned gen = old / nloc;
        if (old + 1u == (gen + 1u) * nloc) {
            __builtin_amdgcn_fence(__ATOMIC_RELEASE, "agent");
            asm volatile("s_waitcnt vmcnt(0)" ::: "memory");
            const unsigned og = xb_add(&bar[XB_TOP], 1u);
            const unsigned tg = og / nx;
            if (og + 1u == (tg + 1u) * nx) xb_add(&bar[XB_TOPGEN], 1u);
            else XB_SPIN(xb_ld(&bar[XB_TOPGEN]) == tg, bar);
            __builtin_amdgcn_fence(__ATOMIC_ACQUIRE, "agent");
            xb_add(&bar[XB_XGEN(b.x)], 1u);
            asm volatile("s_waitcnt vmcnt(0)" ::: "memory");
        } else {
            XB_SPIN(xb_ld(&bar[XB_XGEN(b.x)]) == gen, bar);
            __builtin_amdgcn_fence(__ATOMIC_ACQUIRE, "agent");
            asm volatile("s_waitcnt vmcnt(0)" ::: "memory");
        }
    }
    __syncthreads();
}

namespace pg8 {
constexpr int BM = 256, BK = 64, HALF = 128, HTB = HALF * BK * 2, STAGE_BYTES = 8 * HTB, NXCD = 8, WGM = 8;
__host__ __device__ __forceinline__ int lds_byte(int r, int c) { const int st = (r >> 4) * 2 + (c >> 5), rr = r & 15, cc = c & 31, ob = rr * 64 + cc * 2; return st * 1024 + (ob ^ (((ob >> 9) & 1) << 5)); }
__host__ __device__ __forceinline__ void stage_rc(int b, int& R, int& C) { const int st = b / 1024, sb = b % 1024, swz = sb ^ (((sb >> 9) & 1) << 5); R = (st >> 1) * 16 + swz / 64; C = (st & 1) * 32 + (swz % 64) / 2; }
__host__ __device__ __forceinline__ int perm32(int rho) { const int n = rho >> 4, i = rho & 15; return 8 * (i >> 2) + 4 * n + (i & 3); }

struct Unit { const char* A; const char* B; int nt, pm, pn, aux; };

__device__ __forceinline__ void dense_map(int L, int nM, int nN, int& pm, int& pn) {
    const int nwg = nM * nN; int wgid = L;
    { const int q = nwg / NXCD, r = nwg % NXCD, xcd = wgid % NXCD, off = wgid / NXCD; wgid = (xcd < r ? xcd * (q + 1) : r * (q + 1) + (xcd - r) * q) + off; }
    const int nig = WGM * nN, gid = wgid / nig, fm = gid * WGM, gsz = (nM - fm) < WGM ? (nM - fm) : WGM;
    pm = fm + ((wgid % nig) % gsz); pn = (wgid % nig) / gsz;
}

typedef int v8i_t __attribute__((ext_vector_type(8)));
typedef int v4i_t __attribute__((ext_vector_type(4)));
template <class Epi, class Sched, bool FP8 = false, int PRB = 0>
__device__ __forceinline__ void gemm_phase(LAS unsigned char* lds, const unsigned lda, const unsigned ldb, const Sched& S, const Epi& E) {
    const int tid = threadIdx.x, wid = __builtin_amdgcn_readfirstlane(tid >> 6), lane = tid & 63, wr = wid >> 2, wc = wid & 3, fr = lane & 15, fq = lane >> 4;
    unsigned voffA[2], voffB[2];
#pragma unroll
    for (int i = 0; i < 2; ++i) { int R, C; stage_rc(tid * 16 + i * 8192, R, C); const int Rb = Epi::PERM ? ((R & ~31) + perm32(R & 31)) : R;
        voffA[i] = (unsigned)R * lda + (unsigned)C * 2u; voffB[i] = (unsigned)Rb * ldb + (unsigned)C * 2u; }
    const size_t kstep = (size_t)(BK * 2);
    const size_t hstepA = (size_t)HALF * lda, hstepB = (size_t)HALF * ldb;
    const unsigned ldsw = (unsigned)wid * 1024u;
    const int aoff = lds_byte(wr * 64 + fr, fq * 8), boff = lds_byte(wc * 32 + fr, fq * 8);
#define PG8_SA(b, h) (((b) * 2 + (h)) * HTB)
#define PG8_SB(b, h) ((4 + (b) * 2 + (h)) * HTB)
#define PG8_STAGE(bufoff, gbase, voff) do { if constexpr (PRB != 1) { _Pragma("unroll") for (int _i = 0; _i < 2; ++_i) \
        __builtin_amdgcn_global_load_lds((const unsigned*)((const char*)(gbase) + (voff)[_i]), (LAS unsigned*)(lds + (bufoff) + ldsw + _i * 8192), 16, 0, 0); } } while (0)
#define PG8_LDA(dst, b, h) do { _Pragma("unroll") for (int m = 0; m < 4; ++m) { const v4i_t lo_ = *(const LAS v4i_t*)(lds + PG8_SA(b, h) + aoff + m * 2048), hi_ = *(const LAS v4i_t*)(lds + PG8_SA(b, h) + aoff + m * 2048 + 1024); dst[m] = __builtin_shufflevector(lo_, hi_, 0, 1, 2, 3, 4, 5, 6, 7); } } while (0)
#define PG8_LDB(dst, b, h) do { _Pragma("unroll") for (int n = 0; n < 2; ++n) { const v4i_t lo_ = *(const LAS v4i_t*)(lds + PG8_SB(b, h) + boff + n * 2048), hi_ = *(const LAS v4i_t*)(lds + PG8_SB(b, h) + boff + n * 2048 + 1024); dst[n] = __builtin_shufflevector(lo_, hi_, 0, 1, 2, 3, 4, 5, 6, 7); } } while (0)
#define PG8_LO(x) __builtin_bit_cast(bf16x8, __builtin_shufflevector(x, x, 0, 1, 2, 3))
#define PG8_HI(x) __builtin_bit_cast(bf16x8, __builtin_shufflevector(x, x, 4, 5, 6, 7))
#define PG8_MMA(ai, bj, At, Bt) do { __builtin_amdgcn_s_setprio(1); \
        if constexpr (PRB == 2) {} else if constexpr (FP8) { _Pragma("unroll") for (int m = 0; m < 4; ++m) _Pragma("unroll") for (int n = 0; n < 2; ++n) \
            asm volatile("v_mfma_f32_16x16x128_f8f6f4 %0, %1, %2, %0" : "+v"(acc[ai][bj][m][n]) : "v"(Bt[n]), "v"(At[m])); \
            asm volatile("s_nop 7" ::: "memory"); } \
        else { _Pragma("unroll") for (int m = 0; m < 4; ++m) _Pragma("unroll") for (int n = 0; n < 2; ++n) { \
            acc[ai][bj][m][n] = __builtin_amdgcn_mfma_f32_16x16x32_bf16(PG8_LO(Bt[n]), PG8_LO(At[m]), acc[ai][bj][m][n], 0, 0, 0); \
            acc[ai][bj][m][n] = __builtin_amdgcn_mfma_f32_16x16x32_bf16(PG8_HI(Bt[n]), PG8_HI(At[m]), acc[ai][bj][m][n], 0, 0, 0); } } \
        __builtin_amdgcn_s_setprio(0); } while (0)
#define PG8_WAIT_V(n) asm volatile("s_waitcnt vmcnt(" #n ")" ::: "memory")
#define PG8_WAIT_L(n) asm volatile("s_waitcnt lgkmcnt(" #n ")" ::: "memory")
#define PG8_BAR __builtin_amdgcn_s_barrier()
#define PG8_SCHED __builtin_amdgcn_sched_barrier(0)
    Unit cur, nxt; int ui = 0;
    if (!S.next(0, cur)) return;
    if constexpr (Epi::AUXT) E.prefetch(cur, lds + AUX_OFF, wid, lane);
    f32x4 acc[2][2][4][2];
#pragma unroll
    for (int a = 0; a < 2; ++a)
#pragma unroll
        for (int b = 0; b < 2; ++b)
#pragma unroll
            for (int m = 0; m < 4; ++m)
#pragma unroll
                for (int n = 0; n < 2; ++n) acc[a][b][m][n] = (f32x4){0.f, 0.f, 0.f, 0.f};
    v8i_t At[4], B0[2], B1[2];
    const char* cA = cur.A; const char* cB = cur.B;
    PG8_STAGE(PG8_SB(0, 0), cB, voffB); PG8_STAGE(PG8_SA(0, 0), cA, voffA); PG8_STAGE(PG8_SB(0, 1), cB + hstepB, voffB); PG8_STAGE(PG8_SA(0, 1), cA + hstepA, voffA);
    if (wr == 1) PG8_BAR;
    PG8_WAIT_V(4); PG8_BAR;
    PG8_STAGE(PG8_SB(1, 0), cB + kstep, voffB); PG8_STAGE(PG8_SA(1, 0), cA + kstep, voffA); PG8_STAGE(PG8_SB(1, 1), cB + hstepB + kstep, voffB);
    PG8_WAIT_V(6); PG8_BAR;
    for (;;) {
        const bool has_next = S.next(ui + 1, nxt);
        const char* nA = has_next ? nxt.A : cA; const char* nB = has_next ? nxt.B : cB;
        const int nt = cur.nt;
        for (int t = 0; t < nt; t += 2) {
            const bool last = (t == nt - 2);
            if constexpr (Epi::AUXT) { if (last && has_next) E.prefetch(nxt, lds + AUX_OFF + ((ui + 1) & 1) * 2048, wid, lane); }
            const char* a1 = cA + (size_t)(t + 1) * kstep;
            const char* a2 = last ? nA : cA + (size_t)(t + 2) * kstep; const char* b2 = last ? nB : cB + (size_t)(t + 2) * kstep;
            const char* a3 = a2 + kstep; const char* b3 = b2 + kstep;
            PG8_LDB(B0, 0, 0); PG8_SCHED; PG8_LDA(At, 0, 0); PG8_STAGE(PG8_SA(1, 1), a1 + hstepA, voffA);
            PG8_WAIT_L(8); PG8_BAR; PG8_WAIT_L(0); PG8_MMA(0, 0, At, B0); PG8_BAR; PG8_SCHED;
            PG8_LDB(B1, 0, 1); PG8_STAGE(PG8_SB(0, 0), b2, voffB);
            PG8_BAR; PG8_WAIT_L(0); PG8_MMA(0, 1, At, B1); PG8_BAR;
            PG8_LDA(At, 0, 1); PG8_STAGE(PG8_SA(0, 0), a2, voffA);
            PG8_BAR; PG8_WAIT_L(0); PG8_MMA(1, 0, At, B0); PG8_BAR; PG8_SCHED;
            PG8_STAGE(PG8_SB(0, 1), b2 + hstepB, voffB);
            PG8_WAIT_V(6); PG8_BAR; PG8_MMA(1, 1, At, B1); PG8_BAR;
            PG8_LDB(B0, 1, 0); PG8_SCHED; PG8_LDA(At, 1, 0); PG8_STAGE(PG8_SA(0, 1), a2 + hstepA, voffA);
            PG8_WAIT_L(8); PG8_BAR; PG8_WAIT_L(0); PG8_MMA(0, 0, At, B0); PG8_BAR; PG8_SCHED;
            PG8_LDB(B1, 1, 1); PG8_STAGE(PG8_SB(1, 0), b3, voffB);
            PG8_BAR; PG8_WAIT_L(0); PG8_MMA(0, 1, At, B1); PG8_BAR;
            PG8_LDA(At, 1, 1); PG8_STAGE(PG8_SA(1, 0), a3, voffA);
            PG8_BAR; PG8_WAIT_L(0); PG8_MMA(1, 0, At, B0); PG8_BAR; PG8_SCHED;
            PG8_STAGE(PG8_SB(1, 1), b3 + hstepB, voffB);
            PG8_WAIT_V(6); PG8_BAR; PG8_MMA(1, 1, At, B1); PG8_BAR;
        }
        if constexpr (FP8) asm volatile("s_nop 15\n\ts_nop 15" ::: "memory");
        if constexpr (PRB == 0) { if constexpr (Epi::AUXT) E(acc, cur, wr, wc, fr, fq, lds + AUX_OFF + (ui & 1) * 2048); else E(acc, cur, wr, wc, fr, fq); }
        if (!has_next) break;
#pragma unroll
        for (int a = 0; a < 2; ++a)
#pragma unroll
            for (int b = 0; b < 2; ++b)
#pragma unroll
                for (int m = 0; m < 4; ++m)
#pragma unroll
                    for (int n = 0; n < 2; ++n) acc[a][b][m][n] = (f32x4){0.f, 0.f, 0.f, 0.f};
        cur = nxt; cA = nA; cB = nB; ++ui;
    }
    PG8_WAIT_V(0);
    if (wr == 0) PG8_BAR;
    PG8_BAR;
#undef PG8_SA
#undef PG8_SB
#undef PG8_STAGE
#undef PG8_LDA
#undef PG8_LDB
#undef PG8_LO
#undef PG8_HI
#undef PG8_MMA
#undef PG8_WAIT_V
#undef PG8_WAIT_L
#undef PG8_BAR
#undef PG8_SCHED
}
}
using pg8::Unit;

struct SchedDense {
    const char* A; const char* B; unsigned lda, ldb; int nM, nN, nt, G, c;
    __device__ __forceinline__ bool next(int i, Unit& u) const {
        const long L = (long)i * G + c; if (L >= (long)nM * nN) return false;
        int pm, pn; pg8::dense_map((int)L, nM, nN, pm, pn);
        u.A = A + (size_t)pm * 256 * lda; u.B = B + (size_t)pn * 256 * ldb; u.nt = nt; u.pm = pm; u.pn = pn; u.aux = 0; return true;
    }
};
struct SchedP3 {
    const char* AG; const char* WG; const char* Z2; const char* WUQ; const char* WUKV; int G, c;
    __device__ __forceinline__ bool next(int i, Unit& u) const {
        int kind, L;
        if (G == 256) {
            if (c < 128) { if (i == 0) { kind = 2; L = c; } else if (i <= 3) { kind = 0; L = (i - 1) * 256 + c; } else if (i == 4) { kind = 0; L = 2 * 256 + c + 128; } else if (i == 5) { kind = 1; L = 3 * 256 + c; } else return false; }
            else { if (i <= 1) { kind = 0; L = i * 256 + c; } else if (i <= 5) { kind = 1; L = (i - 2) * 256 + c; } else if (i <= 8) { kind = 1; L = (i - 6) * 256 + (c - 128); } else return false; }
        } else { const int Lg = i * G + c; if (Lg < 128) { kind = 2; L = Lg; } else if (Lg < 896) { kind = 0; L = Lg - 128; } else if (Lg < 1920) { kind = 1; L = Lg - 896; } else return false; }
        if (kind == 2) { const int g = L >> 1, pmm = L & 1; u.A = AG + ((size_t)(g * NCH + pmm * 256) * AGW + 128) * 2; u.B = WG + (size_t)g * 256 * 1024 * 2; u.nt = 16; u.pm = g * 2 + pmm; u.pn = 0; u.aux = 2; return true; }
        if (kind == 0) { int pm, pn; pg8::dense_map(L, 128, 6, pm, pn); u.A = Z2 + (size_t)pm * 256 * (AGW * 2); u.B = WUQ + (size_t)pn * 256 * 2048; u.nt = 8; u.pm = pm; u.pn = pn; u.aux = 0; return true; }
        { int pm, pn; pg8::dense_map(L, 128, 8, pm, pn); u.A = Z2 + (size_t)pm * 256 * (AGW * 2) + 1024; u.B = WUKV + (size_t)pn * 256 * 2048; u.nt = 4; u.pm = pm; u.pn = pn; u.aux = 1; return true; }
    }
};
struct SchedSsm {
    const char* AG; const char* BTG; int G, c;
    __device__ __forceinline__ bool next(int i, Unit& u) const {
        int pn, gp;
        if (G == 256) { if (i > 1) return false; pn = (i == 0) ? ((c < 128) ? 3 : 2) : ((c < 128) ? 0 : 1); gp = c & 127; }
        else { const int L = i * G + c; if (L >= 512) return false; pn = 3 - (L >> 7); gp = L & 127; }
        const int g = gp >> 1, pmm = gp & 1;
        u.A = AG + (size_t)(g * NCH + pmm * 256) * AGW * 2; u.B = BTG + ((size_t)g * 1024 + pn * 256) * AGW * 2; u.nt = 2 + 4 * (pn + 1); u.pm = pmm; u.pn = pn; u.aux = g; return true;
    }
};
struct SchedMoe {
    const char* A; const char* W; const volatile LAS int* tab; int NPN, G, c; size_t wstride; unsigned rowb; int nt;
    __device__ __forceinline__ bool next(int i, Unit& u) const {
        const int total = __builtin_amdgcn_readfirstlane(tab[64]);
        int grb, pn;
        if ((G & 255) == 0) {
            const int L = i * G + c, x = L & 7, j = (L >> 3) & 31, R = (L >> 8) * 8 + x;
            const int s = (NPN == 16) ? (R >> 1) : R;
            grb = 4 * s + (j & 3); pn = ((NPN == 16) ? 8 * (R & 1) : 0) + (j >> 2);
            if (4 * s >= total) return false;
            if (grb >= total) { grb = total - 1; u.aux = -1; }
        } else { const int L = i * G + c; if (L >= total * NPN) return false; grb = L / NPN; pn = L % NPN; }
        const int e = __builtin_amdgcn_readfirstlane(tab[128 + grb]);
        u.A = A + (size_t)grb * 256 * rowb; u.B = W + (size_t)e * wstride + (size_t)pn * 256 * rowb; u.nt = nt; u.pm = grb; u.pn = pn; u.aux = e; return true;
    }
};

struct EpiZ {
    static constexpr bool PERM = true; static constexpr bool AUXT = false;
    bf16_t* AG; bf16_t* GS; bf16_t* Z2;
    __device__ __forceinline__ void operator()(const f32x4 (&acc)[2][2][4][2], const Unit& u, int wr, int wc, int fr, int fq) const {
        const int row0 = u.pm * 256 + wr * 64 + fr, colt = u.pn * 256 + wc * 32 + 8 * fq;
#pragma unroll
        for (int ai = 0; ai < 2; ++ai)
#pragma unroll
            for (int m = 0; m < 4; ++m) { const int row = row0 + ai * 128 + m * 16; const int chunk = row >> 6, j = row & 63;
#pragma unroll
                for (int bj = 0; bj < 2; ++bj) { const int col = colt + bj * 128; const f32x4 v0 = acc[ai][bj][m][0], v1 = acc[ai][bj][m][1];
                    u32x4 w; w.x = cvt_pk_bf16(v0[0], v0[1]); w.y = cvt_pk_bf16(v0[2], v0[3]); w.z = cvt_pk_bf16(v1[0], v1[1]); w.w = cvt_pk_bf16(v1[2], v1[3]);
                    bf16_t* dst;
                    if (u.pn < 4) { const int g = col >> 4, h0 = col & 15; dst = AG + ((size_t)(g * NCH + chunk) * AGW + 128 + j * 16 + h0); }
                    else if (u.pn < 8) { const int ch = col - 1024, g = ch >> 4, h0 = ch & 15; dst = GS + ((size_t)(g * NCH + chunk) * 1024 + j * 16 + h0); }
                    else dst = Z2 + (size_t)row * AGW + (col - 2048);
                    *(u32x4*)dst = w; } }
    }
};
struct EpiP3 {
    static constexpr bool PERM = true; static constexpr bool AUXT = false;
    bf16_t* QRAW; bf16_t* KVRAW; float* SEND;
    __device__ __forceinline__ void operator()(const f32x4 (&acc)[2][2][4][2], const Unit& u, int wr, int wc, int fr, int fq) const {
        if (u.aux == 2) {
            const int row0 = u.pm * 256 + wr * 64 + fr, col0 = wc * 32 + 8 * fq;
#pragma unroll
            for (int ai = 0; ai < 2; ++ai)
#pragma unroll
                for (int m = 0; m < 4; ++m) { float* rowp = SEND + (size_t)(row0 + ai * 128 + m * 16) * 128 + col0;
                    *(f32x4*)rowp = acc[ai][0][m][0]; *(f32x4*)(rowp + 4) = acc[ai][0][m][1]; }
        } else {
            bf16_t* O = (u.aux == 0) ? QRAW : KVRAW; const int ldc = (u.aux == 0) ? 1536 : 2048;
            const int row0 = u.pm * 256 + wr * 64 + fr, col0 = u.pn * 256 + wc * 32 + 8 * fq;
#pragma unroll
            for (int ai = 0; ai < 2; ++ai)
#pragma unroll
                for (int m = 0; m < 4; ++m) { bf16_t* rowp = O + (size_t)(row0 + ai * 128 + m * 16) * ldc + col0;
#pragma unroll
                    for (int bj = 0; bj < 2; ++bj) { const f32x4 v0 = acc[ai][bj][m][0], v1 = acc[ai][bj][m][1];
                        u32x4 w; w.x = cvt_pk_bf16(v0[0], v0[1]); w.y = cvt_pk_bf16(v0[2], v0[3]); w.z = cvt_pk_bf16(v1[0], v1[1]); w.w = cvt_pk_bf16(v1[2], v1[3]);
                        *(u32x4*)(rowp + bj * 128) = w; } }
        }
    }
};
__device__ __forceinline__ float gelu_tanh(float x) { const float u = 0.7978845608028654f * (x + 0.044715f * x * x * x); return x * sigmoidf_(2.0f * u); }
struct EpiSsm {
    static constexpr bool PERM = true; static constexpr bool AUXT = false;
    const bf16_t* GS; bf16_t* YS;
    __device__ __forceinline__ void operator()(const f32x4 (&acc)[2][2][4][2], const Unit& u, int wr, int wc, int fr, int fq) const {
        const int g = u.aux, row0 = u.pm * 256 + wr * 64 + fr, colt = u.pn * 256 + wc * 32 + 8 * fq;
#pragma unroll
        for (int ai = 0; ai < 2; ++ai)
#pragma unroll
            for (int m = 0; m < 4; ++m) { const int chunk = row0 + ai * 128 + m * 16;
#pragma unroll
                for (int bj = 0; bj < 2; ++bj) { const int col = colt + bj * 128, l = col >> 4, h0 = col & 15;
                    const u32x4 gw = *(const u32x4*)(GS + ((size_t)(g * NCH + chunk) * 1024 + col));
                    const f32x4 v0 = acc[ai][bj][m][0], v1 = acc[ai][bj][m][1];
                    float o[8];
                    o[0] = gelu_tanh(v0[0]) * sigmoidf_(bflo(gw.x)); o[1] = gelu_tanh(v0[1]) * sigmoidf_(bfhi(gw.x));
                    o[2] = gelu_tanh(v0[2]) * sigmoidf_(bflo(gw.y)); o[3] = gelu_tanh(v0[3]) * sigmoidf_(bfhi(gw.y));
                    o[4] = gelu_tanh(v1[0]) * sigmoidf_(bflo(gw.z)); o[5] = gelu_tanh(v1[1]) * sigmoidf_(bfhi(gw.z));
                    o[6] = gelu_tanh(v1[2]) * sigmoidf_(bflo(gw.w)); o[7] = gelu_tanh(v1[3]) * sigmoidf_(bfhi(gw.w));
                    u32x4 w; w.x = cvt_pk_bf16(o[0], o[1]); w.y = cvt_pk_bf16(o[2], o[3]); w.z = cvt_pk_bf16(o[4], o[5]); w.w = cvt_pk_bf16(o[6], o[7]);
                    *(u32x4*)(YS + ((size_t)(chunk * 64 + l) * 1024 + g * 16 + h0)) = w; } }
    }
};
#ifndef OUT_FP8
#define OUT_FP8 0
#endif
struct EpiOut {
    static constexpr float OUT_SC = OUT_FP8 ? (1.0f / 64.0f) : 1.0f;
    static constexpr bool PERM = true; static constexpr bool AUXT = false;
    const float* X; bf16_t* X1B; const float* MOD;
    __device__ __forceinline__ void operator()(const f32x4 (&acc)[2][2][4][2], const Unit& u, int wr, int wc, int fr, int fq) const {
        const int row0 = u.pm * 256 + wr * 64 + fr, col0 = u.pn * 256 + wc * 32 + 8 * fq;
        const int b = (u.pm * 256) >> 14;
        f32x4 gv[2][2];
#pragma unroll
        for (int bj = 0; bj < 2; ++bj)
#pragma unroll
            for (int n = 0; n < 2; ++n) gv[bj][n] = *(const f32x4*)(MOD + b * 12288 + 4096 + col0 + bj * 128 + 4 * n);
#pragma unroll
        for (int ai = 0; ai < 2; ++ai)
#pragma unroll
            for (int m = 0; m < 4; ++m) { const size_t off = (size_t)(row0 + ai * 128 + m * 16) * DM + col0;
#pragma unroll
                for (int bj = 0; bj < 2; ++bj) { const f32x4 x0 = *(const f32x4*)(X + off + bj * 128), x1 = *(const f32x4*)(X + off + bj * 128 + 4);
                    const f32x4 v0 = x0 + gv[bj][0] * (acc[ai][bj][m][0] * OUT_SC), v1 = x1 + gv[bj][1] * (acc[ai][bj][m][1] * OUT_SC);
                    u32x4 w; w.x = cvt_pk_bf16(v0[0], v0[1]); w.y = cvt_pk_bf16(v0[2], v0[3]); w.z = cvt_pk_bf16(v1[0], v1[1]); w.w = cvt_pk_bf16(v1[2], v1[3]);
                    *(u32x4*)(X1B + off + bj * 128) = w; } }
    }
};
__device__ __forceinline__ unsigned pk4_fp8(float a, float b, float c, float d) { unsigned w = 0u; w = __builtin_amdgcn_cvt_pk_fp8_f32(a, b, w, false); w = __builtin_amdgcn_cvt_pk_fp8_f32(c, d, w, true); return w; }
constexpr float W8_SCALE = 64.0f, W8_INV = 1.0f / 64.0f;
__device__ __forceinline__ u32x4 pair16(const u32x2& X, const u32x2& Y) {
    const auto r0 = __builtin_amdgcn_permlane16_swap(X.x, Y.x, false, false), r1 = __builtin_amdgcn_permlane16_swap(X.y, Y.y, false, false);
    return (u32x4){r0[0], r1[0], r0[1], r1[1]};
}
struct EpiGu {
    static constexpr bool PERM = true; static constexpr bool AUXT = true;
    const float* BGU; unsigned char* ACT;
    __device__ __forceinline__ void prefetch(const Unit& u, LAS unsigned char* aux, int wid, int lane) const {
        if (wid == 0) __builtin_amdgcn_global_load_lds((const unsigned*)(BGU + (size_t)u.aux * 4096 + u.pn * 256 + lane * 4), (LAS unsigned*)aux, 16, 0, 0);
    }
    __device__ __forceinline__ void operator()(const f32x4 (&acc)[2][2][4][2], const Unit& u, int wr, int wc, int fr, int fq, const LAS unsigned char* aux) const {
        const int row0 = u.pm * 256 + wr * 64 + fr, j0 = u.pn * 128 + wc * 32 + 8 * fq;
        const LAS f32x4* bp = (const LAS f32x4*)(aux + (wc * 32 + 8 * fq) * 8);
        const f32x4 b0 = bp[0], b1 = bp[1], b2 = bp[2], b3 = bp[3];
        const float bg[8] = {b0[0], b0[2], b1[0], b1[2], b2[0], b2[2], b3[0], b3[2]}, bu[8] = {b0[1], b0[3], b1[1], b1[3], b2[1], b2[3], b3[1], b3[3]};
        constexpr float SC = MOE_FP8 ? W8_INV : 1.0f;
        const bool odd = (fq & 1) != 0;
#pragma unroll
        for (int ai = 0; ai < 2; ++ai)
#pragma unroll
            for (int mp = 0; mp < 2; ++mp) { u32x2 wq[2];
#pragma unroll
                for (int mm = 0; mm < 2; ++mm) { const int m = 2 * mp + mm; float o[8];
#pragma unroll
                    for (int n = 0; n < 2; ++n)
#pragma unroll
                        for (int e = 0; e < 4; ++e) { float gt = acc[ai][0][m][n][e] * SC + bg[4 * n + e], up = acc[ai][1][m][n][e] * SC + bu[4 * n + e];
                            gt = fminf(gt, 7.0f); up = fminf(fmaxf(up, -7.0f), 7.0f); o[4 * n + e] = (up + 1.0f) * gt * sigmoidf_(1.702f * gt); }
                    wq[mm].x = pk4_fp8(o[0], o[1], o[2], o[3]); wq[mm].y = pk4_fp8(o[4], o[5], o[6], o[7]); }
                const u32x4 w = pair16(wq[0], wq[1]);
                *(u32x4*)(ACT + (size_t)(row0 + ai * 128 + (2 * mp + (odd ? 1 : 0)) * 16) * 2048 + (odd ? j0 - 8 : j0)) = w; }
    }
};
constexpr float YB_SCALE = 16.0f, YB_INV = 1.0f / 16.0f;
struct EpiDn {
    static constexpr bool PERM = true; static constexpr bool AUXT = true;
    const float* BD; const float* ROWGATE; unsigned char* YB;
    __device__ __forceinline__ void prefetch(const Unit& u, LAS unsigned char* aux, int wid, int lane) const {
        if (wid == 0) __builtin_amdgcn_global_load_lds((const unsigned*)(BD + (size_t)u.aux * 2048 + u.pn * 256 + lane * 4), (LAS unsigned*)aux, 16, 0, 0);
        if (wid == 1) __builtin_amdgcn_global_load_lds((const unsigned*)(ROWGATE + (size_t)u.pm * 256 + lane * 4), (LAS unsigned*)(aux + 1024), 16, 0, 0);
    }
    __device__ __forceinline__ void operator()(const f32x4 (&acc)[2][2][4][2], const Unit& u, int wr, int wc, int fr, int fq, const LAS unsigned char* aux) const {
        const int row0 = u.pm * 256 + wr * 64 + fr, col0 = u.pn * 256 + wc * 32 + 8 * fq;
        f32x4 bv[2][2];
#pragma unroll
        for (int bj = 0; bj < 2; ++bj)
#pragma unroll
            for (int n = 0; n < 2; ++n) bv[bj][n] = *(const LAS f32x4*)(aux + (wc * 32 + 8 * fq + bj * 128 + 4 * n) * 4);
        const LAS float* gp = (const LAS float*)(aux + 1024) + wr * 64 + fr;
        const bool odd = (fq & 1) != 0;
#pragma unroll
        for (int ai = 0; ai < 2; ++ai)
#pragma unroll
            for (int m = 0; m < 4; ++m) { const int row = row0 + ai * 128 + m * 16; const float gt = gp[ai * 128 + m * 16] * YB_SCALE; u32x2 wq[2];
#pragma unroll
                for (int bj = 0; bj < 2; ++bj) { constexpr float SC = MOE_FP8 ? W8_INV : 1.0f; const f32x4 v0 = (acc[ai][bj][m][0] * SC + bv[bj][0]) * gt, v1 = (acc[ai][bj][m][1] * SC + bv[bj][1]) * gt;
                    wq[bj].x = pk4_fp8(v0[0], v0[1], v0[2], v0[3]); wq[bj].y = pk4_fp8(v1[0], v1[1], v1[2], v1[3]); }
                const u32x4 w = pair16(wq[0], wq[1]);
                *(u32x4*)(YB + (size_t)row * 2048 + (odd ? col0 - 8 + 128 : col0)) = w; }
    }
};

namespace att {
constexpr int D = 128, NW = 8, QBLK = 32, KVBLK = 64;
constexpr float SCALE = 0.07216878364870322f;
constexpr float THR = 8.f;
#ifndef ATT_SDEPTH
#define ATT_SDEPTH 2
#endif
constexpr int SDEPTH = ATT_SDEPTH;
constexpr int LDQ = 192, LDK = 128, LDR = 64, LDO = 1024;
constexpr int SHM_V = KVBLK * D * 2, SHM_K = KVBLK * D * 2, SHM_R = KVBLK * 64 * 2;
constexpr int OFF_V = 0, OFF_K = 2 * SHM_V, OFF_R = OFF_K + 2 * SHM_K, OFF_WS = OFF_R + 2 * SHM_R, SHM_ATTN = OFF_WS + NW * 64 * 4;
#define KSWZ(row, colB) ((row) * 256 + ((colB) ^ (((row) & 15) << 4)))
#define RSWZ(row, colB) ((row) * 128 + ((colB) ^ ((((row) >> 1) & 7) << 4)))
#define SBAR() __builtin_amdgcn_sched_barrier(0)
__device__ __forceinline__ int crow(int r, int hi) { return (r & 3) + 8 * (r >> 2) + 4 * hi; }

__device__ __forceinline__ void partialSM(f32x16& p0, f32x16& p1, float& m_reg, float& mn, float& alpha) {
  constexpr float C = SCALE * 1.4426950408889634f;
  float pmax = p0[0];
#pragma unroll
  for (int r = 1; r < 16; ++r) pmax = fmaxf(pmax, p0[r]);
#pragma unroll
  for (int r = 0; r < 16; ++r) pmax = fmaxf(pmax, p1[r]);
  { auto rr = __builtin_amdgcn_permlane32_swap(__float_as_uint(pmax), __float_as_uint(pmax), false, false);
    pmax = fmaxf(__uint_as_float(rr[0]), __uint_as_float(rr[1])); }
  if (__builtin_expect(__all(pmax - m_reg <= THR / SCALE), 1)) { mn = m_reg; alpha = 1.f; }
  else { mn = fmaxf(m_reg, pmax); alpha = __builtin_amdgcn_exp2f((m_reg - mn) * C); m_reg = mn; }
  float mnC = -mn * C;
#pragma unroll
  for (int r = 0; r < 16; ++r) p0[r] = fmaf(p0[r], C, mnC);
#pragma unroll
  for (int r = 0; r < 16; ++r) p1[r] = fmaf(p1[r], C, mnC);
#pragma unroll
  for (int r = 0; r < 16; ++r) p0[r] = __builtin_amdgcn_exp2f(p0[r]);
}
__device__ __forceinline__ void finishSM(f32x16& p0, f32x16& p1, float alpha, float& l_reg, bf16x8& pa0, bf16x8& pa1, bf16x8& pa2, bf16x8& pa3) {
#pragma unroll
  for (int r = 0; r < 16; ++r) p1[r] = __builtin_amdgcn_exp2f(p1[r]);
  float ps = 0;
#pragma unroll
  for (int r = 0; r < 16; ++r) ps += p0[r];
#pragma unroll
  for (int r = 0; r < 16; ++r) ps += p1[r];
  { auto rr = __builtin_amdgcn_permlane32_swap(__float_as_uint(ps), __float_as_uint(ps), false, false);
    ps = __uint_as_float(rr[0]) + __uint_as_float(rr[1]); }
  l_reg = l_reg * alpha + ps;
#define PK4(P, BASE, OUT) do { unsigned a0 = cvt_pk_bf16(P[BASE + 0], P[BASE + 1]), a1 = cvt_pk_bf16(P[BASE + 2], P[BASE + 3]);   \
    unsigned b0 = cvt_pk_bf16(P[BASE + 4], P[BASE + 5]), b1 = cvt_pk_bf16(P[BASE + 6], P[BASE + 7]);                              \
    auto r0 = __builtin_amdgcn_permlane32_swap(a0, b0, false, false); auto r1 = __builtin_amdgcn_permlane32_swap(a1, b1, false, false); \
    u32x4 w = {r0[0], r1[0], r0[1], r1[1]}; OUT = *reinterpret_cast<bf16x8*>(&w); } while (0)
  PK4(p0, 0, pa0); PK4(p0, 8, pa1); PK4(p1, 0, pa2); PK4(p1, 8, pa3);
#undef PK4
}
__device__ __forceinline__ void softmax_nomax(f32x16& p0, f32x16& p1, float& l_reg, bf16x8& pa0, bf16x8& pa1, bf16x8& pa2, bf16x8& pa3) {
#pragma unroll
  for (int r = 0; r < 16; ++r) p0[r] = __builtin_amdgcn_exp2f(p0[r]);
#pragma unroll
  for (int r = 0; r < 16; ++r) p1[r] = __builtin_amdgcn_exp2f(p1[r]);
  float ps = 0;
#pragma unroll
  for (int r = 0; r < 16; ++r) ps += p0[r];
#pragma unroll
  for (int r = 0; r < 16; ++r) ps += p1[r];
  l_reg += ps;
#define PK4(P, BASE, OUT) do { unsigned a0 = cvt_pk_bf16(P[BASE + 0], P[BASE + 1]), a1 = cvt_pk_bf16(P[BASE + 2], P[BASE + 3]);   \
    unsigned b0 = cvt_pk_bf16(P[BASE + 4], P[BASE + 5]), b1 = cvt_pk_bf16(P[BASE + 6], P[BASE + 7]);                              \
    auto r0 = __builtin_amdgcn_permlane32_swap(a0, b0, false, false); auto r1 = __builtin_amdgcn_permlane32_swap(a1, b1, false, false); \
    u32x4 w = {r0[0], r1[0], r0[1], r1[1]}; OUT = *reinterpret_cast<bf16x8*>(&w); } while (0)
  PK4(p0, 0, pa0); PK4(p0, 8, pa1); PK4(p1, 0, pa2); PK4(p1, 8, pa3);
#undef PK4
}
__device__ __forceinline__ void qkt(f32x16& p0, f32x16& p1, const char* Ks, const char* Rs, const bf16x8* qr, int r32, int hi, bool masked) {
  p0 = f32x16{}; p1 = f32x16{};
#pragma unroll
  for (int d0 = 0; d0 < 8; ++d0) { int cb = (d0 * 16 + hi * 8) * 2;
    bf16x8 b0 = *reinterpret_cast<const bf16x8*>(Ks + KSWZ(r32, cb));
    bf16x8 b1 = *reinterpret_cast<const bf16x8*>(Ks + KSWZ(32 + r32, cb));
    p0 = __builtin_amdgcn_mfma_f32_32x32x16_bf16(b0, qr[d0], p0, 0, 0, 0);
    p1 = __builtin_amdgcn_mfma_f32_32x32x16_bf16(b1, qr[d0], p1, 0, 0, 0); }
#pragma unroll
  for (int d0 = 0; d0 < 4; ++d0) { int cb = (d0 * 16 + hi * 8) * 2;
    bf16x8 b0 = *reinterpret_cast<const bf16x8*>(Rs + RSWZ(r32, cb));
    bf16x8 b1 = *reinterpret_cast<const bf16x8*>(Rs + RSWZ(32 + r32, cb));
    p0 = __builtin_amdgcn_mfma_f32_32x32x16_bf16(b0, qr[8 + d0], p0, 0, 0, 0);
    p1 = __builtin_amdgcn_mfma_f32_32x32x16_bf16(b1, qr[8 + d0], p1, 0, 0, 0); }
  (void)masked;
}
__device__ __forceinline__ int v_st(int k, int c) { const int kk = (k & ~0xC) | ((k & 4) << 1) | ((k & 8) >> 1); return ((kk >> 3) * 4 + (c >> 5)) * 512 + ((kk & 7) * 32 + (c & 31)) * 2; }
__device__ __forceinline__ int v_rd_base(int lane) { return ((lane & 3) << 3) | (((lane >> 2) & 3) << 6) | (((lane >> 4) & 1) << 5) | (((lane >> 5) & 1) << 8); }
constexpr int v_rd_off(int d0, int ks, int half) { return d0 * 512 + ks * 4096 + half * 2048; }
template <int OFF> __device__ __forceinline__ s16x4 tr_read(int vb) {
  s16x4 r; asm volatile("ds_read_b64_tr_b16 %0, %1 offset:%2" : "=&v"(r) : "v"(vb), "i"(OFF) : "memory"); return r;
}
template <int D0> __device__ __forceinline__ void pv_one(f32x16& od, int vb, bf16x8 pa0, bf16x8 pa1, bf16x8 pa2, bf16x8 pa3) {
  const s16x4 l0 = tr_read<v_rd_off(D0, 0, 0)>(vb), h0 = tr_read<v_rd_off(D0, 0, 1)>(vb), l1 = tr_read<v_rd_off(D0, 1, 0)>(vb), h1 = tr_read<v_rd_off(D0, 1, 1)>(vb);
  const s16x4 l2 = tr_read<v_rd_off(D0, 2, 0)>(vb), h2 = tr_read<v_rd_off(D0, 2, 1)>(vb), l3 = tr_read<v_rd_off(D0, 3, 0)>(vb), h3 = tr_read<v_rd_off(D0, 3, 1)>(vb);
  asm volatile("s_waitcnt lgkmcnt(0)" ::: "memory"); SBAR();
#define PK(L, H) (bf16x8){L[0], L[1], L[2], L[3], H[0], H[1], H[2], H[3]}
  od = __builtin_amdgcn_mfma_f32_32x32x16_bf16(pa0, PK(l0, h0), od, 0, 0, 0);
  od = __builtin_amdgcn_mfma_f32_32x32x16_bf16(pa1, PK(l1, h1), od, 0, 0, 0);
  od = __builtin_amdgcn_mfma_f32_32x32x16_bf16(pa2, PK(l2, h2), od, 0, 0, 0);
  od = __builtin_amdgcn_mfma_f32_32x32x16_bf16(pa3, PK(l3, h3), od, 0, 0, 0);
#undef PK
}
__device__ __forceinline__ void pv_d0(f32x16* o, int vb, bf16x8 pa0, bf16x8 pa1, bf16x8 pa2, bf16x8 pa3) {
  pv_one<0>(o[0], vb, pa0, pa1, pa2, pa3); pv_one<1>(o[1], vb, pa0, pa1, pa2, pa3); pv_one<2>(o[2], vb, pa0, pa1, pa2, pa3); pv_one<3>(o[3], vb, pa0, pa1, pa2, pa3);
}

#define PK(L, H) (bf16x8){L[0], L[1], L[2], L[3], H[0], H[1], H[2], H[3]}
#define PV_READ(D0, S) const s16x4 l0##S = tr_read<v_rd_off(D0, 0, 0)>(vb), h0##S = tr_read<v_rd_off(D0, 0, 1)>(vb), l1##S = tr_read<v_rd_off(D0, 1, 0)>(vb), h1##S = tr_read<v_rd_off(D0, 1, 1)>(vb), \
    l2##S = tr_read<v_rd_off(D0, 2, 0)>(vb), h2##S = tr_read<v_rd_off(D0, 2, 1)>(vb), l3##S = tr_read<v_rd_off(D0, 3, 0)>(vb), h3##S = tr_read<v_rd_off(D0, 3, 1)>(vb)
#define PV_MMA(D0, S) do { o[D0] = __builtin_amdgcn_mfma_f32_32x32x16_bf16(pa0, PK(l0##S, h0##S), o[D0], 0, 0, 0); o[D0] = __builtin_amdgcn_mfma_f32_32x32x16_bf16(pa1, PK(l1##S, h1##S), o[D0], 0, 0, 0); \
    o[D0] = __builtin_amdgcn_mfma_f32_32x32x16_bf16(pa2, PK(l2##S, h2##S), o[D0], 0, 0, 0); o[D0] = __builtin_amdgcn_mfma_f32_32x32x16_bf16(pa3, PK(l3##S, h3##S), o[D0], 0, 0, 0); } while (0)
__device__ __forceinline__ void pv_pipe(f32x16* o, int vb, bf16x8 pa0, bf16x8 pa1, bf16x8 pa2, bf16x8 pa3) {
  PV_READ(0, a); PV_READ(1, b);
  asm volatile("s_waitcnt lgkmcnt(8)" ::: "memory"); SBAR(); PV_MMA(0, a); SBAR();
  PV_READ(2, c);
  asm volatile("s_waitcnt lgkmcnt(8)" ::: "memory"); SBAR(); PV_MMA(1, b); SBAR();
  PV_READ(3, d);
  asm volatile("s_waitcnt lgkmcnt(8)" ::: "memory"); SBAR(); PV_MMA(2, c); SBAR();
  asm volatile("s_waitcnt lgkmcnt(0)" ::: "memory"); SBAR(); PV_MMA(3, d);
}
#undef PV_READ
#undef PV_MMA
#undef PK

constexpr int STG = SHM_V + SHM_K + SHM_R;
constexpr int OFF_WS3 = 3 * STG;
__device__ __forceinline__ void attn_block(const bf16_t* __restrict__ Qb, const bf16_t* __restrict__ Kh, const bf16_t* __restrict__ Vh, const bf16_t* __restrict__ Rh,
                                           float* __restrict__ Ob, int qb, char* lds) {
  const int tid = threadIdx.x, wid = __builtin_amdgcn_readfirstlane(tid >> 6), lane = tid & 63, r32 = lane & 31, hi = lane >> 5;
  float* ws = (float*)(lds + OFF_WS3) + wid * 64; float* li_l = ws; float* al_l = ws + 32;
  float l_reg = 0; f32x16 o[4] = {}; bf16x8 qr[12];
  const bf16_t* Qw = Qb + (long)(wid * QBLK + r32) * LDQ + hi * 8;
#pragma unroll
  for (int d0 = 0; d0 < 12; ++d0) qr[d0] = *reinterpret_cast<const bf16x8*>(Qw + d0 * 16);
  unsigned kof[2], vof[2], rof;
#pragma unroll
  for (int u = 0; u < 2; ++u) { const int c = 2 * wid + u;
    { const int row = 4 * c + (lane >> 4), slot = lane & 15; kof[u] = (unsigned)(row * 256 + ((slot ^ (row & 15)) << 4)); }
    { const int sub = 2 * c + (lane >> 5), i5 = lane & 31, kk = (sub >> 2) * 8 + (i5 >> 2), col = (sub & 3) * 32 + (i5 & 3) * 8, k = (kk & ~0xC) | ((kk & 4) << 1) | ((kk & 8) >> 1); vof[u] = (unsigned)(k * 256 + col * 2); } }
  { const int row = 8 * wid + (lane >> 3), slot = lane & 7; rof = (unsigned)(row * 128 + ((slot ^ ((row >> 1) & 7)) << 4)); }
  const int wchunk = wid >> 1, t0 = 4 * qb, NT = 4 * qb + 4;
  const LAS unsigned char* ldsb = (const LAS unsigned char*)lds;
#define DMA(tile, st) do { const char* kp = (const char*)Kh + (size_t)(tile) * (KVBLK * 256); const char* vp = (const char*)Vh + (size_t)(tile) * (KVBLK * 256); const char* rp = (const char*)Rh + (size_t)(tile) * (KVBLK * 128); \
    LAS unsigned char* sb = (LAS unsigned char*)ldsb + (st) * STG; \
    __builtin_amdgcn_global_load_lds((const unsigned*)(vp + vof[0]), (LAS unsigned*)(sb + (2 * wid) * 1024), 16, 0, 0); __builtin_amdgcn_global_load_lds((const unsigned*)(vp + vof[1]), (LAS unsigned*)(sb + (2 * wid + 1) * 1024), 16, 0, 0); \
    __builtin_amdgcn_global_load_lds((const unsigned*)(kp + kof[0]), (LAS unsigned*)(sb + SHM_V + (2 * wid) * 1024), 16, 0, 0); __builtin_amdgcn_global_load_lds((const unsigned*)(kp + kof[1]), (LAS unsigned*)(sb + SHM_V + (2 * wid + 1) * 1024), 16, 0, 0); \
    __builtin_amdgcn_global_load_lds((const unsigned*)(rp + rof), (LAS unsigned*)(sb + SHM_V + SHM_K + wid * 1024), 16, 0, 0); } while (0)
#define RESC(a) do { if (__any((a) < 1.f)) { if (hi == 0) al_l[r32] = (a); asm volatile("s_waitcnt lgkmcnt(0)" ::: "memory"); \
    _Pragma("unroll") for (int d = 0; d < 4; ++d) _Pragma("unroll") for (int r = 0; r < 16; ++r) o[d][r] *= al_l[crow(r, hi)]; } } while (0)
#define MASKED(j) (((j) - t0) > wchunk)
  f32x16 p0, p1; bf16x8 pa0, pa1, pa2, pa3;
  DMA(0, 0); DMA(1, 1);
  asm volatile("s_waitcnt vmcnt(5)" ::: "memory"); __builtin_amdgcn_s_barrier(); asm volatile("" ::: "memory");
  int st = 0;
#pragma unroll 1
  for (int j = 0; j < NT; ++j) {
    const bool more = (j + 2 < NT);
    if (more) { const int st2 = (st >= 1) ? st - 1 : 2; DMA(j + 2, st2); }
    char* sb = lds + st * STG;
    if (!MASKED(j)) {
      SBAR(); qkt(p0, p1, sb + SHM_V, sb + SHM_V + SHM_K, qr, r32, hi, false);
      softmax_nomax(p0, p1, l_reg, pa0, pa1, pa2, pa3); SBAR();
      pv_pipe(o, (int)(uintptr_t)sb + v_rd_base(lane), pa0, pa1, pa2, pa3);
    }
    if (more) asm volatile("s_waitcnt vmcnt(5)" ::: "memory"); else asm volatile("s_waitcnt vmcnt(0)" ::: "memory");
    __builtin_amdgcn_s_barrier(); asm volatile("" ::: "memory");
    st = (st == 2) ? 0 : st + 1;
  }
  { auto rr = __builtin_amdgcn_permlane32_swap(__float_as_uint(l_reg), __float_as_uint(l_reg), false, false); l_reg = __uint_as_float(rr[0]) + __uint_as_float(rr[1]); }
  if (hi == 0) li_l[r32] = l_reg; asm volatile("s_waitcnt lgkmcnt(0)" ::: "memory");
  float rli[16];
#pragma unroll
  for (int r = 0; r < 16; ++r) rli[r] = __builtin_amdgcn_rcpf(li_l[crow(r, hi)]);
  float* Ow = Ob + (long)(wid * QBLK) * LDO;
#pragma unroll
  for (int r = 0; r < 16; ++r) { int orow = crow(r, hi);
#pragma unroll
    for (int d0 = 0; d0 < 4; ++d0) Ow[(long)orow * LDO + d0 * 32 + r32] = o[d0][r] * rli[r]; }
#undef DMA
#undef RESC
#undef MASKED
}

constexpr int S8_V = 16384, S8_K = 8192, S8_R = 4096, STG8 = S8_V + S8_K + S8_R, OFF_WS8 = 3 * STG8;
#define KS8(row, b) ((row) * 128 + ((b) ^ ((((row) >> 1) & 7) << 4)))
#define RS8(row, b) ((row) * 64 + ((b) ^ ((((row) >> 2) & 3) << 4)))
typedef int v8i_a __attribute__((ext_vector_type(8)));
typedef int v4i_a __attribute__((ext_vector_type(4)));
__device__ __forceinline__ v8i_a ld32(const char* p0, const char* p1) { const v4i_a a = *reinterpret_cast<const v4i_a*>(p0), b = *reinterpret_cast<const v4i_a*>(p1); return __builtin_shufflevector(a, b, 0, 1, 2, 3, 4, 5, 6, 7); }
__device__ __forceinline__ void qkt8(f32x16& p0, f32x16& p1, const char* Ks, const char* Rs, const v8i_a* qf, int r32, int hi, float init = 0.f) {
#pragma unroll
  for (int r = 0; r < 16; ++r) { p0[r] = init; p1[r] = init; }
#pragma unroll
  for (int s = 0; s < 2; ++s) { const int b0 = 64 * s + 32 * hi;
    const v8i_a a0 = ld32(Ks + KS8(r32, b0), Ks + KS8(r32, b0 + 16)), a1 = ld32(Ks + KS8(32 + r32, b0), Ks + KS8(32 + r32, b0 + 16));
    p0 = __builtin_amdgcn_mfma_scale_f32_32x32x64_f8f6f4(a0, qf[s], p0, 0, 0, 0, 0, 0, 0);
    p1 = __builtin_amdgcn_mfma_scale_f32_32x32x64_f8f6f4(a1, qf[s], p1, 0, 0, 0, 0, 0, 0); }
  { const int b0 = 32 * hi;
    const v8i_a a0 = ld32(Rs + RS8(r32, b0), Rs + RS8(r32, b0 + 16)), a1 = ld32(Rs + RS8(32 + r32, b0), Rs + RS8(32 + r32, b0 + 16));
    p0 = __builtin_amdgcn_mfma_scale_f32_32x32x64_f8f6f4(a0, qf[2], p0, 0, 0, 0, 0, 0, 0);
    p1 = __builtin_amdgcn_mfma_scale_f32_32x32x64_f8f6f4(a1, qf[2], p1, 0, 0, 0, 0, 0, 0); }
}
__device__ __forceinline__ void attn_block8(const unsigned char* __restrict__ Qb, const unsigned char* __restrict__ Kh, const bf16_t* __restrict__ Vh, const unsigned char* __restrict__ Rh,
                                            float* __restrict__ Ob, int qb, char* lds) {
  const int tid = threadIdx.x, wid = __builtin_amdgcn_readfirstlane(tid >> 6), lane = tid & 63, r32 = lane & 31, hi = lane >> 5;
  float* ws = (float*)(lds + OFF_WS8) + wid * 64; float* li_l = ws;
  float l_reg = 0; f32x16 o[4] = {}; v8i_a qf[3];
  { const unsigned char* Qw = Qb + (long)(wid * QBLK + r32) * 192 + 32 * hi;
#pragma unroll
    for (int s = 0; s < 3; ++s) { const v4i_a a = *reinterpret_cast<const v4i_a*>(Qw + 64 * s), b = *reinterpret_cast<const v4i_a*>(Qw + 64 * s + 16); qf[s] = __builtin_shufflevector(a, b, 0, 1, 2, 3, 4, 5, 6, 7); } }
  unsigned vof[2], kof, rof;
#pragma unroll
  for (int u = 0; u < 2; ++u) { const int c = 2 * wid + u;
    const int sub = 2 * c + (lane >> 5), i5 = lane & 31, kk = (sub >> 2) * 8 + (i5 >> 2), col = (sub & 3) * 32 + (i5 & 3) * 8, k = (kk & ~0xC) | ((kk & 4) << 1) | ((kk & 8) >> 1); vof[u] = (unsigned)(k * 256 + col * 2); }
  { const int row = 8 * wid + (lane >> 3), slot = lane & 7; kof = (unsigned)(row * 128 + ((slot ^ ((row >> 1) & 7)) << 4)); }
  { const int row = 16 * (wid & 3) + (lane >> 2), slot = lane & 3; rof = (unsigned)(row * 64 + ((slot ^ ((row >> 2) & 3)) << 4)); }
  const int wchunk = wid >> 1, t0 = 4 * qb, NT = 4 * qb + 4;
  const LAS unsigned char* ldsb = (const LAS unsigned char*)lds;
#define DMA8(tile, st) do { const char* kp = (const char*)Kh + (size_t)(tile) * (KVBLK * 128); const char* vp = (const char*)Vh + (size_t)(tile) * (KVBLK * 256); const char* rp = (const char*)Rh + (size_t)(tile) * (KVBLK * 64); \
    LAS unsigned char* sb_ = (LAS unsigned char*)ldsb + (st) * STG8; \
    __builtin_amdgcn_global_load_lds((const unsigned*)(vp + vof[0]), (LAS unsigned*)(sb_ + (2 * wid) * 1024), 16, 0, 0); __builtin_amdgcn_global_load_lds((const unsigned*)(vp + vof[1]), (LAS unsigned*)(sb_ + (2 * wid + 1) * 1024), 16, 0, 0); \
    __builtin_amdgcn_global_load_lds((const unsigned*)(kp + kof), (LAS unsigned*)(sb_ + S8_V + wid * 1024), 16, 0, 0); \
    __builtin_amdgcn_global_load_lds((const unsigned*)(rp + rof), (LAS unsigned*)(sb_ + S8_V + S8_K + (wid & 3) * 1024), 16, 0, 0); } while (0)
#define MASKED(j) (((j) - t0) > wchunk)
  f32x16 p0, p1; bf16x8 pa0, pa1, pa2, pa3;
  DMA8(0, 0); DMA8(1, 1);
  asm volatile("s_waitcnt vmcnt(4)" ::: "memory"); __builtin_amdgcn_s_barrier(); asm volatile("" ::: "memory");
  int st = 0;
#pragma unroll 1
  for (int j = 0; j < NT; ++j) {
    const bool more = (j + 2 < NT);
    if (more) { const int st2 = (st >= 1) ? st - 1 : 2; DMA8(j + 2, st2); }
    char* sb = lds + st * STG8;
    if (!MASKED(j)) {
      SBAR(); qkt8(p0, p1, sb + S8_V, sb + S8_V + S8_K, qf, r32, hi);
      softmax_nomax(p0, p1, l_reg, pa0, pa1, pa2, pa3); SBAR();
      pv_pipe(o, (int)(uintptr_t)sb + v_rd_base(lane), pa0, pa1, pa2, pa3);
    }
    if (more) asm volatile("s_waitcnt vmcnt(4)" ::: "memory"); else asm volatile("s_waitcnt vmcnt(0)" ::: "memory");
    __builtin_amdgcn_s_barrier(); asm volatile("" ::: "memory");
    st = (st == 2) ? 0 : st + 1;
  }
  { auto rr = __builtin_amdgcn_permlane32_swap(__float_as_uint(l_reg), __float_as_uint(l_reg), false, false); l_reg = __uint_as_float(rr[0]) + __uint_as_float(rr[1]); }
  if (hi == 0) li_l[r32] = l_reg; asm volatile("s_waitcnt lgkmcnt(0)" ::: "memory");
  float rli[16];
#pragma unroll
  for (int r = 0; r < 16; ++r) rli[r] = __builtin_amdgcn_rcpf(li_l[crow(r, hi)]);
  float* Ow = Ob + (long)(wid * QBLK) * LDO;
#pragma unroll
  for (int r = 0; r < 16; ++r) { int orow = crow(r, hi);
#pragma unroll
    for (int d0 = 0; d0 < 4; ++d0) Ow[(long)orow * LDO + d0 * 32 + r32] = o[d0][r] * rli[r]; }
#undef DMA8
#undef MASKED
}

constexpr int T8_V = 8192, T8_K = 8192, T8_R = 4096, STG9 = T8_V + T8_K + T8_R, OFF_WS9 = 3 * STG9;
#define VS8(d, b) ((d) * 64 + ((b) ^ ((((d) >> 2) & 3) << 4)))
template <int ABL = 0> __device__ __forceinline__ void attn_block9(const unsigned char* __restrict__ Qb, const unsigned char* __restrict__ Kh, const unsigned char* __restrict__ Vt, const unsigned char* __restrict__ Rh,
                                            float* __restrict__ Ob, int qb, char* lds) {
  const int tid = threadIdx.x, wid = __builtin_amdgcn_readfirstlane(tid >> 6), lane = tid & 63, r32 = lane & 31, hi = lane >> 5;
  float* ws = (float*)(lds + OFF_WS9) + wid * 64; float* li_l = ws;
  float l_reg = 0; f32x16 o[4] = {}; v8i_a qf[3];
  { const unsigned char* Qw = Qb + (long)(wid * QBLK + r32) * 192 + 32 * hi;
#pragma unroll
    for (int s = 0; s < 3; ++s) { const v4i_a a = *reinterpret_cast<const v4i_a*>(Qw + 64 * s), b = *reinterpret_cast<const v4i_a*>(Qw + 64 * s + 16); qf[s] = __builtin_shufflevector(a, b, 0, 1, 2, 3, 4, 5, 6, 7); } }
  unsigned kof, rof; const unsigned vof = (unsigned)(wid * 1024 + lane * 16);
  { const int row = 8 * wid + (lane >> 3), slot = lane & 7; kof = (unsigned)(row * 128 + ((slot ^ ((row >> 1) & 7)) << 4)); }
  { const int row = 16 * (wid & 3) + (lane >> 2), slot = lane & 3; rof = (unsigned)(row * 64 + ((slot ^ ((row >> 2) & 3)) << 4)); }
  const int wchunk = wid >> 1, t0 = 4 * qb, NT = 4 * qb + 4;
  const LAS unsigned char* ldsb = (const LAS unsigned char*)lds;
#define DMA9(tile, st) do { const char* kp = (const char*)Kh + (size_t)(tile) * (KVBLK * 128); const char* vp = (const char*)Vt + (size_t)(tile) * 8192; const char* rp = (const char*)Rh + (size_t)(tile) * (KVBLK * 64); \
    LAS unsigned char* sb_ = (LAS unsigned char*)ldsb + (st) * STG9; \
    __builtin_amdgcn_global_load_lds((const unsigned*)(vp + vof), (LAS unsigned*)(sb_ + wid * 1024), 16, 0, 0); \
    __builtin_amdgcn_global_load_lds((const unsigned*)(kp + kof), (LAS unsigned*)(sb_ + T8_V + wid * 1024), 16, 0, 0); \
    __builtin_amdgcn_global_load_lds((const unsigned*)(rp + rof), (LAS unsigned*)(sb_ + T8_V + T8_K + (wid & 3) * 1024), 16, 0, 0); } while (0)
#define MASKED(j) (((j) - t0) > wchunk)
  f32x16 p0, p1; v8i_a P8 = {0, 0, 0, 0, 0, 0, 0, 0};
#ifndef ATT_DEPHASE
#define ATT_DEPHASE 0
#endif
#if ATT_DEPHASE
  const int half = wid >> 2;
  DMA9(0, 0); DMA9(1, 1);
  asm volatile("s_waitcnt vmcnt(3)" ::: "memory"); __builtin_amdgcn_s_barrier(); asm volatile("" ::: "memory");
  f32x16 cinit;
#pragma unroll
  for (int r = 0; r < 16; ++r) cinit[r] = -2.0f;
  asm volatile("" : "+v"(cinit));
  if (half == 1) { __builtin_amdgcn_s_barrier(); asm volatile("" ::: "memory"); }
  int st = 0;
#pragma unroll 1
  for (int j = 0; j < NT; ++j) {
    char* sb = lds + st * STG9; const bool live = !MASKED(j);
    v8i_a vf[4];
    if (live) {
      const char* Ks = sb + T8_V; const char* Rs = sb + T8_V + T8_K;
      SBAR();
      v8i_a kf[6];
#pragma unroll
      for (int s2 = 0; s2 < 2; ++s2) { const int b0 = 64 * s2 + 32 * hi;
        kf[2 * s2] = ld32(Ks + KS8(r32, b0), Ks + KS8(r32, b0 + 16)); kf[2 * s2 + 1] = ld32(Ks + KS8(32 + r32, b0), Ks + KS8(32 + r32, b0 + 16)); }
      kf[4] = ld32(Rs + RS8(r32, 32 * hi), Rs + RS8(r32, 32 * hi + 16)); kf[5] = ld32(Rs + RS8(32 + r32, 32 * hi), Rs + RS8(32 + r32, 32 * hi + 16));
      SBAR();
      p0 = __builtin_amdgcn_mfma_scale_f32_32x32x64_f8f6f4(kf[0], qf[0], cinit, 0, 0, 0, 0, 0, 0);
      p1 = __builtin_amdgcn_mfma_scale_f32_32x32x64_f8f6f4(kf[1], qf[0], cinit, 0, 0, 0, 0, 0, 0);
      p0 = __builtin_amdgcn_mfma_scale_f32_32x32x64_f8f6f4(kf[2], qf[1], p0, 0, 0, 0, 0, 0, 0);
      p1 = __builtin_amdgcn_mfma_scale_f32_32x32x64_f8f6f4(kf[3], qf[1], p1, 0, 0, 0, 0, 0, 0);
      p0 = __builtin_amdgcn_mfma_scale_f32_32x32x64_f8f6f4(kf[4], qf[2], p0, 0, 0, 0, 0, 0, 0);
      p1 = __builtin_amdgcn_mfma_scale_f32_32x32x64_f8f6f4(kf[5], qf[2], p1, 0, 0, 0, 0, 0, 0);
      SBAR();
#pragma unroll
      for (int d0 = 0; d0 < 4; ++d0) { const int d = d0 * 32 + r32; vf[d0] = ld32(sb + VS8(d, 32 * hi), sb + VS8(d, 32 * hi + 16)); }
      SBAR();
      float ps = 0;
#pragma unroll
      for (int r = 0; r < 16; ++r) { p0[r] = fminf(__builtin_amdgcn_exp2f(p0[r]), 448.0f); ps += p0[r]; }
      l_reg += ps;
      P8[0] = (int)pk4_fp8(p0[0], p0[1], p0[2], p0[3]); P8[1] = (int)pk4_fp8(p0[4], p0[5], p0[6], p0[7]); P8[2] = (int)pk4_fp8(p0[8], p0[9], p0[10], p0[11]); P8[3] = (int)pk4_fp8(p0[12], p0[13], p0[14], p0[15]);
      SBAR(); }
    asm volatile("s_waitcnt vmcnt(0)" ::: "memory");
    __builtin_amdgcn_s_barrier(); asm volatile("" ::: "memory");
    if (j + 2 < NT) { const int st2 = (st >= 1) ? st - 1 : 2; DMA9(j + 2, st2); }
    if (live) {
      SBAR();
      float ps = 0;
#pragma unroll
      for (int r = 0; r < 16; ++r) { p1[r] = fminf(__builtin_amdgcn_exp2f(p1[r]), 448.0f); ps += p1[r]; }
      l_reg += ps;
      P8[4] = (int)pk4_fp8(p1[0], p1[1], p1[2], p1[3]); P8[5] = (int)pk4_fp8(p1[4], p1[5], p1[6], p1[7]); P8[6] = (int)pk4_fp8(p1[8], p1[9], p1[10], p1[11]); P8[7] = (int)pk4_fp8(p1[12], p1[13], p1[14], p1[15]);
      SBAR();
#pragma unroll
      for (int d0 = 0; d0 < 4; ++d0) o[d0] = __builtin_amdgcn_mfma_scale_f32_32x32x64_f8f6f4(P8, vf[d0], o[d0], 0, 0, 0, 0, 0, 0);
      SBAR(); }
    __builtin_amdgcn_s_barrier(); asm volatile("" ::: "memory");
    st = (st == 2) ? 0 : st + 1;
  }
  if (half == 0) { __builtin_amdgcn_s_barrier(); asm volatile("" ::: "memory"); }
#else
#define DMA9V(tile, st) __builtin_amdgcn_global_load_lds((const unsigned*)((const char*)Vt + (size_t)(tile) * 8192 + vof), (LAS unsigned*)((LAS unsigned char*)ldsb + (st) * STG9 + wid * 1024), 16, 0, 0)
#define DMA9K(tile, st) __builtin_amdgcn_global_load_lds((const unsigned*)((const char*)Kh + (size_t)(tile) * (KVBLK * 128) + kof), (LAS unsigned*)((LAS unsigned char*)ldsb + (st) * STG9 + T8_V + wid * 1024), 16, 0, 0)
#define DMA9R(tile, st) __builtin_amdgcn_global_load_lds((const unsigned*)((const char*)Rh + (size_t)(tile) * (KVBLK * 64) + rof), (LAS unsigned*)((LAS unsigned char*)ldsb + (st) * STG9 + T8_V + T8_K + (wid & 3) * 1024), 16, 0, 0)
  const bool rdma = (wid < 4);
  DMA9V(0, 0); DMA9K(0, 0); if (rdma) DMA9R(0, 0);
  DMA9V(1, 1); DMA9K(1, 1); if (rdma) DMA9R(1, 1);
  if (rdma) asm volatile("s_waitcnt vmcnt(3)" ::: "memory"); else asm volatile("s_waitcnt vmcnt(2)" ::: "memory");
  __builtin_amdgcn_s_barrier(); asm volatile("" ::: "memory");
  f32x16 osum = {};
  v8i_a ones = {0x38383838, 0x38383838, 0x38383838, 0x38383838, 0x38383838, 0x38383838, 0x38383838, 0x38383838};
  asm volatile("" : "+v"(ones));
  int st = 0, j = 0;
#pragma unroll 1
  for (; j < t0; ++j) {
    const int st2 = (st >= 1) ? st - 1 : 2;
    if constexpr (ABL != 2) DMA9V(j + 2, st2);
    char* sb = lds + st * STG9;
      { const char* Ks = sb + T8_V; const char* Rs = sb + T8_V + T8_K;
      SBAR();
      v8i_a kf[6];
#pragma unroll
      for (int s2 = 0; s2 < 2; ++s2) { const int b0 = 64 * s2 + 32 * hi;
        kf[2 * s2] = ld32(Ks + KS8(r32, b0), Ks + KS8(r32, b0 + 16)); kf[2 * s2 + 1] = ld32(Ks + KS8(32 + r32, b0), Ks + KS8(32 + r32, b0 + 16)); }
      kf[4] = ld32(Rs + RS8(r32, 32 * hi), Rs + RS8(r32, 32 * hi + 16)); kf[5] = ld32(Rs + RS8(32 + r32, 32 * hi), Rs + RS8(32 + r32, 32 * hi + 16));
      SBAR();
#pragma unroll
      for (int r = 0; r < 16; ++r) { p0[r] = 40.25f; p1[r] = 40.25f; }
      p0 = __builtin_amdgcn_mfma_scale_f32_32x32x64_f8f6f4(kf[0], qf[0], p0, 0, 0, 0, 0, 0, 0);
      p1 = __builtin_amdgcn_mfma_scale_f32_32x32x64_f8f6f4(kf[1], qf[0], p1, 0, 0, 0, 0, 0, 0);
      p0 = __builtin_amdgcn_mfma_scale_f32_32x32x64_f8f6f4(kf[2], qf[1], p0, 0, 0, 0, 0, 0, 0);
      p1 = __builtin_amdgcn_mfma_scale_f32_32x32x64_f8f6f4(kf[3], qf[1], p1, 0, 0, 0, 0, 0, 0);
      p0 = __builtin_amdgcn_mfma_scale_f32_32x32x64_f8f6f4(kf[4], qf[2], p0, 0, 0, 0, 0, 0, 0);
      p1 = __builtin_amdgcn_mfma_scale_f32_32x32x64_f8f6f4(kf[5], qf[2], p1, 0, 0, 0, 0, 0, 0);
      SBAR();
      if constexpr (ABL != 2) { if (true) DMA9K(j + 2, st2); }
      v8i_a vf[4];
#pragma unroll
      for (int d0 = 0; d0 < 4; ++d0) { const int d = d0 * 32 + r32; vf[d0] = ld32(sb + VS8(d, 32 * hi), sb + VS8(d, 32 * hi + 16)); }
      SBAR();
#pragma unroll
      for (int k = 0; k < 4; ++k) { unsigned w0, w1; asm volatile("" : "=v"(w0), "=v"(w1));
#pragma unroll
        for (int b = 0; b < 4; ++b) { w0 = __builtin_amdgcn_cvt_pk_u8_f32(__builtin_amdgcn_fmed3f(p0[4 * k + b], 0.0f, 126.0f), b, w0); w1 = __builtin_amdgcn_cvt_pk_u8_f32(__builtin_amdgcn_fmed3f(p1[4 * k + b], 0.0f, 126.0f), b, w1); }
        P8[k] = (int)w0; P8[4 + k] = (int)w1; }
      SBAR();
      if constexpr (ABL != 2) { if (true && rdma) DMA9R(j + 2, st2); }
#pragma unroll
      for (int d0 = 0; d0 < 4; ++d0) o[d0] = __builtin_amdgcn_mfma_scale_f32_32x32x64_f8f6f4(P8, vf[d0], o[d0], 0, 0, 0, 0, 0, 0);
      osum = __builtin_amdgcn_mfma_scale_f32_32x32x64_f8f6f4(P8, ones, osum, 0, 0, 0, 0, 0, 0); }
    if (rdma) asm volatile("s_waitcnt vmcnt(3)" ::: "memory"); else asm volatile("s_waitcnt vmcnt(2)" ::: "memory");
    __builtin_amdgcn_s_barrier(); asm volatile("" ::: "memory");
    st = (st == 2) ? 0 : st + 1;
  }
#pragma unroll 1
  for (; j < NT; ++j) {
    const bool more = (j + 2 < NT); const int st2 = (st >= 1) ? st - 1 : 2;
    if constexpr (ABL != 2) { if (more) DMA9V(j + 2, st2); }
    char* sb = lds + st * STG9;
    if (!MASKED(j)) {
      { const char* Ks = sb + T8_V; const char* Rs = sb + T8_V + T8_K;
      SBAR();
      v8i_a kf[6];
#pragma unroll
      for (int s2 = 0; s2 < 2; ++s2) { const int b0 = 64 * s2 + 32 * hi;
        kf[2 * s2] = ld32(Ks + KS8(r32, b0), Ks + KS8(r32, b0 + 16)); kf[2 * s2 + 1] = ld32(Ks + KS8(32 + r32, b0), Ks + KS8(32 + r32, b0 + 16)); }
      kf[4] = ld32(Rs + RS8(r32, 32 * hi), Rs + RS8(r32, 32 * hi + 16)); kf[5] = ld32(Rs + RS8(32 + r32, 32 * hi), Rs + RS8(32 + r32, 32 * hi + 16));
      SBAR();
#pragma unroll
      for (int r = 0; r < 16; ++r) { p0[r] = 40.25f; p1[r] = 40.25f; }
      p0 = __builtin_amdgcn_mfma_scale_f32_32x32x64_f8f6f4(kf[0], qf[0], p0, 0, 0, 0, 0, 0, 0);
      p1 = __builtin_amdgcn_mfma_scale_f32_32x32x64_f8f6f4(kf[1], qf[0], p1, 0, 0, 0, 0, 0, 0);
      p0 = __builtin_amdgcn_mfma_scale_f32_32x32x64_f8f6f4(kf[2], qf[1], p0, 0, 0, 0, 0, 0, 0);
      p1 = __builtin_amdgcn_mfma_scale_f32_32x32x64_f8f6f4(kf[3], qf[1], p1, 0, 0, 0, 0, 0, 0);
      p0 = __builtin_amdgcn_mfma_scale_f32_32x32x64_f8f6f4(kf[4], qf[2], p0, 0, 0, 0, 0, 0, 0);
      p1 = __builtin_amdgcn_mfma_scale_f32_32x32x64_f8f6f4(kf[5], qf[2], p1, 0, 0, 0, 0, 0, 0);
      SBAR();
      if constexpr (ABL != 2) { if (more) DMA9K(j + 2, st2); }
      v8i_a vf[4];
#pragma unroll
      for (int d0 = 0; d0 < 4; ++d0) { const int d = d0 * 32 + r32; vf[d0] = ld32(sb + VS8(d, 32 * hi), sb + VS8(d, 32 * hi + 16)); }
      SBAR();
#pragma unroll
      for (int k = 0; k < 4; ++k) { unsigned w0, w1; asm volatile("" : "=v"(w0), "=v"(w1));
#pragma unroll
        for (int b = 0; b < 4; ++b) { w0 = __builtin_amdgcn_cvt_pk_u8_f32(__builtin_amdgcn_fmed3f(p0[4 * k + b], 0.0f, 126.0f), b, w0); w1 = __builtin_amdgcn_cvt_pk_u8_f32(__builtin_amdgcn_fmed3f(p1[4 * k + b], 0.0f, 126.0f), b, w1); }
        P8[k] = (int)w0; P8[4 + k] = (int)w1; }
      SBAR();
      if constexpr (ABL != 2) { if (more && rdma) DMA9R(j + 2, st2); }
#pragma unroll
      for (int d0 = 0; d0 < 4; ++d0) o[d0] = __builtin_amdgcn_mfma_scale_f32_32x32x64_f8f6f4(P8, vf[d0], o[d0], 0, 0, 0, 0, 0, 0);
      osum = __builtin_amdgcn_mfma_scale_f32_32x32x64_f8f6f4(P8, ones, osum, 0, 0, 0, 0, 0, 0); }
    } else {
      if constexpr (ABL != 2) { if (more) { DMA9K(j + 2, st2); if (rdma) DMA9R(j + 2, st2); } }
    }
    if (more) { if (rdma) asm volatile("s_waitcnt vmcnt(3)" ::: "memory"); else asm volatile("s_waitcnt vmcnt(2)" ::: "memory"); } else asm volatile("s_waitcnt vmcnt(0)" ::: "memory");
    __builtin_amdgcn_s_barrier(); asm volatile("" ::: "memory");
    st = (st == 2) ? 0 : st + 1;
  }
#undef DMA9V
#undef DMA9K
#undef DMA9R
#endif
#if ATT_DEPHASE
  { auto rr = __builtin_amdgcn_permlane32_swap(__float_as_uint(l_reg), __float_as_uint(l_reg), false, false); l_reg = __uint_as_float(rr[0]) + __uint_as_float(rr[1]); }
  if (hi == 0) li_l[r32] = l_reg; asm volatile("s_waitcnt lgkmcnt(0)" ::: "memory");
  float rli[16];
#pragma unroll
  for (int r = 0; r < 16; ++r) rli[r] = __builtin_amdgcn_rcpf(li_l[crow(r, hi)]);
#else
  float rli[16];
#pragma unroll
  for (int r = 0; r < 16; ++r) rli[r] = __builtin_amdgcn_rcpf(osum[r]);
  (void)li_l; (void)l_reg;
#endif
  float* Ow = Ob + (long)(wid * QBLK) * LDO;
  if (ABL == 0 || qb < 0) {
#pragma unroll
  for (int r = 0; r < 16; ++r) { int orow = crow(r, hi);
#pragma unroll
    for (int d0 = 0; d0 < 4; ++d0) Ow[(long)orow * LDO + d0 * 32 + r32] = o[d0][r] * rli[r]; } }
#undef DMA9
#undef MASKED
}
}

struct Ctx { int tid, lane, wave, vcu, G; LAS unsigned char* lds; };
#define LDS_FENCE() asm volatile("s_waitcnt lgkmcnt(0)" ::: "memory")

__device__ __forceinline__ void p0_mod_chunk(const Ctx& c, int chunk, const float* __restrict__ cvec, const float* __restrict__ w_ada, const float* __restrict__ b_ada, float* __restrict__ MOD) {
    const int n0 = chunk * 64, ncg = c.tid & 15, ks = c.tid >> 4;
    f32x4 a0 = {0.f, 0.f, 0.f, 0.f}, a1 = {0.f, 0.f, 0.f, 0.f};
#pragma unroll 8
    for (int k = ks; k < 2048; k += 32) {
        const f32x4 w = *(const f32x4*)(w_ada + (size_t)k * 12288 + n0 + 4 * ncg);
        const float c0 = cvec[k], c1 = cvec[2048 + k];
        const float s0 = c0 * sigmoidf_(c0), s1 = c1 * sigmoidf_(c1);
        a0 += s0 * w; a1 += s1 * w;
    }
    LAS float* red = (LAS float*)c.lds;
    *(LAS f32x4*)(red + (ks * 2 + 0) * 64 + 4 * ncg) = a0; *(LAS f32x4*)(red + (ks * 2 + 1) * 64 + 4 * ncg) = a1;
    __syncthreads();
    if (c.tid < 128) { const int b = c.tid >> 6, n = c.tid & 63; float s = 0.f;
#pragma unroll 8
        for (int k2 = 0; k2 < 32; ++k2) s += red[(k2 * 2 + b) * 64 + n];
        MOD[b * 12288 + n0 + n] = s + b_ada[n0 + n]; }
    __syncthreads();
}
__device__ __forceinline__ void p0_kc_item(const Ctx& c, int item, const float* __restrict__ A_re, const float* __restrict__ A_im, const float* __restrict__ B_re, const float* __restrict__ B_im,
                                           const float* __restrict__ C_re, const float* __restrict__ C_im, const float* __restrict__ Dv, const float* __restrict__ log_dt, float* __restrict__ KC, float* __restrict__ BB) {
    const int g = item >> 2, dq = item & 3;
    LAS float* Cre = (LAS float*)c.lds; LAS float* Cim = Cre + 1024; LAS float* Bre = Cim + 1024; LAS float* Bim = Bre + 1024; LAS float* Are = Bim + 1024; LAS float* Aim = Are + 1024;
    const float dt = expf(log_dt[g]);
    for (int idx = c.tid; idx < 1024; idx += 512) {
        { const int h = idx >> 6, p = idx & 63; Cre[idx] = C_re[(g * 16 + h) * 64 + p]; Cim[idx] = C_im[(g * 16 + h) * 64 + p]; }
        { const int p = idx >> 4, hh = idx & 15; const float are = A_re[g * 64 + p], aim = A_im[g * 64 + p];
          float cs, sn; sincos_d((double)dt * (double)aim, cs, sn); const float ex = expf(dt * are);
          const float nr = ex * cs - 1.0f, ni = ex * sn, den = are * are + aim * aim;
          const float cbr = (nr * are + ni * aim) / den, cbi = (ni * are - nr * aim) / den;
          const float br = B_re[(g * 64 + p) * 16 + hh], bi = B_im[(g * 64 + p) * 16 + hh];
          const float bbr = cbr * br - cbi * bi, bbi = cbr * bi + cbi * br;
          Bre[idx] = bbr; Bim[idx] = bbi;
          if (dq == 0) { BB[((size_t)(g * 64 + p) * 16 + hh) * 2] = bbr; BB[((size_t)(g * 64 + p) * 16 + hh) * 2 + 1] = bbi; } }
        { const int dd = idx >> 6, p = idx & 63, d = dq * 16 + dd; const float are = A_re[g * 64 + p], aim = A_im[g * 64 + p];
          float cs, sn; sincos_d((double)d * (double)dt * (double)aim, cs, sn); const float ex = expf((float)d * dt * are);
          Are[idx] = ex * cs; Aim[idx] = ex * sn; }
    }
    __syncthreads();
#pragma unroll 1
    for (int r = 0; r < 8; ++r) { const int e = c.tid + 512 * r, dd = e >> 8, h = (e >> 4) & 15, hh = e & 15; float s = 0.f;
#pragma unroll 8
        for (int p = 0; p < 64; ++p) { const float ar = Are[dd * 64 + p], ai = Aim[dd * 64 + p], br = Bre[p * 16 + hh], bi = Bim[p * 16 + hh];
            const float er = ar * br - ai * bi, ei = ar * bi + ai * br; s += Cre[h * 64 + p] * er - Cim[h * 64 + p] * ei; }
        const int d = dq * 16 + dd; if (d == 0 && h == hh) s += Dv[g * 16 + h];
        KC[((size_t)(g * 64 + d) * 16 + h) * 16 + hh] = s; }
    __syncthreads();
}
template <int MAP> __device__ __forceinline__ int rowmap(int n) {
    if (MAP == 1) { const int h = n / 192, d = n - h * 192; return d < 128 ? h * 128 + d : 1024 + h * 64 + (d - 128); }
    if (MAP == 2) { const int j = n >> 1, s = n & 1; return (j >> 7) * 256 + s * 128 + (j & 127); }
    return n;
}
template <int MAP> __device__ __forceinline__ void tr_item(const float* __restrict__ W, int N, const float* __restrict__ kscale, bf16_t* __restrict__ WT, int ldt, int kb, int nb, int lane) {
    const int kgrp = lane >> 3, nc = lane & 7, k0 = kb * 64 + 8 * kgrp;
    f32x4 v[2][8];
#pragma unroll
    for (int nn = 0; nn < 2; ++nn)
#pragma unroll
        for (int i = 0; i < 8; ++i) v[nn][i] = *(const f32x4*)(W + (size_t)(k0 + i) * N + nb * 64 + 32 * nn + 4 * nc);
    float sc[8];
#pragma unroll
    for (int i = 0; i < 8; ++i) sc[i] = kscale ? kscale[k0 + i] : 1.0f;
#pragma unroll
    for (int nn = 0; nn < 2; ++nn)
#pragma unroll
        for (int j = 0; j < 4; ++j) { const int row = rowmap<MAP>(nb * 64 + 32 * nn + 4 * nc + j);
            u32x4 w; w.x = cvt_pk_bf16(v[nn][0][j] * sc[0], v[nn][1][j] * sc[1]); w.y = cvt_pk_bf16(v[nn][2][j] * sc[2], v[nn][3][j] * sc[3]);
            w.z = cvt_pk_bf16(v[nn][4][j] * sc[4], v[nn][5][j] * sc[5]); w.w = cvt_pk_bf16(v[nn][6][j] * sc[6], v[nn][7][j] * sc[7]);
            *(u32x4*)(WT + (size_t)row * ldt + k0) = w; }
}

struct RowRaw { f32x4 v[8]; };
__device__ __forceinline__ RowRaw hnorm_load(const float* __restrict__ xrow, int lane) { RowRaw r;
#pragma unroll
    for (int j = 0; j < 8; ++j) r.v[j] = __builtin_nontemporal_load((const f32x4*)(xrow + 4 * lane + 256 * j));
    return r; }
__device__ __forceinline__ float hnorm_proc(const RowRaw& r, bf16_t* __restrict__ hrow, const f32x4 (&fa)[8], const f32x4 (&fb)[8], int lane) {
    float ss = 0.f;
#pragma unroll
    for (int j = 0; j < 8; ++j) ss += (r.v[j][0] * r.v[j][0] + r.v[j][1] * r.v[j][1]) + (r.v[j][2] * r.v[j][2] + r.v[j][3] * r.v[j][3]);
    const float rstd = 1.0f / sqrtf(wave_sum(ss) * (1.0f / 2048.0f) + EPS);
#pragma unroll
    for (int j = 0; j < 8; ++j) { const f32x4 y = r.v[j] * rstd * fa[j] + fb[j]; u32x2 w; w.x = cvt_pk_bf16(y[0], y[1]); w.y = cvt_pk_bf16(y[2], y[3]);
        *(u32x2*)(hrow + 4 * lane + 256 * j) = w; }
    return rstd;
}
__device__ __forceinline__ float hnorm_row(const float* __restrict__ xrow, bf16_t* __restrict__ hrow, const f32x4 (&fa)[8], const f32x4 (&fb)[8], int lane) {
    const RowRaw r = hnorm_load(xrow, lane); return hnorm_proc(r, hrow, fa, fb, lane);
}

template <int MAP> __device__ __forceinline__ void tr_item8(const float* __restrict__ W, int N, unsigned char* __restrict__ WT, int ldt, int kb, int nb, int lane, const float* __restrict__ kscale = nullptr) {
    const int kgrp = lane >> 4, nc = lane & 15, k0 = kb * 128 + 32 * kgrp;
    f32x4 v[32];
#pragma unroll
    for (int i = 0; i < 32; ++i) v[i] = __builtin_nontemporal_load((const f32x4*)(W + (size_t)(k0 + i) * N + nb * 64 + 4 * nc));
    if (kscale) {
#pragma unroll
        for (int i = 0; i < 32; ++i) v[i] *= kscale[k0 + i]; }
#pragma unroll
    for (int j = 0; j < 4; ++j) { const int row = rowmap<MAP>(nb * 64 + 4 * nc + j);
#pragma unroll
        for (int hh = 0; hh < 2; ++hh) { const int q = 16 * hh;
            u32x4 w; w.x = pk4_fp8(v[q + 0][j] * W8_SCALE, v[q + 1][j] * W8_SCALE, v[q + 2][j] * W8_SCALE, v[q + 3][j] * W8_SCALE); w.y = pk4_fp8(v[q + 4][j] * W8_SCALE, v[q + 5][j] * W8_SCALE, v[q + 6][j] * W8_SCALE, v[q + 7][j] * W8_SCALE);
            w.z = pk4_fp8(v[q + 8][j] * W8_SCALE, v[q + 9][j] * W8_SCALE, v[q + 10][j] * W8_SCALE, v[q + 11][j] * W8_SCALE); w.w = pk4_fp8(v[q + 12][j] * W8_SCALE, v[q + 13][j] * W8_SCALE, v[q + 14][j] * W8_SCALE, v[q + 15][j] * W8_SCALE);
            *(u32x4*)(WT + (size_t)row * ldt + k0 + q) = w; } }
}
__device__ __forceinline__ float hnorm_row8(const float* __restrict__ xrow, unsigned char* __restrict__ hrow, const f32x4 (&fa)[8], const f32x4 (&fb)[8], int lane) {
    f32x4 v[8]; float ss = 0.f;
#pragma unroll
    for (int j = 0; j < 8; ++j) { v[j] = *(const f32x4*)(xrow + 4 * lane + 256 * j); ss += (v[j][0] * v[j][0] + v[j][1] * v[j][1]) + (v[j][2] * v[j][2] + v[j][3] * v[j][3]); }
    const float rstd = 1.0f / sqrtf(wave_sum(ss) * (1.0f / 2048.0f) + EPS);
#pragma unroll
    for (int j = 0; j < 8; ++j) { const f32x4 y = v[j] * rstd * fa[j] + fb[j]; *(unsigned*)(hrow + 4 * lane + 256 * j) = pk4_fp8(y[0], y[1], y[2], y[3]); }
    return rstd;
}

struct RowRawB { u32x4 w[4]; };
__device__ __forceinline__ RowRawB hnorm_b_load(const bf16_t* __restrict__ xrow, int lane) { RowRawB r;
#pragma unroll
    for (int j = 0; j < 4; ++j) r.w[j] = *(const u32x4*)(xrow + 8 * lane + 512 * j);
    return r; }
__device__ __forceinline__ float hnorm_b_proc(const RowRawB& r, unsigned char* __restrict__ hrow, const f32x4 (&fa)[4][2], const f32x4 (&fb)[4][2], int lane) {
    float v[4][8]; float ss = 0.f;
#pragma unroll
    for (int j = 0; j < 4; ++j) { const u32x4 w = r.w[j];
        v[j][0] = bflo(w[0]); v[j][1] = bfhi(w[0]); v[j][2] = bflo(w[1]); v[j][3] = bfhi(w[1]); v[j][4] = bflo(w[2]); v[j][5] = bfhi(w[2]); v[j][6] = bflo(w[3]); v[j][7] = bfhi(w[3]);
#pragma unroll
        for (int e = 0; e < 8; ++e) ss += v[j][e] * v[j][e]; }
    const float rstd = 1.0f / sqrtf(wave_sum(ss) * (1.0f / 2048.0f) + EPS);
#pragma unroll
    for (int j = 0; j < 4; ++j) { float y[8];
#pragma unroll
        for (int e = 0; e < 8; ++e) y[e] = v[j][e] * rstd * fa[j][e >> 2][e & 3] + fb[j][e >> 2][e & 3];
#if MOE_FP8
        u32x2 w; w.x = pk4_fp8(y[0], y[1], y[2], y[3]); w.y = pk4_fp8(y[4], y[5], y[6], y[7]); *(u32x2*)(hrow + 8 * lane + 512 * j) = w;
#else
        u32x4 w; w.x = cvt_pk_bf16(y[0], y[1]); w.y = cvt_pk_bf16(y[2], y[3]); w.z = cvt_pk_bf16(y[4], y[5]); w.w = cvt_pk_bf16(y[6], y[7]); *(u32x4*)((bf16_t*)hrow + 8 * lane + 512 * j) = w;
#endif
    }
    return rstd;
}

__device__ __forceinline__ void p4_carry_item(const Ctx& c, int item, const float* __restrict__ SEND, const float* __restrict__ A64, const float* __restrict__ A1024, bf16_t* __restrict__ AG) {
    const int g = item >> 2, b = (item >> 1) & 1, ph = item & 1, seg = c.tid >> 5, pl = c.tid & 31, p = ph * 32 + pl;
    const float ar = A64[(g * 64 + p) * 2], ai = A64[(g * 64 + p) * 2 + 1], qr = A1024[(g * 64 + p) * 2], qi = A1024[(g * 64 + p) * 2 + 1];
    float sre[16], sim[16];
#pragma unroll
    for (int i = 0; i < 16; ++i) { const size_t row = (size_t)(g * NCH + b * 256 + seg * 16 + i) * 128; sre[i] = SEND[row + p]; sim[i] = SEND[row + 64 + p]; }
    float lr = 0.f, li = 0.f;
#pragma unroll
    for (int i = 0; i < 16; ++i) { const float nr = ar * lr - ai * li + sre[i], ni = ar * li + ai * lr + sim[i]; lr = nr; li = ni; }
    LAS float* se = (LAS float*)c.lds;
    LAS float* ci = se + 1024;
    se[(seg * 32 + pl) * 2] = lr; se[(seg * 32 + pl) * 2 + 1] = li;
    __syncthreads();
    if (c.tid < 32) { float cr = 0.f, cim = 0.f;
#pragma unroll 1
        for (int s = 0; s < 16; ++s) { ci[(s * 32 + pl) * 2] = cr; ci[(s * 32 + pl) * 2 + 1] = cim; const float er = se[(s * 32 + pl) * 2], ei = se[(s * 32 + pl) * 2 + 1];
            const float nr = qr * cr - qi * cim + er, ni = qr * cim + qi * cr + ei; cr = nr; cim = ni; } }
    __syncthreads();
    float cr = ci[(seg * 32 + pl) * 2], cim = ci[(seg * 32 + pl) * 2 + 1];
#pragma unroll
    for (int i = 0; i < 16; ++i) { bf16_t* dst = AG + (size_t)(g * NCH + b * 256 + seg * 16 + i) * AGW; dst[p] = f2bf(cr); dst[64 + p] = f2bf(cim);
        const float nr = ar * cr - ai * cim + sre[i], ni = ar * cim + ai * cr + sim[i]; cr = nr; cim = ni; }
    __syncthreads();
}

constexpr float QSC = 0.07216878364870322f * 1.4426950408889634f;
constexpr float SQ8 = 0.3226727f;
constexpr float QMUL = ATT_FP8 ? (ATT_PV8 ? 8.0f * SQ8 : SQ8) : QSC, KMUL = ATT_FP8 ? SQ8 : 1.0f;
struct QkRaw { u32x4 zq; u32x2 zkv; unsigned zkr; u32x4 qn0, qn1, qr, kn0, kn1, v0, v1; f32x4 cq0, cq1, sq0, sq1; float ck, sk; };
struct QkGain { float qn[16], qr[8], kn[16], kr; };
__device__ __forceinline__ QkGain p4_gains(int lane, const float* __restrict__ q_nope_g, const float* __restrict__ q_rope_g, const float* __restrict__ k_nope_g, const float* __restrict__ k_rope_g) {
    QkGain g; const int s = lane & 7;
#pragma unroll
    for (int i = 0; i < 16; ++i) { g.qn[i] = q_nope_g[s * 16 + i] * QMUL; g.kn[i] = k_nope_g[s * 16 + i] * KMUL; }
#pragma unroll
    for (int i = 0; i < 8; ++i) g.qr[i] = q_rope_g[s * 8 + i] * QMUL;
    g.kr = k_rope_g[lane] * KMUL; return g;
}
__device__ __forceinline__ QkRaw p4_load(int t, int lane, const bf16_t* __restrict__ Z2, const bf16_t* __restrict__ QRAW, const bf16_t* __restrict__ KVRAW, const float* __restrict__ COS, const float* __restrict__ SIN) {
    QkRaw r; const int h = lane >> 3, s = lane & 7; const bf16_t* z = Z2 + (size_t)t * AGW;
    r.zq = *(const u32x4*)(z + lane * 8); r.zkv = *(const u32x2*)(z + 512 + lane * 4); r.zkr = z[768 + lane];
    const bf16_t* q = QRAW + (size_t)t * 1536; r.qn0 = __builtin_nontemporal_load((const u32x4*)(q + h * 128 + s * 16)); r.qn1 = __builtin_nontemporal_load((const u32x4*)(q + h * 128 + s * 16 + 8)); r.qr = __builtin_nontemporal_load((const u32x4*)(q + 1024 + h * 64 + s * 8));
    const bf16_t* kv = KVRAW + (size_t)t * 2048 + h * 256 + s * 16; r.kn0 = __builtin_nontemporal_load((const u32x4*)kv); r.kn1 = __builtin_nontemporal_load((const u32x4*)(kv + 8)); r.v0 = __builtin_nontemporal_load((const u32x4*)(kv + 128)); r.v1 = __builtin_nontemporal_load((const u32x4*)(kv + 136));
    const float* cp = COS + (size_t)t * 32; const float* sp = SIN + (size_t)t * 32;
    r.cq0 = *(const f32x4*)(cp + (s & 3) * 8); r.cq1 = *(const f32x4*)(cp + (s & 3) * 8 + 4); r.sq0 = *(const f32x4*)(sp + (s & 3) * 8); r.sq1 = *(const f32x4*)(sp + (s & 3) * 8 + 4);
    r.ck = cp[lane & 31]; r.sk = sp[lane & 31]; return r;
}
#define UNPK8(W_, X_, O_) do { const u32x4 w_ = (W_); X_[O_ + 0] = bflo(w_[0]); X_[O_ + 1] = bfhi(w_[0]); X_[O_ + 2] = bflo(w_[1]); X_[O_ + 3] = bfhi(w_[1]); X_[O_ + 4] = bflo(w_[2]); X_[O_ + 5] = bfhi(w_[2]); X_[O_ + 6] = bflo(w_[3]); X_[O_ + 7] = bfhi(w_[3]); } while (0)
__device__ __forceinline__ void p4_proc(int t, int lane, const QkRaw& r, const QkGain& g, bf16_t* __restrict__ Q, bf16_t* __restrict__ KN, bf16_t* __restrict__ V, bf16_t* __restrict__ KR, LAS unsigned char* vtile) {
    const int h = lane >> 3, s = lane & 7, b = t >> 14, l = t & (SEQ - 1);
    float rq, rkv;
    { float x[8]; UNPK8(r.zq, x, 0); float ss = 0.f;
#pragma unroll
      for (int i = 0; i < 8; ++i) ss += x[i] * x[i];
      rq = 1.0f / sqrtf(wave_sum(ss) * (1.0f / 512.0f) + EPS); }
    { const float ss = bflo(r.zkv.x) * bflo(r.zkv.x) + bfhi(r.zkv.x) * bfhi(r.zkv.x) + bflo(r.zkv.y) * bflo(r.zkv.y) + bfhi(r.zkv.y) * bfhi(r.zkv.y);
      rkv = 1.0f / sqrtf(wave_sum(ss) * (1.0f / 256.0f) + EPS); }
    { float x = bf2f((unsigned short)r.zkr); const float rr = 1.0f / sqrtf(wave_sum(x * x) * (1.0f / 64.0f) + EPS); x = x * rr * g.kr;
      const float other = __shfl_xor(x, 32); const float o = (lane < 32) ? (x * r.ck - other * r.sk) : (x * r.ck + other * r.sk);
#if ATT_FP8
      ((unsigned char*)KR)[(size_t)t * 64 + lane] = (unsigned char)(pk4_fp8(o, o, o, o) & 0xffu); }
#else
      KR[(size_t)t * 64 + lane] = f2bf(o); }
#endif
    { float x[16]; UNPK8(r.qn0, x, 0); UNPK8(r.qn1, x, 8); float ss = 0.f;
#pragma unroll
      for (int i = 0; i < 16; ++i) { x[i] *= rq; ss += x[i] * x[i]; }
      ss += __shfl_xor(ss, 1); ss += __shfl_xor(ss, 2); ss += __shfl_xor(ss, 4);
      const float rr = 1.0f / sqrtf(ss * (1.0f / 128.0f) + EPS); unsigned o[8];
#pragma unroll
#if ATT_FP8
      for (int i = 0; i < 16; ++i) x[i] = x[i] * rr * g.qn[i];
      (void)o;
      *(u32x4*)((unsigned char*)Q + ((size_t)((b * NH + h) * SEQ + l)) * 192 + s * 16) = (u32x4){pk4_fp8(x[0], x[1], x[2], x[3]), pk4_fp8(x[4], x[5], x[6], x[7]), pk4_fp8(x[8], x[9], x[10], x[11]), pk4_fp8(x[12], x[13], x[14], x[15])}; }
#else
      for (int i = 0; i < 8; ++i) o[i] = cvt_pk_bf16(x[2 * i] * rr * g.qn[2 * i], x[2 * i + 1] * rr * g.qn[2 * i + 1]);
      bf16_t* dst = Q + ((size_t)((b * NH + h) * SEQ + l)) * 192 + s * 16;
      *(u32x4*)dst = (u32x4){o[0], o[1], o[2], o[3]}; *(u32x4*)(dst + 8) = (u32x4){o[4], o[5], o[6], o[7]}; }
#endif
    { float x[8]; UNPK8(r.qr, x, 0); float ss = 0.f;
#pragma unroll
      for (int i = 0; i < 8; ++i) { x[i] *= rq; ss += x[i] * x[i]; }
      ss += __shfl_xor(ss, 1); ss += __shfl_xor(ss, 2); ss += __shfl_xor(ss, 4);
      const float rr = 1.0f / sqrtf(ss * (1.0f / 64.0f) + EPS); float y[8];
      const float cs[8] = {r.cq0[0], r.cq0[1], r.cq0[2], r.cq0[3], r.cq1[0], r.cq1[1], r.cq1[2], r.cq1[3]}, sn[8] = {r.sq0[0], r.sq0[1], r.sq0[2], r.sq0[3], r.sq1[0], r.sq1[1], r.sq1[2], r.sq1[3]};
#pragma unroll
      for (int i = 0; i < 8; ++i) x[i] = x[i] * rr * g.qr[i];
#pragma unroll
      for (int i = 0; i < 8; ++i) { const float other = __shfl_xor(x[i], 4); y[i] = (s < 4) ? (x[i] * cs[i] - other * sn[i]) : (x[i] * cs[i] + other * sn[i]); }
#if ATT_FP8
      *(u32x2*)((unsigned char*)Q + ((size_t)((b * NH + h) * SEQ + l)) * 192 + 128 + s * 8) = (u32x2){pk4_fp8(y[0], y[1], y[2], y[3]), pk4_fp8(y[4], y[5], y[6], y[7])}; }
#else
      bf16_t* dst = Q + ((size_t)((b * NH + h) * SEQ + l)) * 192 + 128 + s * 8;
      *(u32x4*)dst = (u32x4){cvt_pk_bf16(y[0], y[1]), cvt_pk_bf16(y[2], y[3]), cvt_pk_bf16(y[4], y[5]), cvt_pk_bf16(y[6], y[7])}; }
#endif
    { float x[16]; UNPK8(r.kn0, x, 0); UNPK8(r.kn1, x, 8); float ss = 0.f;
#pragma unroll
      for (int i = 0; i < 16; ++i) { x[i] *= rkv; ss += x[i] * x[i]; }
      ss += __shfl_xor(ss, 1); ss += __shfl_xor(ss, 2); ss += __shfl_xor(ss, 4);
      const float rr = 1.0f / sqrtf(ss * (1.0f / 128.0f) + EPS); unsigned o[8];
#pragma unroll
#if ATT_FP8
      for (int i = 0; i < 16; ++i) x[i] = x[i] * rr * g.kn[i];
      (void)o;
      *(u32x4*)((unsigned char*)KN + ((size_t)((b * NH + h) * SEQ + l)) * 128 + s * 16) = (u32x4){pk4_fp8(x[0], x[1], x[2], x[3]), pk4_fp8(x[4], x[5], x[6], x[7]), pk4_fp8(x[8], x[9], x[10], x[11]), pk4_fp8(x[12], x[13], x[14], x[15])}; }
#else
      for (int i = 0; i < 8; ++i) o[i] = cvt_pk_bf16(x[2 * i] * rr * g.kn[2 * i], x[2 * i + 1] * rr * g.kn[2 * i + 1]);
      bf16_t* dst = KN + ((size_t)((b * NH + h) * SEQ + l)) * 128 + s * 16;
      *(u32x4*)dst = (u32x4){o[0], o[1], o[2], o[3]}; *(u32x4*)(dst + 8) = (u32x4){o[4], o[5], o[6], o[7]}; }
#endif
#if ATT_PV8
    { const unsigned ww[8] = {r.v0[0], r.v0[1], r.v0[2], r.v0[3], r.v1[0], r.v1[1], r.v1[2], r.v1[3]}; unsigned q8[4];
#pragma unroll
      for (int i = 0; i < 4; ++i) q8[i] = pk4_fp8(bflo(ww[2 * i]) * rkv, bfhi(ww[2 * i]) * rkv, bflo(ww[2 * i + 1]) * rkv, bfhi(ww[2 * i + 1]) * rkv);
      const int k = t & 63, slot = 2 * ((k >> 2) & 1) + (k >> 5), bis = (k & 3) + 4 * ((k & 31) >> 3);
#pragma unroll
      for (int j = 0; j < 16; ++j) { const int d = s * 16 + j; vtile[(h * 128 + d) * 64 + ((slot ^ ((d >> 2) & 3)) << 4) + bis] = (unsigned char)((q8[j >> 2] >> (8 * (j & 3))) & 0xffu); } }
#else
    { unsigned o[8]; const unsigned ww[8] = {r.v0.x, r.v0.y, r.v0.z, r.v0.w, r.v1.x, r.v1.y, r.v1.z, r.v1.w};
#pragma unroll
      for (int i = 0; i < 8; ++i) o[i] = cvt_pk_bf16(bflo(ww[i]) * rkv, bfhi(ww[i]) * rkv);
      bf16_t* dst = V + ((size_t)((b * NH + h) * SEQ + l)) * 128 + s * 16;
      *(u32x4*)dst = (u32x4){o[0], o[1], o[2], o[3]}; *(u32x4*)(dst + 8) = (u32x4){o[4], o[5], o[6], o[7]}; }
    (void)vtile;
#endif
}

struct MixRaw { u32x4 s0, s1; f32x4 m[4]; };
__device__ __forceinline__ MixRaw p6_load(int t, int lane, const bf16_t* __restrict__ YS, const float* __restrict__ YM) {
    MixRaw r; const bf16_t* ys = YS + (size_t)t * 1024 + lane * 16; r.s0 = __builtin_nontemporal_load((const u32x4*)ys); r.s1 = __builtin_nontemporal_load((const u32x4*)(ys + 8));
    const float* ym = YM + (size_t)t * 1024 + lane * 16;
#pragma unroll
    for (int j = 0; j < 4; ++j) r.m[j] = __builtin_nontemporal_load((const f32x4*)(ym + 4 * j));
    return r;
}
__device__ __forceinline__ void p6_proc(int t, int lane, const MixRaw& r, bf16_t* __restrict__ MIX) {
    float x[16]; UNPK8(r.s0, x, 0); UNPK8(r.s1, x, 8);
    float ss = 0.f, sm = 0.f;
#pragma unroll
    for (int i = 0; i < 16; ++i) ss += x[i] * x[i];
#pragma unroll
    for (int j = 0; j < 4; ++j) sm += (r.m[j][0] * r.m[j][0] + r.m[j][1] * r.m[j][1]) + (r.m[j][2] * r.m[j][2] + r.m[j][3] * r.m[j][3]);
    const float rs = 1.0f / sqrtf(wave_sum(ss) * (1.0f / 1024.0f) + EPS), rm = 1.0f / sqrtf(wave_sum(sm) * (1.0f / 1024.0f) + EPS);
#if OUT_FP8
    unsigned char* d0 = (unsigned char*)MIX + (size_t)t * 2048 + lane * 16;
    *(u32x4*)d0 = (u32x4){pk4_fp8(x[0] * rs, x[1] * rs, x[2] * rs, x[3] * rs), pk4_fp8(x[4] * rs, x[5] * rs, x[6] * rs, x[7] * rs), pk4_fp8(x[8] * rs, x[9] * rs, x[10] * rs, x[11] * rs), pk4_fp8(x[12] * rs, x[13] * rs, x[14] * rs, x[15] * rs)};
    *(u32x4*)(d0 + 1024) = (u32x4){pk4_fp8(r.m[0][0] * rm, r.m[0][1] * rm, r.m[0][2] * rm, r.m[0][3] * rm), pk4_fp8(r.m[1][0] * rm, r.m[1][1] * rm, r.m[1][2] * rm, r.m[1][3] * rm),
                                   pk4_fp8(r.m[2][0] * rm, r.m[2][1] * rm, r.m[2][2] * rm, r.m[2][3] * rm), pk4_fp8(r.m[3][0] * rm, r.m[3][1] * rm, r.m[3][2] * rm, r.m[3][3] * rm)};
#else
    bf16_t* d0 = MIX + (size_t)t * 2048 + lane * 16; unsigned o[8];
#pragma unroll
    for (int i = 0; i < 8; ++i) o[i] = cvt_pk_bf16(x[2 * i] * rs, x[2 * i + 1] * rs);
    *(u32x4*)d0 = (u32x4){o[0], o[1], o[2], o[3]}; *(u32x4*)(d0 + 8) = (u32x4){o[4], o[5], o[6], o[7]};
    bf16_t* d1 = d0 + 1024;
#pragma unroll
    for (int j = 0; j < 4; ++j) { o[2 * j] = cvt_pk_bf16(r.m[j][0] * rm, r.m[j][1] * rm); o[2 * j + 1] = cvt_pk_bf16(r.m[j][2] * rm, r.m[j][3] * rm); }
    *(u32x4*)d1 = (u32x4){o[0], o[1], o[2], o[3]}; *(u32x4*)(d1 + 8) = (u32x4){o[4], o[5], o[6], o[7]};
#endif
}

__device__ __forceinline__ void p8_group(int grp, int lane, LAS float* wl  , const bf16_t* __restrict__ X1, const float* __restrict__ FA2, const float* __restrict__ FB2,
                                         const bf16_t* __restrict__ WRT_HI, const bf16_t* __restrict__ WRT_LO, const float* __restrict__ b_router, unsigned char* __restrict__ H8,
                                         int* __restrict__ RIDX, float* __restrict__ RGATE, int* __restrict__ RPOS, unsigned* __restrict__ CNT) {
    const int t0 = grp * 16, b = t0 >> 14, fr = lane & 15, fq = lane >> 4;
    float rstd_mine = 0.f;
    { f32x4 fa[4][2], fb[4][2];
#pragma unroll
      for (int j = 0; j < 4; ++j)
#pragma unroll
        for (int q = 0; q < 2; ++q) { fa[j][q] = *(const f32x4*)(FA2 + b * 2048 + 8 * lane + 512 * j + 4 * q); fb[j][q] = *(const f32x4*)(FB2 + b * 2048 + 8 * lane + 512 * j + 4 * q); }
#pragma unroll 1
      for (int i = 0; i < 16; i += 4) { constexpr int HB = MOE_FP8 ? 2048 : 4096;
          const RowRawB r0 = hnorm_b_load(X1 + (size_t)(t0 + i) * 2048, lane), r1 = hnorm_b_load(X1 + (size_t)(t0 + i + 1) * 2048, lane), r2 = hnorm_b_load(X1 + (size_t)(t0 + i + 2) * 2048, lane), r3 = hnorm_b_load(X1 + (size_t)(t0 + i + 3) * 2048, lane);
          const float q0 = hnorm_b_proc(r0, H8 + (size_t)(t0 + i) * HB, fa, fb, lane), q1 = hnorm_b_proc(r1, H8 + (size_t)(t0 + i + 1) * HB, fa, fb, lane), q2 = hnorm_b_proc(r2, H8 + (size_t)(t0 + i + 2) * HB, fa, fb, lane), q3 = hnorm_b_proc(r3, H8 + (size_t)(t0 + i + 3) * HB, fa, fb, lane);
          rstd_mine = (fr == i) ? q0 : (fr == i + 1) ? q1 : (fr == i + 2) ? q2 : (fr == i + 3) ? q3 : rstd_mine; } }
    f32x4 acc0 = {0.f, 0.f, 0.f, 0.f}, acc1 = {0.f, 0.f, 0.f, 0.f};
    const bf16_t* xrow = X1 + (size_t)(t0 + fr) * 2048 + fq * 8;
    const float* fap = FA2 + b * 2048 + fq * 8; const float* fbp = FB2 + b * 2048 + fq * 8;
    const bf16_t* wh0 = WRT_HI + (size_t)fr * 2048 + fq * 8; const bf16_t* wl0 = WRT_LO + (size_t)fr * 2048 + fq * 8;
#pragma unroll 4
    for (int ks = 0; ks < 64; ++ks) {
        const u32x4 xw = *(const u32x4*)(xrow + ks * 32); const f32x4 x0 = {bflo(xw.x), bfhi(xw.x), bflo(xw.y), bfhi(xw.y)}, x1 = {bflo(xw.z), bfhi(xw.z), bflo(xw.w), bfhi(xw.w)};
        const f32x4 a0 = *(const f32x4*)(fap + ks * 32), a1 = *(const f32x4*)(fap + ks * 32 + 4), c0 = *(const f32x4*)(fbp + ks * 32), c1 = *(const f32x4*)(fbp + ks * 32 + 4);
        const f32x4 h0 = x0 * rstd_mine * a0 + c0, h1 = x1 * rstd_mine * a1 + c1;
        u32x4 hh; hh.x = cvt_pk_bf16(h0[0], h0[1]); hh.y = cvt_pk_bf16(h0[2], h0[3]); hh.z = cvt_pk_bf16(h1[0], h1[1]); hh.w = cvt_pk_bf16(h1[2], h1[3]);
        u32x4 hl; hl.x = cvt_pk_bf16(h0[0] - bflo(hh.x), h0[1] - bfhi(hh.x)); hl.y = cvt_pk_bf16(h0[2] - bflo(hh.y), h0[3] - bfhi(hh.y));
        hl.z = cvt_pk_bf16(h1[0] - bflo(hh.z), h1[1] - bfhi(hh.z)); hl.w = cvt_pk_bf16(h1[2] - bflo(hh.w), h1[3] - bfhi(hh.w));
        const bf16x8 hhi = *reinterpret_cast<bf16x8*>(&hh), hlo = *reinterpret_cast<bf16x8*>(&hl);
        const bf16x8 whi0 = *(const bf16x8*)(wh0 + ks * 32), wlo0 = *(const bf16x8*)(wl0 + ks * 32);
        const bf16x8 whi1 = *(const bf16x8*)(wh0 + 16 * 2048 + ks * 32), wlo1 = *(const bf16x8*)(wl0 + 16 * 2048 + ks * 32);
        acc0 = __builtin_amdgcn_mfma_f32_16x16x32_bf16(whi0, hhi, acc0, 0, 0, 0); acc0 = __builtin_amdgcn_mfma_f32_16x16x32_bf16(wlo0, hhi, acc0, 0, 0, 0); acc0 = __builtin_amdgcn_mfma_f32_16x16x32_bf16(whi0, hlo, acc0, 0, 0, 0);
        acc1 = __builtin_amdgcn_mfma_f32_16x16x32_bf16(whi1, hhi, acc1, 0, 0, 0); acc1 = __builtin_amdgcn_mfma_f32_16x16x32_bf16(wlo1, hhi, acc1, 0, 0, 0); acc1 = __builtin_amdgcn_mfma_f32_16x16x32_bf16(whi1, hlo, acc1, 0, 0, 0);
    }
    LAS float* lg = wl; LAS unsigned* hist = (LAS unsigned*)(wl + 16 * 33); LAS unsigned* basel = hist + 32;
#pragma unroll
    for (int e = 0; e < 4; ++e) { lg[fr * 33 + 4 * fq + e] = acc0[e] + b_router[4 * fq + e]; lg[fr * 33 + 16 + 4 * fq + e] = acc1[e] + b_router[16 + 4 * fq + e]; }
    if (lane < 32) hist[lane] = 0u;
    LDS_FENCE();
    int ie[4] = {0, 0, 0, 0}; float gt[4] = {0.f, 0.f, 0.f, 0.f}; unsigned rk[4] = {0u, 0u, 0u, 0u};
    if (lane < 16) {
        float v0 = -3.0e38f, v1 = -3.0e38f, v2 = -3.0e38f, v3 = -3.0e38f; int i0 = 0, i1 = 0, i2 = 0, i3 = 0;
#pragma unroll 4
        for (int e = 0; e < 32; ++e) { const float x = lg[lane * 33 + e];
            if (x > v0) { v3 = v2; i3 = i2; v2 = v1; i2 = i1; v1 = v0; i1 = i0; v0 = x; i0 = e; }
            else if (x > v1) { v3 = v2; i3 = i2; v2 = v1; i2 = i1; v1 = x; i1 = e; }
            else if (x > v2) { v3 = v2; i3 = i2; v2 = x; i2 = e; }
            else if (x > v3) { v3 = x; i3 = e; } }
        const float e1 = __expf(v1 - v0), e2 = __expf(v2 - v0), e3 = __expf(v3 - v0), inv = 1.0f / (1.0f + e1 + e2 + e3);
        ie[0] = i0; ie[1] = i1; ie[2] = i2; ie[3] = i3; gt[0] = inv; gt[1] = e1 * inv; gt[2] = e2 * inv; gt[3] = e3 * inv;
#pragma unroll
        for (int k = 0; k < 4; ++k) rk[k] = __hip_atomic_fetch_add((LAS unsigned*)&hist[ie[k]], 1u, __ATOMIC_RELAXED, __HIP_MEMORY_SCOPE_WORKGROUP);
    }
    LDS_FENCE();
    if (lane < 32) { const unsigned cnt = hist[lane]; unsigned base = 0u; if (cnt) base = __hip_atomic_fetch_add(CNT + lane, cnt, __ATOMIC_RELAXED, __HIP_MEMORY_SCOPE_AGENT); basel[lane] = base; }
    LDS_FENCE();
    if (lane < 16) { const int t = t0 + lane;
#pragma unroll
        for (int k = 0; k < 4; ++k) { RIDX[t * 4 + k] = ie[k]; RGATE[t * 4 + k] = gt[k]; RPOS[t * 4 + k] = (int)(basel[ie[k]] + rk[k]); } }
    LDS_FENCE();
}

__device__ __forceinline__ void moe_tables(const Ctx& c, const unsigned* __restrict__ CNT, volatile LAS int* tab) {
    if (c.tid < 64) { const int e = c.tid & 31;
        const int n = (int)__hip_atomic_load(CNT + e, __ATOMIC_RELAXED, __HIP_MEMORY_SCOPE_AGENT); const int nb = (n + 255) >> 8;
        int incl = nb;
#pragma unroll
        for (int d = 1; d < 32; d <<= 1) { const int t = __shfl_up(incl, d, 32); if (e >= d) incl += t; }
        if (c.tid < 32) { const int excl = incl - nb; tab[e] = nb; tab[32 + e] = excl; tab[96 + e] = n; if (e == 31) tab[64] = incl;
            for (int i = 0; i < nb; ++i) tab[128 + excl + i] = e; } }
    __syncthreads();
}

__device__ const float INVF[32] = {1.0f, 0.7498942017555237f, 0.5623413324356079f, 0.4216965138912201f, 0.3162277638912201f, 0.23713737726211548f, 0.17782793939113617f, 0.1333521455526352f, 0.10000000149011612f, 0.0749894231557846f, 0.05623413249850273f, 0.04216964915394783f, 0.03162277489900589f, 0.023713737726211548f, 0.017782794311642647f, 0.013335213996469975f, 0.009999999776482582f, 0.007498942315578461f, 0.005623413249850273f, 0.0042169648222625256f, 0.003162277629598975f, 0.0023713738191872835f, 0.0017782794311642647f, 0.0013335214462131262f, 0.0010000000474974513f, 0.0007498941849917173f, 0.000562341301701963f, 0.0004216965171508491f, 0.0003162277571391314f, 0.00023713737027719617f, 0.00017782794020604342f, 0.0001333521504420787f};

struct Args { const void* in[33]; float* out; unsigned char* ws; int ph_lo, ph_hi; };

__global__ void __launch_bounds__(512, 2) mk_fwd(Args a) {
    extern __shared__ __attribute__((aligned(16))) unsigned char lds_raw[];
    Ctx c; c.lds = (LAS unsigned char*)lds_raw; c.tid = threadIdx.x; c.lane = c.tid & 63; c.wave = __builtin_amdgcn_readfirstlane(c.tid >> 6); c.G = gridDim.x;
    { const int bx = blockIdx.x; c.vcu = (c.G % 8 == 0) ? (bx % 8) * (c.G / 8) + bx / 8 : bx; }
    volatile LAS unsigned* MISC = (volatile LAS unsigned*)(c.lds + MISC_OFF);
    for (int u = c.tid; u < 1024; u += 512) MISC[u] = 0u;
    __syncthreads();
    unsigned char* ws = a.ws;
    unsigned* ctl = (unsigned*)(ws + WS_CTL);
    volatile LAS int* tab = (volatile LAS int*)(c.lds + MISC_OFF + 256);
#if MK_N_LAUNCHES == 1
    XcdBarrier bar = xcd_barrier_post(ctl + CW_BAR, MISC);
#define GRID_BAR() xcd_barrier(bar)
#else
#define GRID_BAR() do { } while (0)
#endif
    const int lo = a.ph_lo, hi = a.ph_hi;
#ifndef PHASE_MASK
#define PHASE_MASK 0xFFFF
#endif
#define IN(k) ((((PHASE_MASK) >> (k)) & 1) && lo <= (k) && (k) < hi)
#define BOTH(k) (IN(k) && IN((k) + 1))
#ifndef PROBE_ATT
#ifndef PROBE_ABL
#define PROBE_ABL 0
#endif
#ifndef PROBE_GU
#define PROBE_GU 0
#endif
#define PROBE_ATT 1
#endif
#ifndef PROBE_DUP
#define PROBE_DUP 0
#endif
#define NREP(k) (1 + (((PROBE_DUP) >> (k)) & 1))
#define REP_BEGIN(k) _Pragma("unroll 1") for (int rep_ = 0; rep_ < NREP(k); ++rep_) {
#define REP_END(k) if (rep_ + 1 < NREP(k)) GRID_BAR(); }
    const int gw = c.vcu * 8 + c.wave, NGW = c.G * 8, gtid = c.vcu * 512 + c.tid, NTHR = c.G * 512, lane = c.lane;
    const float* x = (const float*)a.in[0]; const float* cvec = (const float*)a.in[1]; const int* positions = (const int*)a.in[2];
    const float* w_ada = (const float*)a.in[3]; const float* b_ada = (const float*)a.in[4]; const float* norm_mix_g = (const float*)a.in[5]; const float* w_in = (const float*)a.in[6];
    const float* ssm_A_re = (const float*)a.in[7]; const float* ssm_A_im = (const float*)a.in[8]; const float* ssm_B_re = (const float*)a.in[9]; const float* ssm_B_im = (const float*)a.in[10];
    const float* ssm_C_re = (const float*)a.in[11]; const float* ssm_C_im = (const float*)a.in[12]; const float* ssm_D = (const float*)a.in[13]; const float* ssm_log_dt = (const float*)a.in[14];
    const float* q_lat_g = (const float*)a.in[15]; const float* kv_lat_g = (const float*)a.in[16]; const float* w_uq = (const float*)a.in[17]; const float* w_ukv = (const float*)a.in[18];
    const float* q_nope_g = (const float*)a.in[19]; const float* q_rope_g = (const float*)a.in[20]; const float* k_nope_g = (const float*)a.in[21]; const float* k_rope_g = (const float*)a.in[22];
    const float* out_ssm_g = (const float*)a.in[23]; const float* out_mla_g = (const float*)a.in[24]; const float* w_out = (const float*)a.in[25]; const float* norm_ffn_g = (const float*)a.in[26];
    const float* w_router = (const float*)a.in[27]; const float* b_router = (const float*)a.in[28]; const float* w_gate_up = (const float*)a.in[29]; const float* b_gate_up = (const float*)a.in[30];
    const float* w_down = (const float*)a.in[31]; const float* b_down = (const float*)a.in[32];
    float* out = a.out;
    float* MOD = (float*)(ws + WS_MOD); float* FA2 = (float*)(ws + WS_FAB2); float* FB2 = FA2 + 4096;
    float* APOW = (float*)(ws + WS_APOW); float* A64 = (float*)(ws + WS_A64); float* A1024 = (float*)(ws + WS_A1024); float* BB = (float*)(ws + WS_BB); float* KC = (float*)(ws + WS_KC);
    float* COS = (float*)(ws + WS_COS); float* SIN = (float*)(ws + WS_SIN);
    int* RIDX = (int*)(ws + WS_RIDX); float* RGATE = (float*)(ws + WS_RGATE); int* RPOS = (int*)(ws + WS_RPOS); int* SLOT = (int*)(ws + WS_SLOT); float* ROWGATE = (float*)(ws + WS_ROWGATE);
    bf16_t* WRT_HI = (bf16_t*)(ws + WS_WRT); bf16_t* WRT_LO = WRT_HI + 32 * 2048;
    bf16_t* WUQ = (bf16_t*)(ws + WS_WUQ); bf16_t* WUKV = (bf16_t*)(ws + WS_WUKV); bf16_t* WIN = (bf16_t*)(ws + WS_WIN); bf16_t* WOUT = (bf16_t*)(ws + WS_WOUT); bf16_t* WG = (bf16_t*)(ws + WS_WG);
    float* SEND = (float*)(ws + WS_SEND); bf16_t* KR = (bf16_t*)(ws + WS_KR); bf16_t* BTG = (bf16_t*)(ws + WS_BTG); bf16_t* AG = (bf16_t*)(ws + WS_AG); bf16_t* GS = (bf16_t*)(ws + WS_GS);
    bf16_t* Z2 = (bf16_t*)(ws + WS_Z2); bf16_t* H = (bf16_t*)(ws + WS_H); bf16_t* QRAW = (bf16_t*)(ws + WS_QRAW); bf16_t* KVRAW = (bf16_t*)(ws + WS_KVRAW);
    bf16_t* Q = (bf16_t*)(ws + WS_Q); bf16_t* KN = (bf16_t*)(ws + WS_KN); bf16_t* V = (bf16_t*)(ws + WS_V); bf16_t* YS = (bf16_t*)(ws + WS_YS); float* YM = (float*)(ws + WS_YM); bf16_t* MIX = (bf16_t*)(ws + WS_MIX);
    unsigned char* WGU = ws + WS_WGU; unsigned char* WDN = ws + WS_WDN; unsigned char* ACT = ws + WS_ACT; unsigned char* YB = ws + WS_YB; bf16_t* X1B = (bf16_t*)(ws + WS_YM);     unsigned char* XS = ws + WS_XS; unsigned char* H8 = ws + WS_H;
    unsigned* CNT = ctl + CW_CNT;

    if (IN(0)) {
        REP_BEGIN(0)
        for (int it = c.vcu; it < 192; it += c.G) p0_mod_chunk(c, it, cvec, w_ada, b_ada, MOD);
        for (int it = c.vcu; it < 256; it += c.G) p0_kc_item(c, it, ssm_A_re, ssm_A_im, ssm_B_re, ssm_B_im, ssm_C_re, ssm_C_im, ssm_D, ssm_log_dt, KC, BB);
        for (int i = gtid; i < 64 * 65 * 64; i += NTHR) { const int g = i / 4160, k = (i >> 6) % 65, p = i & 63; const float dt = expf(ssm_log_dt[g]), are = ssm_A_re[g * 64 + p], aim = ssm_A_im[g * 64 + p];
            float cs, sn; sincos_d((double)k * (double)dt * (double)aim, cs, sn); const float ex = expf((float)k * dt * are); APOW[2 * (size_t)i] = ex * cs; APOW[2 * (size_t)i + 1] = ex * sn; }
        for (int i = gtid; i < 4096; i += NTHR) { const int g = i >> 6; const float dt = expf(ssm_log_dt[g]), are = ssm_A_re[i], aim = ssm_A_im[i]; float cs, sn;
            sincos_d(64.0 * (double)dt * (double)aim, cs, sn); float ex = expf(64.0f * dt * are); A64[2 * i] = ex * cs; A64[2 * i + 1] = ex * sn;
            sincos_d(1024.0 * (double)dt * (double)aim, cs, sn); ex = expf(1024.0f * dt * are); A1024[2 * i] = ex * cs; A1024[2 * i + 1] = ex * sn; }
        for (int i = gtid; i < NTOK * 32; i += NTHR) { const int t = i >> 5, k = i & 31; const float ang = (float)positions[t] * INVF[k]; float cs, sn; sincos_d((double)ang, cs, sn); COS[i] = cs; SIN[i] = sn; }
        { const u32x4 z4 = {0u, 0u, 0u, 0u};
          u32x4* zw = (u32x4*)(WIN + (size_t)DIN * 2048); for (int i = gtid; i < (DINP - DIN) * 2048 / 8; i += NTHR) zw[i] = z4;
          for (int i = gtid; i < 64 * 128 * 1024 / 8; i += NTHR) { const int g = i >> 14, r = i & 16383; ((u32x4*)(WG + ((size_t)g * 256 + 128) * 1024))[r] = z4; } }
        for (int i = gtid; i < 32 * 2048; i += NTHR) { const int e = i >> 11, k = i & 2047; const float w = w_router[k * 32 + e]; const unsigned short hb = f2bf(w); WRT_HI[i] = hb; WRT_LO[i] = f2bf(w - bf2f(hb)); }
                constexpr int I_IN = 32 * 45, I_UQ = 8 * 24, I_UKV = 4 * 32, I_OUT = 32 * 32;
        constexpr int NIT = I_IN + I_UQ + I_UKV + I_OUT;
        for (int it = gw; it < NIT; it += NGW) {
            int r = it;
            if (r < I_IN) { tr_item<0>(w_in, DIN, nullptr, WIN, 2048, r / 45, r % 45, lane); continue; } r -= I_IN;
#if OUT_FP8
            if (r < I_OUT) { if (r < 16 * 32) { const int kb = r / 32; tr_item8<0>(w_out, 2048, (unsigned char*)WOUT, 2048, kb, r % 32, lane, kb < 8 ? out_ssm_g : out_mla_g - 1024); } continue; } r -= I_OUT;
#else
            if (r < I_OUT) { const int kb = r / 32; tr_item<0>(w_out, 2048, kb < 16 ? out_ssm_g : out_mla_g - 1024, WOUT, 2048, kb, r % 32, lane); continue; } r -= I_OUT;
#endif
            if (r < I_UQ) { tr_item<1>(w_uq, 1536, q_lat_g, WUQ, 1024, r / 24, r % 24, lane); continue; } r -= I_UQ;
            tr_item<0>(w_ukv, 2048, kv_lat_g, WUKV, 1024, r / 32, r % 32, lane);
        }
        REP_END(0)
        if (BOTH(0)) GRID_BAR();
    }
    if (IN(1)) {
        REP_BEGIN(1)
#pragma unroll 1
        for (int b = 0; b < 2; ++b) { f32x4 fa[8], fb[8];
#pragma unroll
            for (int j = 0; j < 8; ++j) { const int col = 4 * lane + 256 * j; const f32x4 g4 = *(const f32x4*)(norm_mix_g + col), sc4 = *(const f32x4*)(MOD + b * 12288 + 2048 + col); fa[j] = g4 * (1.0f + sc4); fb[j] = *(const f32x4*)(MOD + b * 12288 + col); }
#pragma unroll 1
            for (int row = b * SEQ + gw; row < (b + 1) * SEQ; row += 2 * NGW) { const int row1 = row + NGW; const bool two = row1 < (b + 1) * SEQ;
                const RowRaw ra = hnorm_load(x + (size_t)row * 2048, lane), rb = hnorm_load(x + (size_t)(two ? row1 : row) * 2048, lane);
                (void)hnorm_proc(ra, H + (size_t)row * 2048, fa, fb, lane); if (two) (void)hnorm_proc(rb, H + (size_t)row1 * 2048, fa, fb, lane); } }
        for (int i = gtid; i < 4096; i += NTHR) { const int b = i >> 11, k = i & 2047; FA2[i] = norm_ffn_g[k] * (1.0f + MOD[b * 12288 + 8192 + k]); FB2[i] = MOD[b * 12288 + 6144 + k]; }
        for (int i = gtid; i < 64 * 64 * 16 * 64 * 2; i += NTHR) { const int hh8 = i & 1, j = (i >> 1) & 63, h = (i >> 7) & 15, l = (i >> 11) & 63, g = i >> 17;
            if (j >= 16 * ((l >> 4) + 1)) continue;
            u32x4 w = {0u, 0u, 0u, 0u};
            if (j <= l) { const float* src = KC + ((size_t)(g * 64 + (l - j)) * 16 + h) * 16 + hh8 * 8; const f32x4 k0 = *(const f32x4*)src, k1 = *(const f32x4*)(src + 4);
                w.x = cvt_pk_bf16(k0[0], k0[1]); w.y = cvt_pk_bf16(k0[2], k0[3]); w.z = cvt_pk_bf16(k1[0], k1[1]); w.w = cvt_pk_bf16(k1[2], k1[3]); }
            *(u32x4*)(BTG + ((size_t)(g * 1024 + l * 16 + h)) * AGW + 128 + j * 16 + hh8 * 8) = w; }
        for (int i = gtid; i < 64 * 64 * 16 * 16; i += NTHR) { const int cg = i & 15, h = (i >> 4) & 15, l = (i >> 8) & 63, g = i >> 14, part = cg >> 3, p0 = (cg & 7) * 8; float v[8];
#pragma unroll
            for (int e = 0; e < 8; ++e) { const int p = p0 + e; const float cr = ssm_C_re[(g * 16 + h) * 64 + p], ci = ssm_C_im[(g * 16 + h) * 64 + p]; const float ar = APOW[((size_t)(g * 65 + l + 1) * 64 + p) * 2], ai = APOW[((size_t)(g * 65 + l + 1) * 64 + p) * 2 + 1];
                v[e] = part ? -(cr * ai + ci * ar) : (cr * ar - ci * ai); }
            u32x4 w; w.x = cvt_pk_bf16(v[0], v[1]); w.y = cvt_pk_bf16(v[2], v[3]); w.z = cvt_pk_bf16(v[4], v[5]); w.w = cvt_pk_bf16(v[6], v[7]);
            *(u32x4*)(BTG + ((size_t)(g * 1024 + l * 16 + h)) * AGW + cg * 8) = w; }
        for (int i = gtid; i < 64 * 128 * 64 * 2; i += NTHR) { const int hh8 = i & 1, j = (i >> 1) & 63, prow = (i >> 7) & 127, g = i >> 14, p = prow & 63, part = prow >> 6;
            const float ar = APOW[((size_t)(g * 65 + 63 - j) * 64 + p) * 2], ai = APOW[((size_t)(g * 65 + 63 - j) * 64 + p) * 2 + 1]; float v[8];
#pragma unroll
            for (int e = 0; e < 8; ++e) { const float br = BB[((size_t)(g * 64 + p) * 16 + hh8 * 8 + e) * 2], bi = BB[((size_t)(g * 64 + p) * 16 + hh8 * 8 + e) * 2 + 1]; v[e] = part ? (ar * bi + ai * br) : (ar * br - ai * bi); }
            u32x4 w; w.x = cvt_pk_bf16(v[0], v[1]); w.y = cvt_pk_bf16(v[2], v[3]); w.z = cvt_pk_bf16(v[4], v[5]); w.w = cvt_pk_bf16(v[6], v[7]);
            *(u32x4*)(WG + ((size_t)(g * 256 + prow)) * 1024 + j * 16 + hh8 * 8) = w; }
        REP_END(1)
        if (BOTH(1)) GRID_BAR();
    }
    if (IN(2)) {
        REP_BEGIN(2)
        SchedDense S{(const char*)H, (const char*)WIN, 4096u, 4096u, 128, 12, 32, c.G, (int)blockIdx.x}; EpiZ E{AG, GS, Z2};
        pg8::gemm_phase<EpiZ, SchedDense>(c.lds, 4096u, 4096u, S, E);
        REP_END(2)
        if (BOTH(2)) GRID_BAR();
    }
    if (IN(3)) {
        REP_BEGIN(3)
        SchedP3 S{(const char*)AG, (const char*)WG, (const char*)Z2, (const char*)WUQ, (const char*)WUKV, c.G, (int)blockIdx.x}; EpiP3 E{QRAW, KVRAW, SEND};
        pg8::gemm_phase<EpiP3, SchedP3>(c.lds, (unsigned)(AGW * 2), 2048u, S, E);
        REP_END(3)
        if (BOTH(3)) GRID_BAR();
    }
    if (IN(4)) {
        REP_BEGIN(4)
        for (int it = c.vcu; it < 256; it += c.G) p4_carry_item(c, it, SEND, A64, A1024, AG);
        { const QkGain gn = p4_gains(lane, q_nope_g, q_rope_g, k_nope_g, k_rope_g);
#if ATT_PV8
#pragma unroll 1
          for (int tile = c.vcu; tile < NTOK / 64; tile += c.G) {
#pragma unroll 1
              for (int i = 0; i < 8; i += 2) { const int t = tile * 64 + c.wave * 8 + i;
                  const QkRaw ra = p4_load(t, lane, Z2, QRAW, KVRAW, COS, SIN), rb = p4_load(t + 1, lane, Z2, QRAW, KVRAW, COS, SIN);
                  p4_proc(t, lane, ra, gn, Q, KN, V, KR, c.lds); p4_proc(t + 1, lane, rb, gn, Q, KN, V, KR, c.lds); }
              __syncthreads();
              { const int b = tile >> 8, tl = tile & 255; unsigned char* V8T = (unsigned char*)V;
#pragma unroll
                for (int q = 0; q < 8; ++q) { const int o = (c.tid + 512 * q) * 16, h = o >> 13, within = o & 8191;
                    *(u32x4*)(V8T + ((size_t)((b * NH + h) * 256 + tl)) * 8192 + within) = *(const LAS u32x4*)(c.lds + o); } }
              __syncthreads(); }
#else
#pragma unroll 1
          for (int t = gw; t < NTOK; t += 2 * NGW) { const int t1 = t + NGW; const bool two = t1 < NTOK;
              const QkRaw ra = p4_load(t, lane, Z2, QRAW, KVRAW, COS, SIN), rb = p4_load(two ? t1 : t, lane, Z2, QRAW, KVRAW, COS, SIN);
              p4_proc(t, lane, ra, gn, Q, KN, V, KR, c.lds); if (two) p4_proc(t1, lane, rb, gn, Q, KN, V, KR, c.lds); }
#endif
        }
        REP_END(4)
        if (BOTH(4)) GRID_BAR();
    }
    if (IN(5)) {
        REP_BEGIN(5)
#ifndef NO_SSM
        { SchedSsm S{(const char*)AG, (const char*)BTG, c.G, (int)blockIdx.x}; EpiSsm E{GS, YS};
          pg8::gemm_phase<EpiSsm, SchedSsm>(c.lds, (unsigned)(AGW * 2), (unsigned)(AGW * 2), S, E); }
#endif
        __syncthreads();
#ifndef NO_ATT
        { const bool spread = (c.G % 4 == 0); const bool conv = spread ? ((int)blockIdx.x < (c.G >> 1)) : true;
          if (conv) { const int gwc = spread ? (int)blockIdx.x * 8 + c.wave : gw, NGWC = spread ? (c.G >> 1) * 8 : NGW;
#if MOE_FP8
            constexpr int I_GU = 16 * 64, I_DN = 16 * 32;
#else
            constexpr int I_GU = 32 * 64, I_DN = 32 * 32;
#endif
#pragma unroll 1
            for (int it = gwc; it < 32 * (I_GU + I_DN); it += NGWC) {
                if (it < 32 * I_GU) { const int e = it / I_GU, q = it % I_GU;
#if MOE_FP8
                    tr_item8<2>(w_gate_up + (size_t)e * 2048 * 4096, 4096, WGU + (size_t)e * 4096 * 2048, 2048, q / 64, q % 64, lane);
#else
                    tr_item<2>(w_gate_up + (size_t)e * 2048 * 4096, 4096, nullptr, (bf16_t*)WGU + (size_t)e * 4096 * 2048, 2048, q / 64, q % 64, lane);
#endif
                } else { const int r = it - 32 * I_GU, e = r / I_DN, q = r % I_DN;
#if MOE_FP8
                    tr_item8<0>(w_down + (size_t)e * 2048 * 2048, 2048, WDN + (size_t)e * 2048 * 2048, 2048, q / 32, q % 32, lane);
#else
                    tr_item<0>(w_down + (size_t)e * 2048 * 2048, 2048, nullptr, (bf16_t*)WDN + (size_t)e * 2048 * 2048, 2048, q / 32, q % 32, lane);
#endif
                } } } }
#pragma unroll 1
        for (;;) {
            __syncthreads();
            if (c.tid == 0) MISC[16] = __hip_atomic_fetch_add(ctl + CW_ATT, 1u, __ATOMIC_RELAXED, __HIP_MEMORY_SCOPE_AGENT);
            __syncthreads();
            const unsigned u = MISC[16];
            if (u >= 1024u * PROBE_ATT) break;
            const int uu = (int)(u & 1023u), qb = 63 - (uu >> 4), bh = uu & 15, b = bh >> 3, h = bh & 7;
#if ATT_FP8 && ATT_PV8
#if PROBE_ABL
            if (u >= 1024u) att::attn_block9<PROBE_ABL>((const unsigned char*)Q + ((size_t)(b * NH + h) * SEQ + qb * 256) * 192, (const unsigned char*)KN + (size_t)(b * NH + h) * SEQ * 128, (const unsigned char*)V + (size_t)(b * NH + h) * 256 * 8192, (const unsigned char*)KR + (size_t)b * SEQ * 64,
                             YM + ((size_t)(b * SEQ + qb * 256)) * 1024 + h * 128, qb, (char*)lds_raw); else
#endif
            att::attn_block9((const unsigned char*)Q + ((size_t)(b * NH + h) * SEQ + qb * 256) * 192, (const unsigned char*)KN + (size_t)(b * NH + h) * SEQ * 128, (const unsigned char*)V + (size_t)(b * NH + h) * 256 * 8192, (const unsigned char*)KR + (size_t)b * SEQ * 64,
                             YM + ((size_t)(b * SEQ + qb * 256)) * 1024 + h * 128, qb, (char*)lds_raw);
#elif ATT_FP8
            att::attn_block8((const unsigned char*)Q + ((size_t)(b * NH + h) * SEQ + qb * 256) * 192, (const unsigned char*)KN + (size_t)(b * NH + h) * SEQ * 128, V + (size_t)(b * NH + h) * SEQ * 128, (const unsigned char*)KR + (size_t)b * SEQ * 64,
                             YM + ((size_t)(b * SEQ + qb * 256)) * 1024 + h * 128, qb, (char*)lds_raw);
#else
            att::attn_block(Q + ((size_t)(b * NH + h) * SEQ + qb * 256) * 192, KN + (size_t)(b * NH + h) * SEQ * 128, V + (size_t)(b * NH + h) * SEQ * 128, KR + (size_t)b * SEQ * 64,
                            YM + ((size_t)(b * SEQ + qb * 256)) * 1024 + h * 128, qb, (char*)lds_raw);
#endif
        }
#endif
        REP_END(5)
        if (BOTH(5)) GRID_BAR();
    }
    if (IN(6)) {
        REP_BEGIN(6)
#pragma unroll 1
        for (int t = gw; t < NTOK; t += 4 * NGW) { const int t1 = t + NGW, t2 = t + 2 * NGW, t3 = t + 3 * NGW;
            const MixRaw ra = p6_load(t, lane, YS, YM), rb = p6_load(t1 < NTOK ? t1 : t, lane, YS, YM), rc = p6_load(t2 < NTOK ? t2 : t, lane, YS, YM), rd = p6_load(t3 < NTOK ? t3 : t, lane, YS, YM);
            p6_proc(t, lane, ra, MIX); if (t1 < NTOK) p6_proc(t1, lane, rb, MIX); if (t2 < NTOK) p6_proc(t2, lane, rc, MIX); if (t3 < NTOK) p6_proc(t3, lane, rd, MIX); }
        REP_END(6)
        if (BOTH(6)) GRID_BAR();
    }
    if (IN(7)) {
        REP_BEGIN(7)
        constexpr unsigned OB = OUT_FP8 ? 2048u : 4096u;
        SchedDense S{(const char*)MIX, (const char*)WOUT, OB, OB, 128, 8, OUT_FP8 ? 16 : 32, c.G, (int)blockIdx.x}; EpiOut E{x, X1B, MOD};
        pg8::gemm_phase<EpiOut, SchedDense, OUT_FP8 != 0>(c.lds, OB, OB, S, E);
        REP_END(7)
        if (BOTH(7)) GRID_BAR();
    }
    if (IN(8)) {
        REP_BEGIN(8)
        for (int grp = gw; grp < NTOK / 16; grp += NGW) p8_group(grp, lane, (LAS float*)(c.lds + c.wave * 4096), X1B, FA2, FB2, WRT_HI, WRT_LO, b_router, H8, RIDX, RGATE, RPOS, CNT);
        REP_END(8)
        if (BOTH(8)) GRID_BAR();
    }
    if (IN(9)) {
        REP_BEGIN(9)
        moe_tables(c, CNT, tab);
#pragma unroll 1
        for (int t = gw; t < NTOK; t += NGW) { constexpr int RB = MOE_FP8 ? 2048 : 4096;
            const u32x4 ev = *(const u32x4*)(RIDX + t * 4), pv = *(const u32x4*)(RPOS + t * 4); const f32x4 gv = *(const f32x4*)(RGATE + t * 4);
            const u32x4* src = (const u32x4*)(H8 + (size_t)t * RB); u32x4 vv[RB / 1024];
#pragma unroll
            for (int j = 0; j < RB / 1024; ++j) vv[j] = src[lane + 64 * j];
            const int sl[4] = {tab[32 + (int)ev.x] * 256 + (int)pv.x, tab[32 + (int)ev.y] * 256 + (int)pv.y, tab[32 + (int)ev.z] * 256 + (int)pv.z, tab[32 + (int)ev.w] * 256 + (int)pv.w};
#pragma unroll
            for (int k = 0; k < 4; ++k) { u32x4* dst = (u32x4*)(XS + (size_t)sl[k] * RB);
#pragma unroll
                for (int j = 0; j < RB / 1024; ++j) dst[lane + 64 * j] = vv[j]; }
            if (lane == 0) { ROWGATE[sl[0]] = gv[0]; ROWGATE[sl[1]] = gv[1]; ROWGATE[sl[2]] = gv[2]; ROWGATE[sl[3]] = gv[3]; *(u32x4*)(SLOT + t * 4) = (u32x4){(unsigned)sl[0], (unsigned)sl[1], (unsigned)sl[2], (unsigned)sl[3]}; } }
        for (int it = gw; it < 32 * 256; it += NGW) { const int e = it >> 8, r = it & 255, n = tab[96 + e];
            if (n + r < tab[e] * 256) { const int slot = tab[32 + e] * 256 + n + r; constexpr int RB = MOE_FP8 ? 2048 : 4096; u32x4* dst = (u32x4*)(XS + (size_t)slot * RB); const u32x4 z4 = {0u, 0u, 0u, 0u};
#pragma unroll
                for (int j = 0; j < RB / 1024; ++j) dst[lane + 64 * j] = z4;
                if (lane == 0) ROWGATE[slot] = 0.f; } }
        REP_END(9)
        if (BOTH(9)) GRID_BAR();
    }
    if (IN(10)) {
        REP_BEGIN(10)
        moe_tables(c, CNT, tab);
        constexpr unsigned RB = MOE_FP8 ? 2048u : 4096u;
        SchedMoe S{(const char*)XS, (const char*)WGU, tab, 16, c.G, (int)blockIdx.x, (size_t)4096 * RB, RB, MOE_FP8 ? 16 : 32}; EpiGu E{b_gate_up, ACT};
        pg8::gemm_phase<EpiGu, SchedMoe, MOE_FP8 != 0>(c.lds, RB, RB, S, E);
#if PROBE_GU
        __syncthreads(); pg8::gemm_phase<EpiGu, SchedMoe, MOE_FP8 != 0, PROBE_GU>(c.lds, RB, RB, S, E); __syncthreads();
#endif
        REP_END(10)
        if (BOTH(10)) GRID_BAR();
    }
    if (IN(11)) {
        REP_BEGIN(11)
        moe_tables(c, CNT, tab);
        constexpr unsigned RB = MOE_FP8 ? 2048u : 4096u;
        SchedMoe S{(const char*)ACT, (const char*)WDN, tab, 8, c.G, (int)blockIdx.x, (size_t)2048 * RB, RB, MOE_FP8 ? 16 : 32}; EpiDn E{b_down, ROWGATE, YB};
        pg8::gemm_phase<EpiDn, SchedMoe, MOE_FP8 != 0>(c.lds, RB, RB, S, E);
        REP_END(11)
        if (BOTH(11)) GRID_BAR();
    }
    if (IN(12)) {
        typedef float f32x2_t __attribute__((ext_vector_type(2)));
        u32x4 slq = (gw < NTOK) ? *(const u32x4*)(SLOT + gw * 4) : (u32x4){0u, 0u, 0u, 0u};
#pragma unroll 1
        for (int t = gw; t < NTOK; t += NGW) { const int b = t >> 14; const int s0 = (int)slq[0], s1 = (int)slq[1], s2 = (int)slq[2], s3 = (int)slq[3];
            if (t + NGW < NTOK) slq = *(const u32x4*)(SLOT + (t + NGW) * 4);
#pragma unroll
            for (int j = 0; j < 4; ++j) { const int col = 8 * lane + 512 * j;
                const u32x2 y0 = __builtin_nontemporal_load((const u32x2*)(YB + (size_t)s0 * 2048 + col)), y1 = __builtin_nontemporal_load((const u32x2*)(YB + (size_t)s1 * 2048 + col)), y2 = __builtin_nontemporal_load((const u32x2*)(YB + (size_t)s2 * 2048 + col)), y3 = __builtin_nontemporal_load((const u32x2*)(YB + (size_t)s3 * 2048 + col));
                const f32x4 g0 = *(const f32x4*)(MOD + b * 12288 + 10240 + col) * YB_INV, g1 = *(const f32x4*)(MOD + b * 12288 + 10240 + col + 4) * YB_INV;
                const u32x4 xw = *(const u32x4*)(X1B + (size_t)t * 2048 + col);
                f32x4 o0 = {bflo(xw.x), bfhi(xw.x), bflo(xw.y), bfhi(xw.y)}, o1 = {bflo(xw.z), bfhi(xw.z), bflo(xw.w), bfhi(xw.w)};
#define SUM4(W, HI) (((__builtin_amdgcn_cvt_pk_f32_fp8((int)y0.W, HI) + __builtin_amdgcn_cvt_pk_f32_fp8((int)y1.W, HI)) + __builtin_amdgcn_cvt_pk_f32_fp8((int)y2.W, HI)) + __builtin_amdgcn_cvt_pk_f32_fp8((int)y3.W, HI))
                const f32x2_t a0 = SUM4(x, false), a1 = SUM4(x, true), a2 = SUM4(y, false), a3 = SUM4(y, true);
#undef SUM4
                o0[0] += g0[0] * a0[0]; o0[1] += g0[1] * a0[1]; o0[2] += g0[2] * a1[0]; o0[3] += g0[3] * a1[1];
                o1[0] += g1[0] * a2[0]; o1[1] += g1[1] * a2[1]; o1[2] += g1[2] * a3[0]; o1[3] += g1[3] * a3[1];
                float* op = out + (size_t)t * 2048 + col; __builtin_nontemporal_store(o0, (f32x4*)op); __builtin_nontemporal_store(o1, (f32x4*)(op + 4)); } }
    }
#undef IN
#undef BOTH
#undef GRID_BAR
}

extern "C" void kernel_launch(void* const* d_in, const int* in_sizes, int n_in, void* d_out, int out_size, void* d_ws, size_t ws_size, hipStream_t stream) {
    static int grid = 0;
    if (grid == 0) {
        if (n_in != 33 || out_size != NTOK * DM || ws_size < WS_END) { fprintf(stderr, "kernel_launch: unexpected shapes (n_in %d out %d ws %zu, need ws >= %zu)\n", n_in, out_size, ws_size, (size_t)WS_END); grid = -1; return; }
        int dev = 0, cus = 0, per_cu = 0;
        if (hipGetDevice(&dev) != hipSuccess || hipDeviceGetAttribute(&cus, hipDeviceAttributeMultiprocessorCount, dev) != hipSuccess) { grid = -1; return; }
        if (hipFuncSetAttribute((const void*)mk_fwd, hipFuncAttributeMaxDynamicSharedMemorySize, LDS_BYTES) != hipSuccess) { fprintf(stderr, "kernel_launch: hipFuncSetAttribute failed\n"); grid = -1; return; }
        if (hipOccupancyMaxActiveBlocksPerMultiprocessor(&per_cu, (const void*)mk_fwd, 512, LDS_BYTES) != hipSuccess || per_cu < 1) fprintf(stderr, "kernel_launch: occupancy query reports %d\n", per_cu);
        (void)hipGetLastError();
        grid = cus;
    }
    if (grid < 0) return;
    (void)hipMemsetAsync((char*)d_ws + WS_CTL, 0, CTL_BYTES, stream);
    Args a{};
    for (int i = 0; i < 33; ++i) a.in[i] = d_in[i];
    a.out = (float*)d_out; a.ws = (unsigned char*)d_ws;
#if MK_N_LAUNCHES == 1
    a.ph_lo = 0; a.ph_hi = NPHASE;
    hipLaunchKernelGGL(mk_fwd, dim3(grid), dim3(512), LDS_BYTES, stream, a);
#else
    for (int k = 0; k < NPHASE; ++k) { a.ph_lo = k; a.ph_hi = k + 1; hipLaunchKernelGGL(mk_fwd, dim3(grid), dim3(512), LDS_BYTES, stream, a); }
#endif
    const hipError_t le = hipPeekAtLastError();
    if (le != hipSuccess) fprintf(stderr, "kernel_launch: launch failed: %s\n", hipGetErrorName(le));
}
```

```cpp
#include <hip/hip_runtime.h>
#include <cstdio>
#include <cstdint>

#ifndef ATT_PV8
#define ATT_PV8 1
#endif
#ifndef ATT_FP8
#define ATT_FP8 1
#endif
#ifndef MOE_FP8
#define MOE_FP8 1
#endif
#ifndef MK_N_LAUNCHES
#define MK_N_LAUNCHES 1
#endif

#define LAS __attribute__((address_space(3)))
#define GAS __attribute__((address_space(1)))
typedef unsigned short bf16_t;
typedef short bf16x8 __attribute__((ext_vector_type(8)));
typedef short s16x4 __attribute__((ext_vector_type(4)));
typedef float f32x4 __attribute__((ext_vector_type(4)));
typedef float f32x2 __attribute__((ext_vector_type(2)));
typedef float f32x16 __attribute__((ext_vector_type(16)));
typedef unsigned u32x4 __attribute__((ext_vector_type(4)));
typedef unsigned u32x2 __attribute__((ext_vector_type(2)));

constexpr int NB = 2, SEQ = 16384, NTOK = NB * SEQ, DM = 2048;
constexpr int DSSM = 1024, NG = 64, SG = 16, SP = 64, NCH = NTOK / 64;
constexpr int NH = 8, QL = 512, KVL = 256;
constexpr int DIN = 2880, DINP = 3072;
constexpr int NE = 32, DFF = 2048;
constexpr int AGW = 1152;
constexpr int MAXBLK = 544, MAXROWS = MAXBLK * 256;
constexpr float EPS = 1e-6f;
constexpr int NPHASE = 13;

constexpr size_t MiB = 1u << 20;
constexpr size_t WS_CTL = 0, CTL_BYTES = 1 * MiB;
constexpr size_t WS_MOD = 1 * MiB;
constexpr size_t WS_FAB2 = WS_MOD + 512 * 1024;
constexpr size_t WS_APOW = 2 * MiB;
constexpr size_t WS_A64 = 5 * MiB;
constexpr size_t WS_A1024 = WS_A64 + 64 * 1024;
constexpr size_t WS_BB = WS_A64 + 128 * 1024;
constexpr size_t WS_KC = 6 * MiB;
constexpr size_t WS_COS = 10 * MiB, WS_SIN = 14 * MiB;
constexpr size_t WS_RIDX = 18 * MiB;
constexpr size_t WS_RGATE = WS_RIDX + 512 * 1024;
constexpr size_t WS_RPOS = WS_RGATE + 512 * 1024;
constexpr size_t WS_SLOT = WS_RPOS + 512 * 1024;
constexpr size_t WS_ROWGATE = 20 * MiB;
constexpr size_t WS_WRT = 21 * MiB;
constexpr size_t WS_WUQ = 22 * MiB, WS_WUKV = 25 * MiB, WS_WIN = 30 * MiB, WS_WOUT = 42 * MiB, WS_WG = 50 * MiB, WS_SEND = 82 * MiB, WS_KR = 98 * MiB;
constexpr size_t WS_BTG = 104 * MiB, WS_AG = 248 * MiB, WS_GS = 320 * MiB, WS_Z2 = 384 * MiB, WS_H = 456 * MiB, WS_QRAW = 584 * MiB, WS_KVRAW = 680 * MiB;
constexpr size_t WS_Q = 808 * MiB, WS_KN = 904 * MiB, WS_V = 968 * MiB, WS_YS = 1032 * MiB, WS_YM = 1096 * MiB, WS_MIX = 1224 * MiB;
constexpr size_t WS_WGU = 1352 * MiB, WS_WDN = 1864 * MiB, WS_ACT = 2120 * MiB, WS_YB = 2664 * MiB, WS_END = 3208 * MiB;
constexpr size_t WS_XS = WS_QRAW;
static_assert(WS_XS + (size_t)MAXROWS * 2048 * 2 <= WS_MIX, "XS overlay must end before MIX");
constexpr int CW_CNT = 64;
constexpr int CW_BAR = 4096;
constexpr int CW_ATT = 128;

constexpr int RING_BYTES = 131072;
constexpr int MISC_OFF = RING_BYTES;
constexpr int LDS_BYTES = 147456;
constexpr int AUX_OFF = MISC_OFF + 4096;

__device__ __forceinline__ float wave_sum(float v) {
#pragma unroll
    for (int o = 1; o < 64; o <<= 1) v += __shfl_xor(v, o);
    return v;
}
__device__ __forceinline__ unsigned cvt_pk_bf16(float lo, float hi) { unsigned r; asm volatile("v_cvt_pk_bf16_f32 %0, %1, %2" : "=v"(r) : "v"(lo), "v"(hi)); return r; }
__device__ __forceinline__ float bf2f(unsigned short b) { return __uint_as_float(((unsigned)b) << 16); }
__device__ __forceinline__ float bflo(unsigned w) { return __uint_as_float(w << 16); }
__device__ __forceinline__ float bfhi(unsigned w) { return __uint_as_float(w & 0xffff0000u); }
__device__ __forceinline__ unsigned short f2bf(float f) { return (unsigned short)(cvt_pk_bf16(f, 0.f) & 0xffffu); }
__device__ __forceinline__ float sigmoidf_(float x) { return __builtin_amdgcn_rcpf(1.0f + __builtin_amdgcn_exp2f(-1.4426950408889634f * x)); }
__device__ __forceinline__ void sincos_d(double theta, float& c, float& s) {
    double t = theta * 0.15915494309189535; t -= rint(t);
    const double r = t * 6.283185307179586;
    const double q = rint(r * 0.6366197723675814);
    const double y = r - q * 1.5707963267948966, y2 = y * y;
    const double sn = y * (1.0 + y2 * (-1.0 / 6 + y2 * (1.0 / 120 + y2 * (-1.0 / 5040 + y2 * (1.0 / 362880 + y2 * (-1.0 / 39916800))))));
    const double cs = 1.0 + y2 * (-0.5 + y2 * (1.0 / 24 + y2 * (-1.0 / 720 + y2 * (1.0 / 40320 + y2 * (-1.0 / 3628800 + y2 * (1.0 / 479001600))))));
    const int qi = ((int)q) & 3;
    const double co = (qi == 0) ? cs : (qi == 1) ? -sn : (qi == 2) ? -cs : sn;
    const double si = (qi == 0) ? sn : (qi == 1) ? cs : (qi == 2) ? -sn : -cs;
    c = (float)co; s = (float)si;
}

#define XB_TMO      128
#define XB_XCNT(j)  (256  + 64 * (j))
#define XB_XSUB(j)  (1280 + 64 * (j))
#define XB_XGEN(j)  (2304 + 64 * (j))
#define XB_TOP      3328
#define XB_TOPGEN   3392
#define XCD_BAR_WORDS 3456
#define XB_SPIN_CAP (1u << 22)
__device__ __forceinline__ unsigned xb_ld(unsigned* p)              { return __hip_atomic_load(p, __ATOMIC_RELAXED, __HIP_MEMORY_SCOPE_AGENT); }
__device__ __forceinline__ unsigned xb_add(unsigned* p, unsigned v) { return __hip_atomic_fetch_add(p, v, __ATOMIC_RELAXED, __HIP_MEMORY_SCOPE_AGENT); }
__device__ __forceinline__ unsigned xb_xcc_id() { return (unsigned)__builtin_amdgcn_s_getreg((3 << 11) | 20) & 0xFu; }
#define XB_SPIN(cond, bar) do { unsigned _sp = 0; while (cond) { __builtin_amdgcn_s_sleep(1); \
    if ((++_sp & 255u) == 0u) { if (xb_ld(&(bar)[XB_TMO])) break; if (_sp > XB_SPIN_CAP) { atomicAdd(&(bar)[XB_TMO], 1u); break; } } } } while (0)
struct XcdBarrier { unsigned* bar; unsigned x; volatile LAS unsigned* st; };
__device__ __forceinline__ XcdBarrier xcd_barrier_post(unsigned* bar, volatile LAS unsigned* st) {
    XcdBarrier b; b.bar = bar; b.x = xb_xcc_id(); b.st = st;
    if (threadIdx.x == 0) (void)xb_add(&bar[XB_XCNT(b.x)], 1u);
    return b;
}
__device__ __forceinline__ void xcd_barrier_complete(unsigned* bar, unsigned x, unsigned& nloc, unsigned& nx) {
    const unsigned G = gridDim.x * gridDim.y * gridDim.z;
    unsigned sum, cnt, mine, sp = 0u;
    for (;;) {
        sum = 0u; cnt = 0u; mine = 0u;
#pragma unroll
        for (unsigned j = 0; j < 16; ++j) { const unsigned c = xb_ld(&bar[XB_XCNT(j)]); sum += c; cnt += (c > 0u) ? 1u : 0u; mine = (j == x) ? c : mine; }
        if (sum == G) break;
        __builtin_amdgcn_s_sleep(1);
        if ((++sp & 255u) == 0u) { if (xb_ld(&bar[XB_TMO])) break; if (sp > XB_SPIN_CAP) { atomicAdd(&bar[XB_TMO], 1u); break; } }
    }
    nloc = mine > 0u ? mine : 1u; nx = cnt > 0u ? cnt : 1u;
}
__device__ __forceinline__ void xcd_barrier(const XcdBarrier& b) {
    asm volatile("s_waitcnt vmcnt(0)" ::: "memory");
    __syncthreads();
    if (threadIdx.x == 0) {
        unsigned* bar = b.bar;
        __builtin_amdgcn_s_waitcnt(0);
        unsigned nloc = b.st[0], nx = b.st[1];
        if (nloc == 0u) { xcd_barrier_complete(bar, b.x, nloc, nx); b.st[0] = nloc; b.st[1] = nx; }
        const unsigned old = xb_add(&bar[XB_XSUB(b.x)], 1u);
        const unsigned gen = old / nloc;
        if (old + 1u == (gen + 1u) * nloc) {
            __builtin_amdgcn_fence(__ATOMIC_RELEASE, "agent");
            asm volatile("s_waitcnt vmcnt(0)" ::: "memory");
            const unsigned og = xb_add(&bar[XB_TOP], 1u);
            const unsigned tg = og / nx;
            if (og + 1u == (tg + 1u) * nx) xb_add(&bar[XB_TOPGEN], 1u);
            else XB_SPIN(xb_ld(&bar[XB_TOPGEN]) == tg, bar);
            __builtin_amdgcn_fence(__ATOMIC_ACQUIRE, "agent");
            xb_add(&bar[XB_XGEN(b.x)], 1u);
            asm volatile("s_waitcnt vmcnt(0)" ::: "memory");
        } else {
            XB_SPIN(xb_ld(&bar[XB_XGEN(b.x)]) == gen, bar);
            __builtin_amdgcn_fence(__ATOMIC_ACQUIRE, "agent");
            asm volatile("s_waitcnt vmcnt(0)" ::: "memory");
        }
    }
    __syncthreads();
}

namespace pg8 {
constexpr int BM = 256, BK = 64, HALF = 128, HTB = HALF * BK * 2, STAGE_BYTES = 8 * HTB, NXCD = 8, WGM = 8;
__host__ __device__ __forceinline__ int lds_byte(int r, int c) { const int st = (r >> 4) * 2 + (c >> 5), rr = r & 15, cc = c & 31, ob = rr * 64 + cc * 2; return st * 1024 + (ob ^ (((ob >> 9) & 1) << 5)); }
__host__ __device__ __forceinline__ void stage_rc(int b, int& R, int& C) { const int st = b / 1024, sb = b % 1024, swz = sb ^ (((sb >> 9) & 1) << 5); R = (st >> 1) * 16 + swz / 64; C = (st & 1) * 32 + (swz % 64) / 2; }
__host__ __device__ __forceinline__ int perm32(int rho) { const int n = rho >> 4, i = rho & 15; return 8 * (i >> 2) + 4 * n + (i & 3); }

struct Unit { const char* A; const char* B; int nt, pm, pn, aux; };

__device__ __forceinline__ void dense_map(int L, int nM, int nN, int& pm, int& pn) {
    const int nwg = nM * nN; int wgid = L;
    { const int q = nwg / NXCD, r = nwg % NXCD, xcd = wgid % NXCD, off = wgid / NXCD; wgid = (xcd < r ? xcd * (q + 1) : r * (q + 1) + (xcd - r) * q) + off; }
    const int nig = WGM * nN, gid = wgid / nig, fm = gid * WGM, gsz = (nM - fm) < WGM ? (nM - fm) : WGM;
    pm = fm + ((wgid % nig) % gsz); pn = (wgid % nig) / gsz;
}

typedef int v8i_t __attribute__((ext_vector_type(8)));
typedef int v4i_t __attribute__((ext_vector_type(4)));
template <class Epi, class Sched, bool FP8 = false, int PRB = 0>
__device__ __forceinline__ void gemm_phase(LAS unsigned char* lds, const unsigned lda, const unsigned ldb, const Sched& S, const Epi& E) {
    const int tid = threadIdx.x, wid = __builtin_amdgcn_readfirstlane(tid >> 6), lane = tid & 63, wr = wid >> 2, wc = wid & 3, fr = lane & 15, fq = lane >> 4;
    unsigned voffA[2], voffB[2];
#pragma unroll
    for (int i = 0; i < 2; ++i) { int R, C; stage_rc(tid * 16 + i * 8192, R, C); const int Rb = Epi::PERM ? ((R & ~31) + perm32(R & 31)) : R;
        voffA[i] = (unsigned)R * lda + (unsigned)C * 2u; voffB[i] = (unsigned)Rb * ldb + (unsigned)C * 2u; }
    const size_t kstep = (size_t)(BK * 2);
    const size_t hstepA = (size_t)HALF * lda, hstepB = (size_t)HALF * ldb;
    const unsigned ldsw = (unsigned)wid * 1024u;
    const int aoff = lds_byte(wr * 64 + fr, fq * 8), boff = lds_byte(wc * 32 + fr, fq * 8);
#define PG8_SA(b, h) (((b) * 2 + (h)) * HTB)
#define PG8_SB(b, h) ((4 + (b) * 2 + (h)) * HTB)
#define PG8_STAGE(bufoff, gbase, voff) do { if constexpr (PRB != 1) { _Pragma("unroll") for (int _i = 0; _i < 2; ++_i) \
        __builtin_amdgcn_global_load_lds((const unsigned*)((const char*)(gbase) + (voff)[_i]), (LAS unsigned*)(lds + (bufoff) + ldsw + _i * 8192), 16, 0, 0); } } while (0)
#define PG8_LDA(dst, b, h) do { _Pragma("unroll") for (int m = 0; m < 4; ++m) { const v4i_t lo_ = *(const LAS v4i_t*)(lds + PG8_SA(b, h) + aoff + m * 2048), hi_ = *(const LAS v4i_t*)(lds + PG8_SA(b, h) + aoff + m * 2048 + 1024); dst[m] = __builtin_shufflevector(lo_, hi_, 0, 1, 2, 3, 4, 5, 6, 7); } } while (0)
#define PG8_LDB(dst, b, h) do { _Pragma("unroll") for (int n = 0; n < 2; ++n) { const v4i_t lo_ = *(const LAS v4i_t*)(lds + PG8_SB(b, h) + boff + n * 2048), hi_ = *(const LAS v4i_t*)(lds + PG8_SB(b, h) + boff + n * 2048 + 1024); dst[n] = __builtin_shufflevector(lo_, hi_, 0, 1, 2, 3, 4, 5, 6, 7); } } while (0)
#define PG8_LO(x) __builtin_bit_cast(bf16x8, __builtin_shufflevector(x, x, 0, 1, 2, 3))
#define PG8_HI(x) __builtin_bit_cast(bf16x8, __builtin_shufflevector(x, x, 4, 5, 6, 7))
#define PG8_MMA(ai, bj, At, Bt) do { __builtin_amdgcn_s_setprio(1); \
        if constexpr (PRB == 2) {} else if constexpr (FP8) { _Pragma("unroll") for (int m = 0; m < 4; ++m) _Pragma("unroll") for (int n = 0; n < 2; ++n) \
            asm volatile("v_mfma_f32_16x16x128_f8f6f4 %0, %1, %2, %0" : "+v"(acc[ai][bj][m][n]) : "v"(Bt[n]), "v"(At[m])); \
            } \
        else { _Pragma("unroll") for (int m = 0; m < 4; ++m) _Pragma("unroll") for (int n = 0; n < 2; ++n) { \
            acc[ai][bj][m][n] = __builtin_amdgcn_mfma_f32_16x16x32_bf16(PG8_LO(Bt[n]), PG8_LO(At[m]), acc[ai][bj][m][n], 0, 0, 0); \
            acc[ai][bj][m][n] = __builtin_amdgcn_mfma_f32_16x16x32_bf16(PG8_HI(Bt[n]), PG8_HI(At[m]), acc[ai][bj][m][n], 0, 0, 0); } } \
        __builtin_amdgcn_s_setprio(0); } while (0)
#define PG8_WAIT_V(n) asm volatile("s_waitcnt vmcnt(" #n ")" ::: "memory")
#define PG8_WAIT_L(n) asm volatile("s_waitcnt lgkmcnt(" #n ")" ::: "memory")
#define PG8_BAR __builtin_amdgcn_s_barrier()
#define PG8_SCHED __builtin_amdgcn_sched_barrier(0)
    Unit cur, nxt; int ui = 0;
    if (!S.next(0, cur)) return;
    if constexpr (Epi::AUXT) E.prefetch(cur, lds + AUX_OFF, wid, lane);
    f32x4 acc[2][2][4][2];
#pragma unroll
    for (int a = 0; a < 2; ++a)
#pragma unroll
        for (int b = 0; b < 2; ++b)
#pragma unroll
            for (int m = 0; m < 4; ++m)
#pragma unroll
                for (int n = 0; n < 2; ++n) acc[a][b][m][n] = (f32x4){0.f, 0.f, 0.f, 0.f};
    v8i_t At[4], B0[2], B1[2];
    const char* cA = cur.A; const char* cB = cur.B;
    PG8_STAGE(PG8_SB(0, 0), cB, voffB); PG8_STAGE(PG8_SA(0, 0), cA, voffA); PG8_STAGE(PG8_SB(0, 1), cB + hstepB, voffB); PG8_STAGE(PG8_SA(0, 1), cA + hstepA, voffA);
    if (wr == 1) PG8_BAR;
    PG8_WAIT_V(4); PG8_BAR;
    PG8_STAGE(PG8_SB(1, 0), cB + kstep, voffB); PG8_STAGE(PG8_SA(1, 0), cA + kstep, voffA); PG8_STAGE(PG8_SB(1, 1), cB + hstepB + kstep, voffB);
    PG8_WAIT_V(6); PG8_BAR;
    for (;;) {
        const bool has_next = S.next(ui + 1, nxt);
        const char* nA = has_next ? nxt.A : cA; const char* nB = has_next ? nxt.B : cB;
        const int nt = cur.nt;
        for (int t = 0; t < nt; t += 2) {
            const bool last = (t == nt - 2);
            if constexpr (Epi::AUXT) { if (last && has_next) E.prefetch(nxt, lds + AUX_OFF + ((ui + 1) & 1) * 2048, wid, lane); }
            const char* a1 = cA + (size_t)(t + 1) * kstep;
            const char* a2 = last ? nA : cA + (size_t)(t + 2) * kstep; const char* b2 = last ? nB : cB + (size_t)(t + 2) * kstep;
            const char* a3 = a2 + kstep; const char* b3 = b2 + kstep;
            PG8_LDB(B0, 0, 0); PG8_SCHED; PG8_LDA(At, 0, 0); PG8_STAGE(PG8_SA(1, 1), a1 + hstepA, voffA);
            PG8_WAIT_L(8); PG8_BAR; PG8_WAIT_L(0); PG8_MMA(0, 0, At, B0); PG8_BAR; PG8_SCHED;
            PG8_LDB(B1, 0, 1); PG8_STAGE(PG8_SB(0, 0), b2, voffB);
            PG8_BAR; PG8_WAIT_L(0); PG8_MMA(0, 1, At, B1); PG8_BAR;
            PG8_LDA(At, 0, 1); PG8_STAGE(PG8_SA(0, 0), a2, voffA);
            PG8_BAR; PG8_WAIT_L(0); PG8_MMA(1, 0, At, B0); PG8_BAR; PG8_SCHED;
            PG8_STAGE(PG8_SB(0, 1), b2 + hstepB, voffB);
            PG8_WAIT_V(6); PG8_BAR; PG8_MMA(1, 1, At, B1); PG8_BAR;
            PG8_LDB(B0, 1, 0); PG8_SCHED; PG8_LDA(At, 1, 0); PG8_STAGE(PG8_SA(0, 1), a2 + hstepA, voffA);
            PG8_WAIT_L(8); PG8_BAR; PG8_WAIT_L(0); PG8_MMA(0, 0, At, B0); PG8_BAR; PG8_SCHED;
            PG8_LDB(B1, 1, 1); PG8_STAGE(PG8_SB(1, 0), b3, voffB);
            PG8_BAR; PG8_WAIT_L(0); PG8_MMA(0, 1, At, B1); PG8_BAR;
            PG8_LDA(At, 1, 1); PG8_STAGE(PG8_SA(1, 0), a3, voffA);
            PG8_BAR; PG8_WAIT_L(0); PG8_MMA(1, 0, At, B0); PG8_BAR; PG8_SCHED;
            PG8_STAGE(PG8_SB(1, 1), b3 + hstepB, voffB);
            PG8_WAIT_V(6); PG8_BAR; PG8_MMA(1, 1, At, B1); PG8_BAR;
        }
        if constexpr (FP8) asm volatile("s_nop 15\n\ts_nop 15" ::: "memory");
        if constexpr (PRB == 0) { if constexpr (Epi::AUXT) E(acc, cur, wr, wc, fr, fq, lds + AUX_OFF + (ui & 1) * 2048); else E(acc, cur, wr, wc, fr, fq); }
        if (!has_next) break;
#pragma unroll
        for (int a = 0; a < 2; ++a)
#pragma unroll
            for (int b = 0; b < 2; ++b)
#pragma unroll
                for (int m = 0; m < 4; ++m)
#pragma unroll
                    for (int n = 0; n < 2; ++n) acc[a][b][m][n] = (f32x4){0.f, 0.f, 0.f, 0.f};
        cur = nxt; cA = nA; cB = nB; ++ui;
    }
    PG8_WAIT_V(0);
    if (wr == 0) PG8_BAR;
    PG8_BAR;
#undef PG8_SA
#undef PG8_SB
#undef PG8_STAGE
#undef PG8_LDA
#undef PG8_LDB
#undef PG8_LO
#undef PG8_HI
#undef PG8_MMA
#undef PG8_WAIT_V
#undef PG8_WAIT_L
#undef PG8_BAR
#undef PG8_SCHED
}
}
using pg8::Unit;

struct SchedDense {
    const char* A; const char* B; unsigned lda, ldb; int nM, nN, nt, G, c;
    __device__ __forceinline__ bool next(int i, Unit& u) const {
        const long L = (long)i * G + c; if (L >= (long)nM * nN) return false;
        int pm, pn; pg8::dense_map((int)L, nM, nN, pm, pn);
        u.A = A + (size_t)pm * 256 * lda; u.B = B + (size_t)pn * 256 * ldb; u.nt = nt; u.pm = pm; u.pn = pn; u.aux = 0; return true;
    }
};
struct SchedP3 {
    const char* AG; const char* WG; const char* Z2; const char* WUQ; const char* WUKV; int G, c;
    __device__ __forceinline__ bool next(int i, Unit& u) const {
        int kind, L;
        if (G == 256) {
            if (c < 128) { if (i == 0) { kind = 2; L = c; } else if (i <= 3) { kind = 0; L = (i - 1) * 256 + c; } else if (i == 4) { kind = 0; L = 2 * 256 + c + 128; } else if (i == 5) { kind = 1; L = 3 * 256 + c; } else return false; }
            else { if (i <= 1) { kind = 0; L = i * 256 + c; } else if (i <= 5) { kind = 1; L = (i - 2) * 256 + c; } else if (i <= 8) { kind = 1; L = (i - 6) * 256 + (c - 128); } else return false; }
        } else { const int Lg = i * G + c; if (Lg < 128) { kind = 2; L = Lg; } else if (Lg < 896) { kind = 0; L = Lg - 128; } else if (Lg < 1920) { kind = 1; L = Lg - 896; } else return false; }
        if (kind == 2) { const int g = L >> 1, pmm = L & 1; u.A = AG + ((size_t)(g * NCH + pmm * 256) * AGW + 128) * 2; u.B = WG + (size_t)g * 256 * 1024 * 2; u.nt = 16; u.pm = g * 2 + pmm; u.pn = 0; u.aux = 2; return true; }
        if (kind == 0) { int pm, pn; pg8::dense_map(L, 128, 6, pm, pn); u.A = Z2 + (size_t)pm * 256 * (AGW * 2); u.B = WUQ + (size_t)pn * 256 * 2048; u.nt = 8; u.pm = pm; u.pn = pn; u.aux = 0; return true; }
        { int pm, pn; pg8::dense_map(L, 128, 8, pm, pn); u.A = Z2 + (size_t)pm * 256 * (AGW * 2) + 1024; u.B = WUKV + (size_t)pn * 256 * 2048; u.nt = 4; u.pm = pm; u.pn = pn; u.aux = 1; return true; }
    }
};
struct SchedSsm {
    const char* AG; const char* BTG; int G, c;
    __device__ __forceinline__ bool next(int i, Unit& u) const {
        int pn, gp;
        if (G == 256) { if (i > 1) return false; pn = (i == 0) ? ((c < 128) ? 3 : 2) : ((c < 128) ? 0 : 1); gp = c & 127; }
        else { const int L = i * G + c; if (L >= 512) return false; pn = 3 - (L >> 7); gp = L & 127; }
        const int g = gp >> 1, pmm = gp & 1;
        u.A = AG + (size_t)(g * NCH + pmm * 256) * AGW * 2; u.B = BTG + ((size_t)g * 1024 + pn * 256) * AGW * 2; u.nt = 2 + 4 * (pn + 1); u.pm = pmm; u.pn = pn; u.aux = g; return true;
    }
};
struct SchedMoe {
    const char* A; const char* W; const volatile LAS int* tab; int NPN, G, c; size_t wstride; unsigned rowb; int nt;
    __device__ __forceinline__ bool next(int i, Unit& u) const {
        const int total = __builtin_amdgcn_readfirstlane(tab[64]);
        int grb, pn;
        if ((G & 255) == 0) {
            const int L = i * G + c, x = L & 7, j = (L >> 3) & 31, R = (L >> 8) * 8 + x;
            const int s = (NPN == 16) ? (R >> 1) : R;
            grb = 4 * s + (j & 3); pn = ((NPN == 16) ? 8 * (R & 1) : 0) + (j >> 2);
            if (4 * s >= total) return false;
            if (grb >= total) { grb = total - 1; u.aux = -1; }
        } else { const int L = i * G + c; if (L >= total * NPN) return false; grb = L / NPN; pn = L % NPN; }
        const int e = __builtin_amdgcn_readfirstlane(tab[128 + grb]);
        u.A = A + (size_t)grb * 256 * rowb; u.B = W + (size_t)e * wstride + (size_t)pn * 256 * rowb; u.nt = nt; u.pm = grb; u.pn = pn; u.aux = e; return true;
    }
};

struct EpiZ {
    static constexpr bool PERM = true; static constexpr bool AUXT = false;
    bf16_t* AG; bf16_t* GS; bf16_t* Z2;
    __device__ __forceinline__ void operator()(const f32x4 (&acc)[2][2][4][2], const Unit& u, int wr, int wc, int fr, int fq) const {
        const int row0 = u.pm * 256 + wr * 64 + fr, colt = u.pn * 256 + wc * 32 + 8 * fq;
#pragma unroll
        for (int ai = 0; ai < 2; ++ai)
#pragma unroll
            for (int m = 0; m < 4; ++m) { const int row = row0 + ai * 128 + m * 16; const int chunk = row >> 6, j = row & 63;
#pragma unroll
                for (int bj = 0; bj < 2; ++bj) { const int col = colt + bj * 128; const f32x4 v0 = acc[ai][bj][m][0], v1 = acc[ai][bj][m][1];
                    u32x4 w; w.x = cvt_pk_bf16(v0[0], v0[1]); w.y = cvt_pk_bf16(v0[2], v0[3]); w.z = cvt_pk_bf16(v1[0], v1[1]); w.w = cvt_pk_bf16(v1[2], v1[3]);
                    bf16_t* dst;
                    if (u.pn < 4) { const int g = col >> 4, h0 = col & 15; dst = AG + ((size_t)(g * NCH + chunk) * AGW + 128 + j * 16 + h0); }
                    else if (u.pn < 8) { const int ch = col - 1024, g = ch >> 4, h0 = ch & 15; dst = GS + ((size_t)(g * NCH + chunk) * 1024 + j * 16 + h0); }
                    else dst = Z2 + (size_t)row * AGW + (col - 2048);
                    *(u32x4*)dst = w; } }
    }
};
struct EpiP3 {
    static constexpr bool PERM = true; static constexpr bool AUXT = false;
    bf16_t* QRAW; bf16_t* KVRAW; float* SEND;
    __device__ __forceinline__ void operator()(const f32x4 (&acc)[2][2][4][2], const Unit& u, int wr, int wc, int fr, int fq) const {
        if (u.aux == 2) {
            const int row0 = u.pm * 256 + wr * 64 + fr, col0 = wc * 32 + 8 * fq;
#pragma unroll
            for (int ai = 0; ai < 2; ++ai)
#pragma unroll
                for (int m = 0; m < 4; ++m) { float* rowp = SEND + (size_t)(row0 + ai * 128 + m * 16) * 128 + col0;
                    *(f32x4*)rowp = acc[ai][0][m][0]; *(f32x4*)(rowp + 4) = acc[ai][0][m][1]; }
        } else {
            bf16_t* O = (u.aux == 0) ? QRAW : KVRAW; const int ldc = (u.aux == 0) ? 1536 : 2048;
            const int row0 = u.pm * 256 + wr * 64 + fr, col0 = u.pn * 256 + wc * 32 + 8 * fq;
#pragma unroll
            for (int ai = 0; ai < 2; ++ai)
#pragma unroll
                for (int m = 0; m < 4; ++m) { bf16_t* rowp = O + (size_t)(row0 + ai * 128 + m * 16) * ldc + col0;
#pragma unroll
                    for (int bj = 0; bj < 2; ++bj) { const f32x4 v0 = acc[ai][bj][m][0], v1 = acc[ai][bj][m][1];
                        u32x4 w; w.x = cvt_pk_bf16(v0[0], v0[1]); w.y = cvt_pk_bf16(v0[2], v0[3]); w.z = cvt_pk_bf16(v1[0], v1[1]); w.w = cvt_pk_bf16(v1[2], v1[3]);
                        *(u32x4*)(rowp + bj * 128) = w; } }
        }
    }
};
__device__ __forceinline__ float gelu_tanh(float x) { const float u = 0.7978845608028654f * (x + 0.044715f * x * x * x); return x * sigmoidf_(2.0f * u); }
struct EpiSsm {
    static constexpr bool PERM = true; static constexpr bool AUXT = false;
    const bf16_t* GS; bf16_t* YS;
    __device__ __forceinline__ void operator()(const f32x4 (&acc)[2][2][4][2], const Unit& u, int wr, int wc, int fr, int fq) const {
        const int g = u.aux, row0 = u.pm * 256 + wr * 64 + fr, colt = u.pn * 256 + wc * 32 + 8 * fq;
#pragma unroll
        for (int ai = 0; ai < 2; ++ai)
#pragma unroll
            for (int m = 0; m < 4; ++m) { const int chunk = row0 + ai * 128 + m * 16;
#pragma unroll
                for (int bj = 0; bj < 2; ++bj) { const int col = colt + bj * 128, l = col >> 4, h0 = col & 15;
                    const u32x4 gw = *(const u32x4*)(GS + ((size_t)(g * NCH + chunk) * 1024 + col));
                    const f32x4 v0 = acc[ai][bj][m][0], v1 = acc[ai][bj][m][1];
                    float o[8];
                    o[0] = gelu_tanh(v0[0]) * sigmoidf_(bflo(gw.x)); o[1] = gelu_tanh(v0[1]) * sigmoidf_(bfhi(gw.x));
                    o[2] = gelu_tanh(v0[2]) * sigmoidf_(bflo(gw.y)); o[3] = gelu_tanh(v0[3]) * sigmoidf_(bfhi(gw.y));
                    o[4] = gelu_tanh(v1[0]) * sigmoidf_(bflo(gw.z)); o[5] = gelu_tanh(v1[1]) * sigmoidf_(bfhi(gw.z));
                    o[6] = gelu_tanh(v1[2]) * sigmoidf_(bflo(gw.w)); o[7] = gelu_tanh(v1[3]) * sigmoidf_(bfhi(gw.w));
                    u32x4 w; w.x = cvt_pk_bf16(o[0], o[1]); w.y = cvt_pk_bf16(o[2], o[3]); w.z = cvt_pk_bf16(o[4], o[5]); w.w = cvt_pk_bf16(o[6], o[7]);
                    *(u32x4*)(YS + ((size_t)(chunk * 64 + l) * 1024 + g * 16 + h0)) = w; } }
    }
};
#ifndef OUT_FP8
#define OUT_FP8 0
#endif
struct EpiOut {
    static constexpr float OUT_SC = OUT_FP8 ? (1.0f / 64.0f) : 1.0f;
    static constexpr bool PERM = true; static constexpr bool AUXT = false;
    const float* X; bf16_t* X1B; const float* MOD;
    __device__ __forceinline__ void operator()(const f32x4 (&acc)[2][2][4][2], const Unit& u, int wr, int wc, int fr, int fq) const {
        const int row0 = u.pm * 256 + wr * 64 + fr, col0 = u.pn * 256 + wc * 32 + 8 * fq;
        const int b = (u.pm * 256) >> 14;
        f32x4 gv[2][2];
#pragma unroll
        for (int bj = 0; bj < 2; ++bj)
#pragma unroll
            for (int n = 0; n < 2; ++n) gv[bj][n] = *(const f32x4*)(MOD + b * 12288 + 4096 + col0 + bj * 128 + 4 * n);
#pragma unroll
        for (int ai = 0; ai < 2; ++ai)
#pragma unroll
            for (int m = 0; m < 4; ++m) { const size_t off = (size_t)(row0 + ai * 128 + m * 16) * DM + col0;
#pragma unroll
                for (int bj = 0; bj < 2; ++bj) { const f32x4 x0 = *(const f32x4*)(X + off + bj * 128), x1 = *(const f32x4*)(X + off + bj * 128 + 4);
                    const f32x4 v0 = x0 + gv[bj][0] * (acc[ai][bj][m][0] * OUT_SC), v1 = x1 + gv[bj][1] * (acc[ai][bj][m][1] * OUT_SC);
                    u32x4 w; w.x = cvt_pk_bf16(v0[0], v0[1]); w.y = cvt_pk_bf16(v0[2], v0[3]); w.z = cvt_pk_bf16(v1[0], v1[1]); w.w = cvt_pk_bf16(v1[2], v1[3]);
                    *(u32x4*)(X1B + off + bj * 128) = w; } }
    }
};
__device__ __forceinline__ unsigned pk4_fp8(float a, float b, float c, float d) { unsigned w = 0u; w = __builtin_amdgcn_cvt_pk_fp8_f32(a, b, w, false); w = __builtin_amdgcn_cvt_pk_fp8_f32(c, d, w, true); return w; }
constexpr float W8_SCALE = 64.0f, W8_INV = 1.0f / 64.0f;
__device__ __forceinline__ u32x4 pair16(const u32x2& X, const u32x2& Y) {
    const auto r0 = __builtin_amdgcn_permlane16_swap(X.x, Y.x, false, false), r1 = __builtin_amdgcn_permlane16_swap(X.y, Y.y, false, false);
    return (u32x4){r0[0], r1[0], r0[1], r1[1]};
}
struct EpiGu {
    static constexpr bool PERM = true; static constexpr bool AUXT = true;
    const float* BGU; unsigned char* ACT;
    __device__ __forceinline__ void prefetch(const Unit& u, LAS unsigned char* aux, int wid, int lane) const {
        if (wid == 0) __builtin_amdgcn_global_load_lds((const unsigned*)(BGU + (size_t)u.aux * 4096 + u.pn * 256 + lane * 4), (LAS unsigned*)aux, 16, 0, 0);
    }
    __device__ __forceinline__ void operator()(const f32x4 (&acc)[2][2][4][2], const Unit& u, int wr, int wc, int fr, int fq, const LAS unsigned char* aux) const {
        const int row0 = u.pm * 256 + wr * 64 + fr, j0 = u.pn * 128 + wc * 32 + 8 * fq;
        const LAS f32x4* bp = (const LAS f32x4*)(aux + (wc * 32 + 8 * fq) * 8);
        const f32x4 b0 = bp[0], b1 = bp[1], b2 = bp[2], b3 = bp[3];
        const float bg[8] = {b0[0], b0[2], b1[0], b1[2], b2[0], b2[2], b3[0], b3[2]}, bu[8] = {b0[1], b0[3], b1[1], b1[3], b2[1], b2[3], b3[1], b3[3]};
        constexpr float SC = MOE_FP8 ? W8_INV : 1.0f;
        const bool odd = (fq & 1) != 0;
#pragma unroll
        for (int ai = 0; ai < 2; ++ai)
#pragma unroll
            for (int mp = 0; mp < 2; ++mp) { u32x2 wq[2];
#pragma unroll
                for (int mm = 0; mm < 2; ++mm) { const int m = 2 * mp + mm; float o[8];
#pragma unroll
                    for (int n = 0; n < 2; ++n)
#pragma unroll
                        for (int e = 0; e < 4; ++e) { float gt = acc[ai][0][m][n][e] * SC + bg[4 * n + e], up = acc[ai][1][m][n][e] * SC + bu[4 * n + e];
                            gt = fminf(gt, 7.0f); up = fminf(fmaxf(up, -7.0f), 7.0f); o[4 * n + e] = (up + 1.0f) * gt * sigmoidf_(1.702f * gt); }
                    wq[mm].x = pk4_fp8(o[0], o[1], o[2], o[3]); wq[mm].y = pk4_fp8(o[4], o[5], o[6], o[7]); }
                const u32x4 w = pair16(wq[0], wq[1]);
                *(u32x4*)(ACT + (size_t)(row0 + ai * 128 + (2 * mp + (odd ? 1 : 0)) * 16) * 2048 + (odd ? j0 - 8 : j0)) = w; }
    }
};
constexpr float YB_SCALE = 16.0f, YB_INV = 1.0f / 16.0f;
struct EpiDn {
    static constexpr bool PERM = true; static constexpr bool AUXT = true;
    const float* BD; const float* ROWGATE; unsigned char* YB;
    __device__ __forceinline__ void prefetch(const Unit& u, LAS unsigned char* aux, int wid, int lane) const {
        if (wid == 0) __builtin_amdgcn_global_load_lds((const unsigned*)(BD + (size_t)u.aux * 2048 + u.pn * 256 + lane * 4), (LAS unsigned*)aux, 16, 0, 0);
        if (wid == 1) __builtin_amdgcn_global_load_lds((const unsigned*)(ROWGATE + (size_t)u.pm * 256 + lane * 4), (LAS unsigned*)(aux + 1024), 16, 0, 0);
    }
    __device__ __forceinline__ void operator()(const f32x4 (&acc)[2][2][4][2], const Unit& u, int wr, int wc, int fr, int fq, const LAS unsigned char* aux) const {
        const int row0 = u.pm * 256 + wr * 64 + fr, col0 = u.pn * 256 + wc * 32 + 8 * fq;
        f32x4 bv[2][2];
#pragma unroll
        for (int bj = 0; bj < 2; ++bj)
#pragma unroll
            for (int n = 0; n < 2; ++n) bv[bj][n] = *(const LAS f32x4*)(aux + (wc * 32 + 8 * fq + bj * 128 + 4 * n) * 4);
        const LAS float* gp = (const LAS float*)(aux + 1024) + wr * 64 + fr;
        const bool odd = (fq & 1) != 0;
#pragma unroll
        for (int ai = 0; ai < 2; ++ai)
#pragma unroll
            for (int m = 0; m < 4; ++m) { const int row = row0 + ai * 128 + m * 16; const float gt = gp[ai * 128 + m * 16] * YB_SCALE; u32x2 wq[2];
#pragma unroll
                for (int bj = 0; bj < 2; ++bj) { constexpr float SC = MOE_FP8 ? W8_INV : 1.0f; const f32x4 v0 = (acc[ai][bj][m][0] * SC + bv[bj][0]) * gt, v1 = (acc[ai][bj][m][1] * SC + bv[bj][1]) * gt;
                    wq[bj].x = pk4_fp8(v0[0], v0[1], v0[2], v0[3]); wq[bj].y = pk4_fp8(v1[0], v1[1], v1[2], v1[3]); }
                const u32x4 w = pair16(wq[0], wq[1]);
                *(u32x4*)(YB + (size_t)row * 2048 + (odd ? col0 - 8 + 128 : col0)) = w; }
    }
};

namespace att {
constexpr int D = 128, NW = 8, QBLK = 32, KVBLK = 64;
constexpr float SCALE = 0.07216878364870322f;
constexpr float THR = 8.f;
#ifndef ATT_SDEPTH
#define ATT_SDEPTH 2
#endif
constexpr int SDEPTH = ATT_SDEPTH;
constexpr int LDQ = 192, LDK = 128, LDR = 64, LDO = 1024;
constexpr int SHM_V = KVBLK * D * 2, SHM_K = KVBLK * D * 2, SHM_R = KVBLK * 64 * 2;
constexpr int OFF_V = 0, OFF_K = 2 * SHM_V, OFF_R = OFF_K + 2 * SHM_K, OFF_WS = OFF_R + 2 * SHM_R, SHM_ATTN = OFF_WS + NW * 64 * 4;
#define KSWZ(row, colB) ((row) * 256 + ((colB) ^ (((row) & 15) << 4)))
#define RSWZ(row, colB) ((row) * 128 + ((colB) ^ ((((row) >> 1) & 7) << 4)))
#define SBAR() __builtin_amdgcn_sched_barrier(0)
__device__ __forceinline__ int crow(int r, int hi) { return (r & 3) + 8 * (r >> 2) + 4 * hi; }

__device__ __forceinline__ void partialSM(f32x16& p0, f32x16& p1, float& m_reg, float& mn, float& alpha) {
  constexpr float C = SCALE * 1.4426950408889634f;
  float pmax = p0[0];
#pragma unroll
  for (int r = 1; r < 16; ++r) pmax = fmaxf(pmax, p0[r]);
#pragma unroll
  for (int r = 0; r < 16; ++r) pmax = fmaxf(pmax, p1[r]);
  { auto rr = __builtin_amdgcn_permlane32_swap(__float_as_uint(pmax), __float_as_uint(pmax), false, false);
    pmax = fmaxf(__uint_as_float(rr[0]), __uint_as_float(rr[1])); }
  if (__builtin_expect(__all(pmax - m_reg <= THR / SCALE), 1)) { mn = m_reg; alpha = 1.f; }
  else { mn = fmaxf(m_reg, pmax); alpha = __builtin_amdgcn_exp2f((m_reg - mn) * C); m_reg = mn; }
  float mnC = -mn * C;
#pragma unroll
  for (int r = 0; r < 16; ++r) p0[r] = fmaf(p0[r], C, mnC);
#pragma unroll
  for (int r = 0; r < 16; ++r) p1[r] = fmaf(p1[r], C, mnC);
#pragma unroll
  for (int r = 0; r < 16; ++r) p0[r] = __builtin_amdgcn_exp2f(p0[r]);
}
__device__ __forceinline__ void finishSM(f32x16& p0, f32x16& p1, float alpha, float& l_reg, bf16x8& pa0, bf16x8& pa1, bf16x8& pa2, bf16x8& pa3) {
#pragma unroll
  for (int r = 0; r < 16; ++r) p1[r] = __builtin_amdgcn_exp2f(p1[r]);
  float ps = 0;
#pragma unroll
  for (int r = 0; r < 16; ++r) ps += p0[r];
#pragma unroll
  for (int r = 0; r < 16; ++r) ps += p1[r];
  { auto rr = __builtin_amdgcn_permlane32_swap(__float_as_uint(ps), __float_as_uint(ps), false, false);
    ps = __uint_as_float(rr[0]) + __uint_as_float(rr[1]); }
  l_reg = l_reg * alpha + ps;
#define PK4(P, BASE, OUT) do { unsigned a0 = cvt_pk_bf16(P[BASE + 0], P[BASE + 1]), a1 = cvt_pk_bf16(P[BASE + 2], P[BASE + 3]);   \
    unsigned b0 = cvt_pk_bf16(P[BASE + 4], P[BASE + 5]), b1 = cvt_pk_bf16(P[BASE + 6], P[BASE + 7]);                              \
    auto r0 = __builtin_amdgcn_permlane32_swap(a0, b0, false, false); auto r1 = __builtin_amdgcn_permlane32_swap(a1, b1, false, false); \
    u32x4 w = {r0[0], r1[0], r0[1], r1[1]}; OUT = *reinterpret_cast<bf16x8*>(&w); } while (0)
  PK4(p0, 0, pa0); PK4(p0, 8, pa1); PK4(p1, 0, pa2); PK4(p1, 8, pa3);
#undef PK4
}
__device__ __forceinline__ void softmax_nomax(f32x16& p0, f32x16& p1, float& l_reg, bf16x8& pa0, bf16x8& pa1, bf16x8& pa2, bf16x8& pa3) {
#pragma unroll
  for (int r = 0; r < 16; ++r) p0[r] = __builtin_amdgcn_exp2f(p0[r]);
#pragma unroll
  for (int r = 0; r < 16; ++r) p1[r] = __builtin_amdgcn_exp2f(p1[r]);
  float ps = 0;
#pragma unroll
  for (int r = 0; r < 16; ++r) ps += p0[r];
#pragma unroll
  for (int r = 0; r < 16; ++r) ps += p1[r];
  l_reg += ps;
#define PK4(P, BASE, OUT) do { unsigned a0 = cvt_pk_bf16(P[BASE + 0], P[BASE + 1]), a1 = cvt_pk_bf16(P[BASE + 2], P[BASE + 3]);   \
    unsigned b0 = cvt_pk_bf16(P[BASE + 4], P[BASE + 5]), b1 = cvt_pk_bf16(P[BASE + 6], P[BASE + 7]);                              \
    auto r0 = __builtin_amdgcn_permlane32_swap(a0, b0, false, false); auto r1 = __builtin_amdgcn_permlane32_swap(a1, b1, false, false); \
    u32x4 w = {r0[0], r1[0], r0[1], r1[1]}; OUT = *reinterpret_cast<bf16x8*>(&w); } while (0)
  PK4(p0, 0, pa0); PK4(p0, 8, pa1); PK4(p1, 0, pa2); PK4(p1, 8, pa3);
#undef PK4
}
__device__ __forceinline__ void qkt(f32x16& p0, f32x16& p1, const char* Ks, const char* Rs, const bf16x8* qr, int r32, int hi, bool masked) {
  p0 = f32x16{}; p1 = f32x16{};
#pragma unroll
  for (int d0 = 0; d0 < 8; ++d0) { int cb = (d0 * 16 + hi * 8) * 2;
    bf16x8 b0 = *reinterpret_cast<const bf16x8*>(Ks + KSWZ(r32, cb));
    bf16x8 b1 = *reinterpret_cast<const bf16x8*>(Ks + KSWZ(32 + r32, cb));
    p0 = __builtin_amdgcn_mfma_f32_32x32x16_bf16(b0, qr[d0], p0, 0, 0, 0);
    p1 = __builtin_amdgcn_mfma_f32_32x32x16_bf16(b1, qr[d0], p1, 0, 0, 0); }
#pragma unroll
  for (int d0 = 0; d0 < 4; ++d0) { int cb = (d0 * 16 + hi * 8) * 2;
    bf16x8 b0 = *reinterpret_cast<const bf16x8*>(Rs + RSWZ(r32, cb));
    bf16x8 b1 = *reinterpret_cast<const bf16x8*>(Rs + RSWZ(32 + r32, cb));
    p0 = __builtin_amdgcn_mfma_f32_32x32x16_bf16(b0, qr[8 + d0], p0, 0, 0, 0);
    p1 = __builtin_amdgcn_mfma_f32_32x32x16_bf16(b1, qr[8 + d0], p1, 0, 0, 0); }
  (void)masked;
}
__device__ __forceinline__ int v_st(int k, int c) { const int kk = (k & ~0xC) | ((k & 4) << 1) | ((k & 8) >> 1); return ((kk >> 3) * 4 + (c >> 5)) * 512 + ((kk & 7) * 32 + (c & 31)) * 2; }
__device__ __forceinline__ int v_rd_base(int lane) { return ((lane & 3) << 3) | (((lane >> 2) & 3) << 6) | (((lane >> 4) & 1) << 5) | (((lane >> 5) & 1) << 8); }
constexpr int v_rd_off(int d0, int ks, int half) { return d0 * 512 + ks * 4096 + half * 2048; }
template <int OFF> __device__ __forceinline__ s16x4 tr_read(int vb) {
  s16x4 r; asm volatile("ds_read_b64_tr_b16 %0, %1 offset:%2" : "=&v"(r) : "v"(vb), "i"(OFF) : "memory"); return r;
}
template <int D0> __device__ __forceinline__ void pv_one(f32x16& od, int vb, bf16x8 pa0, bf16x8 pa1, bf16x8 pa2, bf16x8 pa3) {
  const s16x4 l0 = tr_read<v_rd_off(D0, 0, 0)>(vb), h0 = tr_read<v_rd_off(D0, 0, 1)>(vb), l1 = tr_read<v_rd_off(D0, 1, 0)>(vb), h1 = tr_read<v_rd_off(D0, 1, 1)>(vb);
  const s16x4 l2 = tr_read<v_rd_off(D0, 2, 0)>(vb), h2 = tr_read<v_rd_off(D0, 2, 1)>(vb), l3 = tr_read<v_rd_off(D0, 3, 0)>(vb), h3 = tr_read<v_rd_off(D0, 3, 1)>(vb);
  asm volatile("s_waitcnt lgkmcnt(0)" ::: "memory"); SBAR();
#define PK(L, H) (bf16x8){L[0], L[1], L[2], L[3], H[0], H[1], H[2], H[3]}
  od = __builtin_amdgcn_mfma_f32_32x32x16_bf16(pa0, PK(l0, h0), od, 0, 0, 0);
  od = __builtin_amdgcn_mfma_f32_32x32x16_bf16(pa1, PK(l1, h1), od, 0, 0, 0);
  od = __builtin_amdgcn_mfma_f32_32x32x16_bf16(pa2, PK(l2, h2), od, 0, 0, 0);
  od = __builtin_amdgcn_mfma_f32_32x32x16_bf16(pa3, PK(l3, h3), od, 0, 0, 0);
#undef PK
}
__device__ __forceinline__ void pv_d0(f32x16* o, int vb, bf16x8 pa0, bf16x8 pa1, bf16x8 pa2, bf16x8 pa3) {
  pv_one<0>(o[0], vb, pa0, pa1, pa2, pa3); pv_one<1>(o[1], vb, pa0, pa1, pa2, pa3); pv_one<2>(o[2], vb, pa0, pa1, pa2, pa3); pv_one<3>(o[3], vb, pa0, pa1, pa2, pa3);
}

#define PK(L, H) (bf16x8){L[0], L[1], L[2], L[3], H[0], H[1], H[2], H[3]}
#define PV_READ(D0, S) const s16x4 l0##S = tr_read<v_rd_off(D0, 0, 0)>(vb), h0##S = tr_read<v_rd_off(D0, 0, 1)>(vb), l1##S = tr_read<v_rd_off(D0, 1, 0)>(vb), h1##S = tr_read<v_rd_off(D0, 1, 1)>(vb), \
    l2##S = tr_read<v_rd_off(D0, 2, 0)>(vb), h2##S = tr_read<v_rd_off(D0, 2, 1)>(vb), l3##S = tr_read<v_rd_off(D0, 3, 0)>(vb), h3##S = tr_read<v_rd_off(D0, 3, 1)>(vb)
#define PV_MMA(D0, S) do { o[D0] = __builtin_amdgcn_mfma_f32_32x32x16_bf16(pa0, PK(l0##S, h0##S), o[D0], 0, 0, 0); o[D0] = __builtin_amdgcn_mfma_f32_32x32x16_bf16(pa1, PK(l1##S, h1##S), o[D0], 0, 0, 0); \
    o[D0] = __builtin_amdgcn_mfma_f32_32x32x16_bf16(pa2, PK(l2##S, h2##S), o[D0], 0, 0, 0); o[D0] = __builtin_amdgcn_mfma_f32_32x32x16_bf16(pa3, PK(l3##S, h3##S), o[D0], 0, 0, 0); } while (0)
__device__ __forceinline__ void pv_pipe(f32x16* o, int vb, bf16x8 pa0, bf16x8 pa1, bf16x8 pa2, bf16x8 pa3) {
  PV_READ(0, a); PV_READ(1, b);
  asm volatile("s_waitcnt lgkmcnt(8)" ::: "memory"); SBAR(); PV_MMA(0, a); SBAR();
  PV_READ(2, c);
  asm volatile("s_waitcnt lgkmcnt(8)" ::: "memory"); SBAR(); PV_MMA(1, b); SBAR();
  PV_READ(3, d);
  asm volatile("s_waitcnt lgkmcnt(8)" ::: "memory"); SBAR(); PV_MMA(2, c); SBAR();
  asm volatile("s_waitcnt lgkmcnt(0)" ::: "memory"); SBAR(); PV_MMA(3, d);
}
#undef PV_READ
#undef PV_MMA
#undef PK

constexpr int STG = SHM_V + SHM_K + SHM_R;
constexpr int OFF_WS3 = 3 * STG;
__device__ __forceinline__ void attn_block(const bf16_t* __restrict__ Qb, const bf16_t* __restrict__ Kh, const bf16_t* __restrict__ Vh, const bf16_t* __restrict__ Rh,
                                           float* __restrict__ Ob, int qb, char* lds) {
  const int tid = threadIdx.x, wid = __builtin_amdgcn_readfirstlane(tid >> 6), lane = tid & 63, r32 = lane & 31, hi = lane >> 5;
  float* ws = (float*)(lds + OFF_WS3) + wid * 64; float* li_l = ws; float* al_l = ws + 32;
  float l_reg = 0; f32x16 o[4] = {}; bf16x8 qr[12];
  const bf16_t* Qw = Qb + (long)(wid * QBLK + r32) * LDQ + hi * 8;
#pragma unroll
  for (int d0 = 0; d0 < 12; ++d0) qr[d0] = *reinterpret_cast<const bf16x8*>(Qw + d0 * 16);
  unsigned kof[2], vof[2], rof;
#pragma unroll
  for (int u = 0; u < 2; ++u) { const int c = 2 * wid + u;
    { const int row = 4 * c + (lane >> 4), slot = lane & 15; kof[u] = (unsigned)(row * 256 + ((slot ^ (row & 15)) << 4)); }
    { const int sub = 2 * c + (lane >> 5), i5 = lane & 31, kk = (sub >> 2) * 8 + (i5 >> 2), col = (sub & 3) * 32 + (i5 & 3) * 8, k = (kk & ~0xC) | ((kk & 4) << 1) | ((kk & 8) >> 1); vof[u] = (unsigned)(k * 256 + col * 2); } }
  { const int row = 8 * wid + (lane >> 3), slot = lane & 7; rof = (unsigned)(row * 128 + ((slot ^ ((row >> 1) & 7)) << 4)); }
  const int wchunk = wid >> 1, t0 = 4 * qb, NT = 4 * qb + 4;
  const LAS unsigned char* ldsb = (const LAS unsigned char*)lds;
#define DMA(tile, st) do { const char* kp = (const char*)Kh + (size_t)(tile) * (KVBLK * 256); const char* vp = (const char*)Vh + (size_t)(tile) * (KVBLK * 256); const char* rp = (const char*)Rh + (size_t)(tile) * (KVBLK * 128); \
    LAS unsigned char* sb = (LAS unsigned char*)ldsb + (st) * STG; \
    __builtin_amdgcn_global_load_lds((const unsigned*)(vp + vof[0]), (LAS unsigned*)(sb + (2 * wid) * 1024), 16, 0, 0); __builtin_amdgcn_global_load_lds((const unsigned*)(vp + vof[1]), (LAS unsigned*)(sb + (2 * wid + 1) * 1024), 16, 0, 0); \
    __builtin_amdgcn_global_load_lds((const unsigned*)(kp + kof[0]), (LAS unsigned*)(sb + SHM_V + (2 * wid) * 1024), 16, 0, 0); __builtin_amdgcn_global_load_lds((const unsigned*)(kp + kof[1]), (LAS unsigned*)(sb + SHM_V + (2 * wid + 1) * 1024), 16, 0, 0); \
    __builtin_amdgcn_global_load_lds((const unsigned*)(rp + rof), (LAS unsigned*)(sb + SHM_V + SHM_K + wid * 1024), 16, 0, 0); } while (0)
#define RESC(a) do { if (__any((a) < 1.f)) { if (hi == 0) al_l[r32] = (a); asm volatile("s_waitcnt lgkmcnt(0)" ::: "memory"); \
    _Pragma("unroll") for (int d = 0; d < 4; ++d) _Pragma("unroll") for (int r = 0; r < 16; ++r) o[d][r] *= al_l[crow(r, hi)]; } } while (0)
#define MASKED(j) (((j) - t0) > wchunk)
  f32x16 p0, p1; bf16x8 pa0, pa1, pa2, pa3;
  DMA(0, 0); DMA(1, 1);
  asm volatile("s_waitcnt vmcnt(5)" ::: "memory"); __builtin_amdgcn_s_barrier(); asm volatile("" ::: "memory");
  int st = 0;
#pragma unroll 1
  for (int j = 0; j < NT; ++j) {
    const bool more = (j + 2 < NT);
    if (more) { const int st2 = (st >= 1) ? st - 1 : 2; DMA(j + 2, st2); }
    char* sb = lds + st * STG;
    if (!MASKED(j)) {
      SBAR(); qkt(p0, p1, sb + SHM_V, sb + SHM_V + SHM_K, qr, r32, hi, false);
      softmax_nomax(p0, p1, l_reg, pa0, pa1, pa2, pa3); SBAR();
      pv_pipe(o, (int)(uintptr_t)sb + v_rd_base(lane), pa0, pa1, pa2, pa3);
    }
    if (more) asm volatile("s_waitcnt vmcnt(5)" ::: "memory"); else asm volatile("s_waitcnt vmcnt(0)" ::: "memory");
    __builtin_amdgcn_s_barrier(); asm volatile("" ::: "memory");
    st = (st == 2) ? 0 : st + 1;
  }
  { auto rr = __builtin_amdgcn_permlane32_swap(__float_as_uint(l_reg), __float_as_uint(l_reg), false, false); l_reg = __uint_as_float(rr[0]) + __uint_as_float(rr[1]); }
  if (hi == 0) li_l[r32] = l_reg; asm volatile("s_waitcnt lgkmcnt(0)" ::: "memory");
  float rli[16];
#pragma unroll
  for (int r = 0; r < 16; ++r) rli[r] = __builtin_amdgcn_rcpf(li_l[crow(r, hi)]);
  float* Ow = Ob + (long)(wid * QBLK) * LDO;
#pragma unroll
  for (int r = 0; r < 16; ++r) { int orow = crow(r, hi);
#pragma unroll
    for (int d0 = 0; d0 < 4; ++d0) Ow[(long)orow * LDO + d0 * 32 + r32] = o[d0][r] * rli[r]; }
#undef DMA
#undef RESC
#undef MASKED
}

constexpr int S8_V = 16384, S8_K = 8192, S8_R = 4096, STG8 = S8_V + S8_K + S8_R, OFF_WS8 = 3 * STG8;
#define KS8(row, b) ((row) * 128 + ((b) ^ ((((row) >> 1) & 7) << 4)))
#define RS8(row, b) ((row) * 64 + ((b) ^ ((((row) >> 2) & 3) << 4)))
typedef int v8i_a __attribute__((ext_vector_type(8)));
typedef int v4i_a __attribute__((ext_vector_type(4)));
__device__ __forceinline__ v8i_a ld32(const char* p0, const char* p1) { const v4i_a a = *reinterpret_cast<const v4i_a*>(p0), b = *reinterpret_cast<const v4i_a*>(p1); return __builtin_shufflevector(a, b, 0, 1, 2, 3, 4, 5, 6, 7); }
__device__ __forceinline__ void qkt8(f32x16& p0, f32x16& p1, const char* Ks, const char* Rs, const v8i_a* qf, int r32, int hi, float init = 0.f) {
#pragma unroll
  for (int r = 0; r < 16; ++r) { p0[r] = init; p1[r] = init; }
#pragma unroll
  for (int s = 0; s < 2; ++s) { const int b0 = 64 * s + 32 * hi;
    const v8i_a a0 = ld32(Ks + KS8(r32, b0), Ks + KS8(r32, b0 + 16)), a1 = ld32(Ks + KS8(32 + r32, b0), Ks + KS8(32 + r32, b0 + 16));
    p0 = __builtin_amdgcn_mfma_scale_f32_32x32x64_f8f6f4(a0, qf[s], p0, 0, 0, 0, 0, 0, 0);
    p1 = __builtin_amdgcn_mfma_scale_f32_32x32x64_f8f6f4(a1, qf[s], p1, 0, 0, 0, 0, 0, 0); }
  { const int b0 = 32 * hi;
    const v8i_a a0 = ld32(Rs + RS8(r32, b0), Rs + RS8(r32, b0 + 16)), a1 = ld32(Rs + RS8(32 + r32, b0), Rs + RS8(32 + r32, b0 + 16));
    p0 = __builtin_amdgcn_mfma_scale_f32_32x32x64_f8f6f4(a0, qf[2], p0, 0, 0, 0, 0, 0, 0);
    p1 = __builtin_amdgcn_mfma_scale_f32_32x32x64_f8f6f4(a1, qf[2], p1, 0, 0, 0, 0, 0, 0); }
}
__device__ __forceinline__ void attn_block8(const unsigned char* __restrict__ Qb, const unsigned char* __restrict__ Kh, const bf16_t* __restrict__ Vh, const unsigned char* __restrict__ Rh,
                                            float* __restrict__ Ob, int qb, char* lds) {
  const int tid = threadIdx.x, wid = __builtin_amdgcn_readfirstlane(tid >> 6), lane = tid & 63, r32 = lane & 31, hi = lane >> 5;
  float* ws = (float*)(lds + OFF_WS8) + wid * 64; float* li_l = ws;
  float l_reg = 0; f32x16 o[4] = {}; v8i_a qf[3];
  { const unsigned char* Qw = Qb + (long)(wid * QBLK + r32) * 192 + 32 * hi;
#pragma unroll
    for (int s = 0; s < 3; ++s) { const v4i_a a = *reinterpret_cast<const v4i_a*>(Qw + 64 * s), b = *reinterpret_cast<const v4i_a*>(Qw + 64 * s + 16); qf[s] = __builtin_shufflevector(a, b, 0, 1, 2, 3, 4, 5, 6, 7); } }
  unsigned vof[2], kof, rof;
#pragma unroll
  for (int u = 0; u < 2; ++u) { const int c = 2 * wid + u;
    const int sub = 2 * c + (lane >> 5), i5 = lane & 31, kk = (sub >> 2) * 8 + (i5 >> 2), col = (sub & 3) * 32 + (i5 & 3) * 8, k = (kk & ~0xC) | ((kk & 4) << 1) | ((kk & 8) >> 1); vof[u] = (unsigned)(k * 256 + col * 2); }
  { const int row = 8 * wid + (lane >> 3), slot = lane & 7; kof = (unsigned)(row * 128 + ((slot ^ ((row >> 1) & 7)) << 4)); }
  { const int row = 16 * (wid & 3) + (lane >> 2), slot = lane & 3; rof = (unsigned)(row * 64 + ((slot ^ ((row >> 2) & 3)) << 4)); }
  const int wchunk = wid >> 1, t0 = 4 * qb, NT = 4 * qb + 4;
  const LAS unsigned char* ldsb = (const LAS unsigned char*)lds;
#define DMA8(tile, st) do { const char* kp = (const char*)Kh + (size_t)(tile) * (KVBLK * 128); const char* vp = (const char*)Vh + (size_t)(tile) * (KVBLK * 256); const char* rp = (const char*)Rh + (size_t)(tile) * (KVBLK * 64); \
    LAS unsigned char* sb_ = (LAS unsigned char*)ldsb + (st) * STG8; \
    __builtin_amdgcn_global_load_lds((const unsigned*)(vp + vof[0]), (LAS unsigned*)(sb_ + (2 * wid) * 1024), 16, 0, 0); __builtin_amdgcn_global_load_lds((const unsigned*)(vp + vof[1]), (LAS unsigned*)(sb_ + (2 * wid + 1) * 1024), 16, 0, 0); \
    __builtin_amdgcn_global_load_lds((const unsigned*)(kp + kof), (LAS unsigned*)(sb_ + S8_V + wid * 1024), 16, 0, 0); \
    __builtin_amdgcn_global_load_lds((const unsigned*)(rp + rof), (LAS unsigned*)(sb_ + S8_V + S8_K + (wid & 3) * 1024), 16, 0, 0); } while (0)
#define MASKED(j) (((j) - t0) > wchunk)
  f32x16 p0, p1; bf16x8 pa0, pa1, pa2, pa3;
  DMA8(0, 0); DMA8(1, 1);
  asm volatile("s_waitcnt vmcnt(4)" ::: "memory"); __builtin_amdgcn_s_barrier(); asm volatile("" ::: "memory");
  int st = 0;
#pragma unroll 1
  for (int j = 0; j < NT; ++j) {
    const bool more = (j + 2 < NT);
    if (more) { const int st2 = (st >= 1) ? st - 1 : 2; DMA8(j + 2, st2); }
    char* sb = lds + st * STG8;
    if (!MASKED(j)) {
      SBAR(); qkt8(p0, p1, sb + S8_V, sb + S8_V + S8_K, qf, r32, hi);
      softmax_nomax(p0, p1, l_reg, pa0, pa1, pa2, pa3); SBAR();
      pv_pipe(o, (int)(uintptr_t)sb + v_rd_base(lane), pa0, pa1, pa2, pa3);
    }
    if (more) asm volatile("s_waitcnt vmcnt(4)" ::: "memory"); else asm volatile("s_waitcnt vmcnt(0)" ::: "memory");
    __builtin_amdgcn_s_barrier(); asm volatile("" ::: "memory");
    st = (st == 2) ? 0 : st + 1;
  }
  { auto rr = __builtin_amdgcn_permlane32_swap(__float_as_uint(l_reg), __float_as_uint(l_reg), false, false); l_reg = __uint_as_float(rr[0]) + __uint_as_float(rr[1]); }
  if (hi == 0) li_l[r32] = l_reg; asm volatile("s_waitcnt lgkmcnt(0)" ::: "memory");
  float rli[16];
#pragma unroll
  for (int r = 0; r < 16; ++r) rli[r] = __builtin_amdgcn_rcpf(li_l[crow(r, hi)]);
  float* Ow = Ob + (long)(wid * QBLK) * LDO;
#pragma unroll
  for (int r = 0; r < 16; ++r) { int orow = crow(r, hi);
#pragma unroll
    for (int d0 = 0; d0 < 4; ++d0) Ow[(long)orow * LDO + d0 * 32 + r32] = o[d0][r] * rli[r]; }
#undef DMA8
#undef MASKED
}

constexpr int T8_V = 8192, T8_K = 8192, T8_R = 4096, STG9 = T8_V + T8_K + T8_R, OFF_WS9 = 3 * STG9;
#define VS8(d, b) ((d) * 64 + ((b) ^ ((((d) >> 2) & 3) << 4)))
template <int ABL = 0> __device__ __forceinline__ void attn_block9(const unsigned char* __restrict__ Qb, const unsigned char* __restrict__ Kh, const unsigned char* __restrict__ Vt, const unsigned char* __restrict__ Rh,
                                            float* __restrict__ Ob, int qb, char* lds) {
  const int tid = threadIdx.x, wid = __builtin_amdgcn_readfirstlane(tid >> 6), lane = tid & 63, r32 = lane & 31, hi = lane >> 5;
  float* ws = (float*)(lds + OFF_WS9) + wid * 64; float* li_l = ws;
  float l_reg = 0; f32x16 o[4] = {}; v8i_a qf[3];
  { const unsigned char* Qw = Qb + (long)(wid * QBLK + r32) * 192 + 32 * hi;
#pragma unroll
    for (int s = 0; s < 3; ++s) { const v4i_a a = *reinterpret_cast<const v4i_a*>(Qw + 64 * s), b = *reinterpret_cast<const v4i_a*>(Qw + 64 * s + 16); qf[s] = __builtin_shufflevector(a, b, 0, 1, 2, 3, 4, 5, 6, 7); } }
  unsigned kof, rof; const unsigned vof = (unsigned)(wid * 1024 + lane * 16);
  { const int row = 8 * wid + (lane >> 3), slot = lane & 7; kof = (unsigned)(row * 128 + ((slot ^ ((row >> 1) & 7)) << 4)); }
  { const int row = 16 * (wid & 3) + (lane >> 2), slot = lane & 3; rof = (unsigned)(row * 64 + ((slot ^ ((row >> 2) & 3)) << 4)); }
  const int wchunk = wid >> 1, t0 = 4 * qb, NT = 4 * qb + 4;
  const LAS unsigned char* ldsb = (const LAS unsigned char*)lds;
#define DMA9(tile, st) do { const char* kp = (const char*)Kh + (size_t)(tile) * (KVBLK * 128); const char* vp = (const char*)Vt + (size_t)(tile) * 8192; const char* rp = (const char*)Rh + (size_t)(tile) * (KVBLK * 64); \
    LAS unsigned char* sb_ = (LAS unsigned char*)ldsb + (st) * STG9; \
    __builtin_amdgcn_global_load_lds((const unsigned*)(vp + vof), (LAS unsigned*)(sb_ + wid * 1024), 16, 0, 0); \
    __builtin_amdgcn_global_load_lds((const unsigned*)(kp + kof), (LAS unsigned*)(sb_ + T8_V + wid * 1024), 16, 0, 0); \
    __builtin_amdgcn_global_load_lds((const unsigned*)(rp + rof), (LAS unsigned*)(sb_ + T8_V + T8_K + (wid & 3) * 1024), 16, 0, 0); } while (0)
#define MASKED(j) (((j) - t0) > wchunk)
  f32x16 p0, p1; v8i_a P8 = {0, 0, 0, 0, 0, 0, 0, 0};
#ifndef ATT_DEPHASE
#define ATT_DEPHASE 0
#endif
#if ATT_DEPHASE
  const int half = wid >> 2;
  DMA9(0, 0); DMA9(1, 1);
  asm volatile("s_waitcnt vmcnt(3)" ::: "memory"); __builtin_amdgcn_s_barrier(); asm volatile("" ::: "memory");
  f32x16 cinit;
#pragma unroll
  for (int r = 0; r < 16; ++r) cinit[r] = -2.0f;
  asm volatile("" : "+v"(cinit));
  if (half == 1) { __builtin_amdgcn_s_barrier(); asm volatile("" ::: "memory"); }
  int st = 0;
#pragma unroll 1
  for (int j = 0; j < NT; ++j) {
    char* sb = lds + st * STG9; const bool live = !MASKED(j);
    v8i_a vf[4];
    if (live) {
      const char* Ks = sb + T8_V; const char* Rs = sb + T8_V + T8_K;
      SBAR();
      v8i_a kf[6];
#pragma unroll
      for (int s2 = 0; s2 < 2; ++s2) { const int b0 = 64 * s2 + 32 * hi;
        kf[2 * s2] = ld32(Ks + KS8(r32, b0), Ks + KS8(r32, b0 + 16)); kf[2 * s2 + 1] = ld32(Ks + KS8(32 + r32, b0), Ks + KS8(32 + r32, b0 + 16)); }
      kf[4] = ld32(Rs + RS8(r32, 32 * hi), Rs + RS8(r32, 32 * hi + 16)); kf[5] = ld32(Rs + RS8(32 + r32, 32 * hi), Rs + RS8(32 + r32, 32 * hi + 16));
      SBAR();
      p0 = __builtin_amdgcn_mfma_scale_f32_32x32x64_f8f6f4(kf[0], qf[0], cinit, 0, 0, 0, 0, 0, 0);
      p1 = __builtin_amdgcn_mfma_scale_f32_32x32x64_f8f6f4(kf[1], qf[0], cinit, 0, 0, 0, 0, 0, 0);
      p0 = __builtin_amdgcn_mfma_scale_f32_32x32x64_f8f6f4(kf[2], qf[1], p0, 0, 0, 0, 0, 0, 0);
      p1 = __builtin_amdgcn_mfma_scale_f32_32x32x64_f8f6f4(kf[3], qf[1], p1, 0, 0, 0, 0, 0, 0);
      p0 = __builtin_amdgcn_mfma_scale_f32_32x32x64_f8f6f4(kf[4], qf[2], p0, 0, 0, 0, 0, 0, 0);
      p1 = __builtin_amdgcn_mfma_scale_f32_32x32x64_f8f6f4(kf[5], qf[2], p1, 0, 0, 0, 0, 0, 0);
      SBAR();
#pragma unroll
      for (int d0 = 0; d0 < 4; ++d0) { const int d = d0 * 32 + r32; vf[d0] = ld32(sb + VS8(d, 32 * hi), sb + VS8(d, 32 * hi + 16)); }
      SBAR();
      float ps = 0;
#pragma unroll
      for (int r = 0; r < 16; ++r) { p0[r] = fminf(__builtin_amdgcn_exp2f(p0[r]), 448.0f); ps += p0[r]; }
      l_reg += ps;
      P8[0] = (int)pk4_fp8(p0[0], p0[1], p0[2], p0[3]); P8[1] = (int)pk4_fp8(p0[4], p0[5], p0[6], p0[7]); P8[2] = (int)pk4_fp8(p0[8], p0[9], p0[10], p0[11]); P8[3] = (int)pk4_fp8(p0[12], p0[13], p0[14], p0[15]);
      SBAR(); }
    asm volatile("s_waitcnt vmcnt(0)" ::: "memory");
    __builtin_amdgcn_s_barrier(); asm volatile("" ::: "memory");
    if (j + 2 < NT) { const int st2 = (st >= 1) ? st - 1 : 2; DMA9(j + 2, st2); }
    if (live) {
      SBAR();
      float ps = 0;
#pragma unroll
      for (int r = 0; r < 16; ++r) { p1[r] = fminf(__builtin_amdgcn_exp2f(p1[r]), 448.0f); ps += p1[r]; }
      l_reg += ps;
      P8[4] = (int)pk4_fp8(p1[0], p1[1], p1[2], p1[3]); P8[5] = (int)pk4_fp8(p1[4], p1[5], p1[6], p1[7]); P8[6] = (int)pk4_fp8(p1[8], p1[9], p1[10], p1[11]); P8[7] = (int)pk4_fp8(p1[12], p1[13], p1[14], p1[15]);
      SBAR();
#pragma unroll
      for (int d0 = 0; d0 < 4; ++d0) o[d0] = __builtin_amdgcn_mfma_scale_f32_32x32x64_f8f6f4(P8, vf[d0], o[d0], 0, 0, 0, 0, 0, 0);
      SBAR(); }
    __builtin_amdgcn_s_barrier(); asm volatile("" ::: "memory");
    st = (st == 2) ? 0 : st + 1;
  }
  if (half == 0) { __builtin_amdgcn_s_barrier(); asm volatile("" ::: "memory"); }
#else
#define DMA9V(tile, st) __builtin_amdgcn_global_load_lds((const unsigned*)((const char*)Vt + (size_t)(tile) * 8192 + vof), (LAS unsigned*)((LAS unsigned char*)ldsb + (st) * STG9 + wid * 1024), 16, 0, 0)
#define DMA9K(tile, st) __builtin_amdgcn_global_load_lds((const unsigned*)((const char*)Kh + (size_t)(tile) * (KVBLK * 128) + kof), (LAS unsigned*)((LAS unsigned char*)ldsb + (st) * STG9 + T8_V + wid * 1024), 16, 0, 0)
#define DMA9R(tile, st) __builtin_amdgcn_global_load_lds((const unsigned*)((const char*)Rh + (size_t)(tile) * (KVBLK * 64) + rof), (LAS unsigned*)((LAS unsigned char*)ldsb + (st) * STG9 + T8_V + T8_K + (wid & 3) * 1024), 16, 0, 0)
  const bool rdma = (wid < 4);
  DMA9V(0, 0); DMA9K(0, 0); if (rdma) DMA9R(0, 0);
  DMA9V(1, 1); DMA9K(1, 1); if (rdma) DMA9R(1, 1);
  if (rdma) asm volatile("s_waitcnt vmcnt(3)" ::: "memory"); else asm volatile("s_waitcnt vmcnt(2)" ::: "memory");
  __builtin_amdgcn_s_barrier(); asm volatile("" ::: "memory");
  f32x16 osum = {};
  v8i_a ones = {0x38383838, 0x38383838, 0x38383838, 0x38383838, 0x38383838, 0x38383838, 0x38383838, 0x38383838};
  asm volatile("" : "+v"(ones));
  int st = 0, j = 0;
#pragma unroll 1
  for (; j < t0; ++j) {
    const int st2 = (st >= 1) ? st - 1 : 2;
    if constexpr (ABL != 2) DMA9V(j + 2, st2);
    char* sb = lds + st * STG9;
      { const char* Ks = sb + T8_V; const char* Rs = sb + T8_V + T8_K;
      SBAR();
      v8i_a kf[6];
#pragma unroll
      for (int s2 = 0; s2 < 2; ++s2) { const int b0 = 64 * s2 + 32 * hi;
        kf[2 * s2] = ld32(Ks + KS8(r32, b0), Ks + KS8(r32, b0 + 16)); kf[2 * s2 + 1] = ld32(Ks + KS8(32 + r32, b0), Ks + KS8(32 + r32, b0 + 16)); }
      kf[4] = ld32(Rs + RS8(r32, 32 * hi), Rs + RS8(r32, 32 * hi + 16)); kf[5] = ld32(Rs + RS8(32 + r32, 32 * hi), Rs + RS8(32 + r32, 32 * hi + 16));
      SBAR();
#pragma unroll
      for (int r = 0; r < 16; ++r) { p0[r] = 40.25f; p1[r] = 40.25f; }
      p0 = __builtin_amdgcn_mfma_scale_f32_32x32x64_f8f6f4(kf[0], qf[0], p0, 0, 0, 0, 0, 0, 0);
      p1 = __builtin_amdgcn_mfma_scale_f32_32x32x64_f8f6f4(kf[1], qf[0], p1, 0, 0, 0, 0, 0, 0);
      p0 = __builtin_amdgcn_mfma_scale_f32_32x32x64_f8f6f4(kf[2], qf[1], p0, 0, 0, 0, 0, 0, 0);
      p1 = __builtin_amdgcn_mfma_scale_f32_32x32x64_f8f6f4(kf[3], qf[1], p1, 0, 0, 0, 0, 0, 0);
      p0 = __builtin_amdgcn_mfma_scale_f32_32x32x64_f8f6f4(kf[4], qf[2], p0, 0, 0, 0, 0, 0, 0);
      p1 = __builtin_amdgcn_mfma_scale_f32_32x32x64_f8f6f4(kf[5], qf[2], p1, 0, 0, 0, 0, 0, 0);
      SBAR();
      if constexpr (ABL != 2) { if (true) DMA9K(j + 2, st2); }
      v8i_a vf[4];
#pragma unroll
      for (int d0 = 0; d0 < 4; ++d0) { const int d = d0 * 32 + r32; vf[d0] = ld32(sb + VS8(d, 32 * hi), sb + VS8(d, 32 * hi + 16)); }
      SBAR();
#pragma unroll
      for (int k = 0; k < 4; ++k) { unsigned w0, w1; asm volatile("" : "=v"(w0), "=v"(w1));
#pragma unroll
        for (int b = 0; b < 4; ++b) { w0 = __builtin_amdgcn_cvt_pk_u8_f32(__builtin_amdgcn_fmed3f(p0[4 * k + b], 0.0f, 126.0f), b, w0); w1 = __builtin_amdgcn_cvt_pk_u8_f32(__builtin_amdgcn_fmed3f(p1[4 * k + b], 0.0f, 126.0f), b, w1); }
        P8[k] = (int)w0; P8[4 + k] = (int)w1; }
      SBAR();
      if constexpr (ABL != 2) { if (true && rdma) DMA9R(j + 2, st2); }
#pragma unroll
      for (int d0 = 0; d0 < 4; ++d0) o[d0] = __builtin_amdgcn_mfma_scale_f32_32x32x64_f8f6f4(P8, vf[d0], o[d0], 0, 0, 0, 0, 0, 0);
      osum = __builtin_amdgcn_mfma_scale_f32_32x32x64_f8f6f4(P8, ones, osum, 0, 0, 0, 0, 0, 0); }
    if (rdma) asm volatile("s_waitcnt vmcnt(3)" ::: "memory"); else asm volatile("s_waitcnt vmcnt(2)" ::: "memory");
    __builtin_amdgcn_s_barrier(); asm volatile("" ::: "memory");
    st = (st == 2) ? 0 : st + 1;
  }
#pragma unroll 1
  for (; j < NT; ++j) {
    const bool more = (j + 2 < NT); const int st2 = (st >= 1) ? st - 1 : 2;
    if constexpr (ABL != 2) { if (more) DMA9V(j + 2, st2); }
    char* sb = lds + st * STG9;
    if (!MASKED(j)) {
      { const char* Ks = sb + T8_V; const char* Rs = sb + T8_V + T8_K;
      SBAR();
      v8i_a kf[6];
#pragma unroll
      for (int s2 = 0; s2 < 2; ++s2) { const int b0 = 64 * s2 + 32 * hi;
        kf[2 * s2] = ld32(Ks + KS8(r32, b0), Ks + KS8(r32, b0 + 16)); kf[2 * s2 + 1] = ld32(Ks + KS8(32 + r32, b0), Ks + KS8(32 + r32, b0 + 16)); }
      kf[4] = ld32(Rs + RS8(r32, 32 * hi), Rs + RS8(r32, 32 * hi + 16)); kf[5] = ld32(Rs + RS8(32 + r32, 32 * hi), Rs + RS8(32 + r32, 32 * hi + 16));
      SBAR();
#pragma unroll
      for (int r = 0; r < 16; ++r) { p0[r] = 40.25f; p1[r] = 40.25f; }
      p0 = __builtin_amdgcn_mfma_scale_f32_32x32x64_f8f6f4(kf[0], qf[0], p0, 0, 0, 0, 0, 0, 0);
      p1 = __builtin_amdgcn_mfma_scale_f32_32x32x64_f8f6f4(kf[1], qf[0], p1, 0, 0, 0, 0, 0, 0);
      p0 = __builtin_amdgcn_mfma_scale_f32_32x32x64_f8f6f4(kf[2], qf[1], p0, 0, 0, 0, 0, 0, 0);
      p1 = __builtin_amdgcn_mfma_scale_f32_32x32x64_f8f6f4(kf[3], qf[1], p1, 0, 0, 0, 0, 0, 0);
      p0 = __builtin_amdgcn_mfma_scale_f32_32x32x64_f8f6f4(kf[4], qf[2], p0, 0, 0, 0, 0, 0, 0);
      p1 = __builtin_amdgcn_mfma_scale_f32_32x32x64_f8f6f4(kf[5], qf[2], p1, 0, 0, 0, 0, 0, 0);
      SBAR();
      if constexpr (ABL != 2) { if (more) DMA9K(j + 2, st2); }
      v8i_a vf[4];
#pragma unroll
      for (int d0 = 0; d0 < 4; ++d0) { const int d = d0 * 32 + r32; vf[d0] = ld32(sb + VS8(d, 32 * hi), sb + VS8(d, 32 * hi + 16)); }
      SBAR();
#pragma unroll
      for (int k = 0; k < 4; ++k) { unsigned w0, w1; asm volatile("" : "=v"(w0), "=v"(w1));
#pragma unroll
        for (int b = 0; b < 4; ++b) { w0 = __builtin_amdgcn_cvt_pk_u8_f32(__builtin_amdgcn_fmed3f(p0[4 * k + b], 0.0f, 126.0f), b, w0); w1 = __builtin_amdgcn_cvt_pk_u8_f32(__builtin_amdgcn_fmed3f(p1[4 * k + b], 0.0f, 126.0f), b, w1); }
        P8[k] = (int)w0; P8[4 + k] = (int)w1; }
      SBAR();
      if constexpr (ABL != 2) { if (more && rdma) DMA9R(j + 2, st2); }
#pragma unroll
      for (int d0 = 0; d0 < 4; ++d0) o[d0] = __builtin_amdgcn_mfma_scale_f32_32x32x64_f8f6f4(P8, vf[d0], o[d0], 0, 0, 0, 0, 0, 0);
      osum = __builtin_amdgcn_mfma_scale_f32_32x32x64_f8f6f4(P8, ones, osum, 0, 0, 0, 0, 0, 0); }
    } else {
      if constexpr (ABL != 2) { if (more) { DMA9K(j + 2, st2); if (rdma) DMA9R(j + 2, st2); } }
    }
    if (more) { if (rdma) asm volatile("s_waitcnt vmcnt(3)" ::: "memory"); else asm volatile("s_waitcnt vmcnt(2)" ::: "memory"); } else asm volatile("s_waitcnt vmcnt(0)" ::: "memory");
    __builtin_amdgcn_s_barrier(); asm volatile("" ::: "memory");
    st = (st == 2) ? 0 : st + 1;
  }
#undef DMA9V
#undef DMA9K
#undef DMA9R
#endif
#if ATT_DEPHASE
  { auto rr = __builtin_amdgcn_permlane32_swap(__float_as_uint(l_reg), __float_as_uint(l_reg), false, false); l_reg = __uint_as_float(rr[0]) + __uint_as_float(rr[1]); }
  if (hi == 0) li_l[r32] = l_reg; asm volatile("s_waitcnt lgkmcnt(0)" ::: "memory");
  float rli[16];
#pragma unroll
  for (int r = 0; r < 16; ++r) rli[r] = __builtin_amdgcn_rcpf(li_l[crow(r, hi)]);
#else
  float rli[16];
#pragma unroll
  for (int r = 0; r < 16; ++r) rli[r] = __builtin_amdgcn_rcpf(osum[r]);
  (void)li_l; (void)l_reg;
#endif
  float* Ow = Ob + (long)(wid * QBLK) * LDO;
  if (ABL == 0 || qb < 0) {
#pragma unroll
  for (int r = 0; r < 16; ++r) { int orow = crow(r, hi);
#pragma unroll
    for (int d0 = 0; d0 < 4; ++d0) Ow[(long)orow * LDO + d0 * 32 + r32] = o[d0][r] * rli[r]; } }
#undef DMA9
#undef MASKED
}
}

struct Ctx { int tid, lane, wave, vcu, G; LAS unsigned char* lds; };
#define LDS_FENCE() asm volatile("s_waitcnt lgkmcnt(0)" ::: "memory")

__device__ __forceinline__ void p0_mod_chunk(const Ctx& c, int chunk, const float* __restrict__ cvec, const float* __restrict__ w_ada, const float* __restrict__ b_ada, float* __restrict__ MOD) {
    const int n0 = chunk * 64, ncg = c.tid & 15, ks = c.tid >> 4;
    f32x4 a0 = {0.f, 0.f, 0.f, 0.f}, a1 = {0.f, 0.f, 0.f, 0.f};
#pragma unroll 8
    for (int k = ks; k < 2048; k += 32) {
        const f32x4 w = *(const f32x4*)(w_ada + (size_t)k * 12288 + n0 + 4 * ncg);
        const float c0 = cvec[k], c1 = cvec[2048 + k];
        const float s0 = c0 * sigmoidf_(c0), s1 = c1 * sigmoidf_(c1);
        a0 += s0 * w; a1 += s1 * w;
    }
    LAS float* red = (LAS float*)c.lds;
    *(LAS f32x4*)(red + (ks * 2 + 0) * 64 + 4 * ncg) = a0; *(LAS f32x4*)(red + (ks * 2 + 1) * 64 + 4 * ncg) = a1;
    __syncthreads();
    if (c.tid < 128) { const int b = c.tid >> 6, n = c.tid & 63; float s = 0.f;
#pragma unroll 8
        for (int k2 = 0; k2 < 32; ++k2) s += red[(k2 * 2 + b) * 64 + n];
        MOD[b * 12288 + n0 + n] = s + b_ada[n0 + n]; }
    __syncthreads();
}
__device__ __forceinline__ void p0_kc_item(const Ctx& c, int item, const float* __restrict__ A_re, const float* __restrict__ A_im, const float* __restrict__ B_re, const float* __restrict__ B_im,
                                           const float* __restrict__ C_re, const float* __restrict__ C_im, const float* __restrict__ Dv, const float* __restrict__ log_dt, float* __restrict__ KC, float* __restrict__ BB) {
    const int g = item >> 2, dq = item & 3;
    LAS float* Cre = (LAS float*)c.lds; LAS float* Cim = Cre + 1024; LAS float* Bre = Cim + 1024; LAS float* Bim = Bre + 1024; LAS float* Are = Bim + 1024; LAS float* Aim = Are + 1024;
    const float dt = expf(log_dt[g]);
    for (int idx = c.tid; idx < 1024; idx += 512) {
        { const int h = idx >> 6, p = idx & 63; Cre[idx] = C_re[(g * 16 + h) * 64 + p]; Cim[idx] = C_im[(g * 16 + h) * 64 + p]; }
        { const int p = idx >> 4, hh = idx & 15; const float are = A_re[g * 64 + p], aim = A_im[g * 64 + p];
          float cs, sn; sincos_d((double)dt * (double)aim, cs, sn); const float ex = expf(dt * are);
          const float nr = ex * cs - 1.0f, ni = ex * sn, den = are * are + aim * aim;
          const float cbr = (nr * are + ni * aim) / den, cbi = (ni * are - nr * aim) / den;
          const float br = B_re[(g * 64 + p) * 16 + hh], bi = B_im[(g * 64 + p) * 16 + hh];
          const float bbr = cbr * br - cbi * bi, bbi = cbr * bi + cbi * br;
          Bre[idx] = bbr; Bim[idx] = bbi;
          if (dq == 0) { BB[((size_t)(g * 64 + p) * 16 + hh) * 2] = bbr; BB[((size_t)(g * 64 + p) * 16 + hh) * 2 + 1] = bbi; } }
        { const int dd = idx >> 6, p = idx & 63, d = dq * 16 + dd; const float are = A_re[g * 64 + p], aim = A_im[g * 64 + p];
          float cs, sn; sincos_d((double)d * (double)dt * (double)aim, cs, sn); const float ex = expf((float)d * dt * are);
          Are[idx] = ex * cs; Aim[idx] = ex * sn; }
    }
    __syncthreads();
#pragma unroll 1
    for (int r = 0; r < 8; ++r) { const int e = c.tid + 512 * r, dd = e >> 8, h = (e >> 4) & 15, hh = e & 15; float s = 0.f;
#pragma unroll 8
        for (int p = 0; p < 64; ++p) { const float ar = Are[dd * 64 + p], ai = Aim[dd * 64 + p], br = Bre[p * 16 + hh], bi = Bim[p * 16 + hh];
            const float er = ar * br - ai * bi, ei = ar * bi + ai * br; s += Cre[h * 64 + p] * er - Cim[h * 64 + p] * ei; }
        const int d = dq * 16 + dd; if (d == 0 && h == hh) s += Dv[g * 16 + h];
        KC[((size_t)(g * 64 + d) * 16 + h) * 16 + hh] = s; }
    __syncthreads();
}
template <int MAP> __device__ __forceinline__ int rowmap(int n) {
    if (MAP == 1) { const int h = n / 192, d = n - h * 192; return d < 128 ? h * 128 + d : 1024 + h * 64 + (d - 128); }
    if (MAP == 2) { const int j = n >> 1, s = n & 1; return (j >> 7) * 256 + s * 128 + (j & 127); }
    return n;
}
template <int MAP> __device__ __forceinline__ void tr_item(const float* __restrict__ W, int N, const float* __restrict__ kscale, bf16_t* __restrict__ WT, int ldt, int kb, int nb, int lane) {
    const int kgrp = lane >> 3, nc = lane & 7, k0 = kb * 64 + 8 * kgrp;
    f32x4 v[2][8];
#pragma unroll
    for (int nn = 0; nn < 2; ++nn)
#pragma unroll
        for (int i = 0; i < 8; ++i) v[nn][i] = *(const f32x4*)(W + (size_t)(k0 + i) * N + nb * 64 + 32 * nn + 4 * nc);
    float sc[8];
#pragma unroll
    for (int i = 0; i < 8; ++i) sc[i] = kscale ? kscale[k0 + i] : 1.0f;
#pragma unroll
    for (int nn = 0; nn < 2; ++nn)
#pragma unroll
        for (int j = 0; j < 4; ++j) { const int row = rowmap<MAP>(nb * 64 + 32 * nn + 4 * nc + j);
            u32x4 w; w.x = cvt_pk_bf16(v[nn][0][j] * sc[0], v[nn][1][j] * sc[1]); w.y = cvt_pk_bf16(v[nn][2][j] * sc[2], v[nn][3][j] * sc[3]);
            w.z = cvt_pk_bf16(v[nn][4][j] * sc[4], v[nn][5][j] * sc[5]); w.w = cvt_pk_bf16(v[nn][6][j] * sc[6], v[nn][7][j] * sc[7]);
            *(u32x4*)(WT + (size_t)row * ldt + k0) = w; }
}

struct RowRaw { f32x4 v[8]; };
__device__ __forceinline__ RowRaw hnorm_load(const float* __restrict__ xrow, int lane) { RowRaw r;
#pragma unroll
    for (int j = 0; j < 8; ++j) r.v[j] = __builtin_nontemporal_load((const f32x4*)(xrow + 4 * lane + 256 * j));
    return r; }
__device__ __forceinline__ float hnorm_proc(const RowRaw& r, bf16_t* __restrict__ hrow, const f32x4 (&fa)[8], const f32x4 (&fb)[8], int lane) {
    float ss = 0.f;
#pragma unroll
    for (int j = 0; j < 8; ++j) ss += (r.v[j][0] * r.v[j][0] + r.v[j][1] * r.v[j][1]) + (r.v[j][2] * r.v[j][2] + r.v[j][3] * r.v[j][3]);
    const float rstd = 1.0f / sqrtf(wave_sum(ss) * (1.0f / 2048.0f) + EPS);
#pragma unroll
    for (int j = 0; j < 8; ++j) { const f32x4 y = r.v[j] * rstd * fa[j] + fb[j]; u32x2 w; w.x = cvt_pk_bf16(y[0], y[1]); w.y = cvt_pk_bf16(y[2], y[3]);
        *(u32x2*)(hrow + 4 * lane + 256 * j) = w; }
    return rstd;
}
__device__ __forceinline__ float hnorm_row(const float* __restrict__ xrow, bf16_t* __restrict__ hrow, const f32x4 (&fa)[8], const f32x4 (&fb)[8], int lane) {
    const RowRaw r = hnorm_load(xrow, lane); return hnorm_proc(r, hrow, fa, fb, lane);
}

template <int MAP> __device__ __forceinline__ void tr_item8(const float* __restrict__ W, int N, unsigned char* __restrict__ WT, int ldt, int kb, int nb, int lane, const float* __restrict__ kscale = nullptr) {
    const int kgrp = lane >> 4, nc = lane & 15, k0 = kb * 128 + 32 * kgrp;
    f32x4 v[32];
#pragma unroll
    for (int i = 0; i < 32; ++i) v[i] = __builtin_nontemporal_load((const f32x4*)(W + (size_t)(k0 + i) * N + nb * 64 + 4 * nc));
    if (kscale) {
#pragma unroll
        for (int i = 0; i < 32; ++i) v[i] *= kscale[k0 + i]; }
#pragma unroll
    for (int j = 0; j < 4; ++j) { const int row = rowmap<MAP>(nb * 64 + 4 * nc + j);
#pragma unroll
        for (int hh = 0; hh < 2; ++hh) { const int q = 16 * hh;
            u32x4 w; w.x = pk4_fp8(v[q + 0][j] * W8_SCALE, v[q + 1][j] * W8_SCALE, v[q + 2][j] * W8_SCALE, v[q + 3][j] * W8_SCALE); w.y = pk4_fp8(v[q + 4][j] * W8_SCALE, v[q + 5][j] * W8_SCALE, v[q + 6][j] * W8_SCALE, v[q + 7][j] * W8_SCALE);
            w.z = pk4_fp8(v[q + 8][j] * W8_SCALE, v[q + 9][j] * W8_SCALE, v[q + 10][j] * W8_SCALE, v[q + 11][j] * W8_SCALE); w.w = pk4_fp8(v[q + 12][j] * W8_SCALE, v[q + 13][j] * W8_SCALE, v[q + 14][j] * W8_SCALE, v[q + 15][j] * W8_SCALE);
            *(u32x4*)(WT + (size_t)row * ldt + k0 + q) = w; } }
}
__device__ __forceinline__ float hnorm_row8(const float* __restrict__ xrow, unsigned char* __restrict__ hrow, const f32x4 (&fa)[8], const f32x4 (&fb)[8], int lane) {
    f32x4 v[8]; float ss = 0.f;
#pragma unroll
    for (int j = 0; j < 8; ++j) { v[j] = *(const f32x4*)(xrow + 4 * lane + 256 * j); ss += (v[j][0] * v[j][0] + v[j][1] * v[j][1]) + (v[j][2] * v[j][2] + v[j][3] * v[j][3]); }
    const float rstd = 1.0f / sqrtf(wave_sum(ss) * (1.0f / 2048.0f) + EPS);
#pragma unroll
    for (int j = 0; j < 8; ++j) { const f32x4 y = v[j] * rstd * fa[j] + fb[j]; *(unsigned*)(hrow + 4 * lane + 256 * j) = pk4_fp8(y[0], y[1], y[2], y[3]); }
    return rstd;
}

struct RowRawB { u32x4 w[4]; };
__device__ __forceinline__ RowRawB hnorm_b_load(const bf16_t* __restrict__ xrow, int lane) { RowRawB r;
#pragma unroll
    for (int j = 0; j < 4; ++j) r.w[j] = *(const u32x4*)(xrow + 8 * lane + 512 * j);
    return r; }
__device__ __forceinline__ float hnorm_b_proc(const RowRawB& r, unsigned char* __restrict__ hrow, const f32x4 (&fa)[4][2], const f32x4 (&fb)[4][2], int lane) {
    float v[4][8]; float ss = 0.f;
#pragma unroll
    for (int j = 0; j < 4; ++j) { const u32x4 w = r.w[j];
        v[j][0] = bflo(w[0]); v[j][1] = bfhi(w[0]); v[j][2] = bflo(w[1]); v[j][3] = bfhi(w[1]); v[j][4] = bflo(w[2]); v[j][5] = bfhi(w[2]); v[j][6] = bflo(w[3]); v[j][7] = bfhi(w[3]);
#pragma unroll
        for (int e = 0; e < 8; ++e) ss += v[j][e] * v[j][e]; }
    const float rstd = 1.0f / sqrtf(wave_sum(ss) * (1.0f / 2048.0f) + EPS);
#pragma unroll
    for (int j = 0; j < 4; ++j) { float y[8];
#pragma unroll
        for (int e = 0; e < 8; ++e) y[e] = v[j][e] * rstd * fa[j][e >> 2][e & 3] + fb[j][e >> 2][e & 3];
#if MOE_FP8
        u32x2 w; w.x = pk4_fp8(y[0], y[1], y[2], y[3]); w.y = pk4_fp8(y[4], y[5], y[6], y[7]); *(u32x2*)(hrow + 8 * lane + 512 * j) = w;
#else
        u32x4 w; w.x = cvt_pk_bf16(y[0], y[1]); w.y = cvt_pk_bf16(y[2], y[3]); w.z = cvt_pk_bf16(y[4], y[5]); w.w = cvt_pk_bf16(y[6], y[7]); *(u32x4*)((bf16_t*)hrow + 8 * lane + 512 * j) = w;
#endif
    }
    return rstd;
}

__device__ __forceinline__ void p4_carry_item(const Ctx& c, int item, const float* __restrict__ SEND, const float* __restrict__ A64, const float* __restrict__ A1024, bf16_t* __restrict__ AG) {
    const int g = item >> 2, b = (item >> 1) & 1, ph = item & 1, seg = c.tid >> 5, pl = c.tid & 31, p = ph * 32 + pl;
    const float ar = A64[(g * 64 + p) * 2], ai = A64[(g * 64 + p) * 2 + 1], qr = A1024[(g * 64 + p) * 2], qi = A1024[(g * 64 + p) * 2 + 1];
    float sre[16], sim[16];
#pragma unroll
    for (int i = 0; i < 16; ++i) { const size_t row = (size_t)(g * NCH + b * 256 + seg * 16 + i) * 128; sre[i] = SEND[row + p]; sim[i] = SEND[row + 64 + p]; }
    float lr = 0.f, li = 0.f;
#pragma unroll
    for (int i = 0; i < 16; ++i) { const float nr = ar * lr - ai * li + sre[i], ni = ar * li + ai * lr + sim[i]; lr = nr; li = ni; }
    LAS float* se = (LAS float*)c.lds;
    LAS float* ci = se + 1024;
    se[(seg * 32 + pl) * 2] = lr; se[(seg * 32 + pl) * 2 + 1] = li;
    __syncthreads();
    if (c.tid < 32) { float cr = 0.f, cim = 0.f;
#pragma unroll 1
        for (int s = 0; s < 16; ++s) { ci[(s * 32 + pl) * 2] = cr; ci[(s * 32 + pl) * 2 + 1] = cim; const float er = se[(s * 32 + pl) * 2], ei = se[(s * 32 + pl) * 2 + 1];
            const float nr = qr * cr - qi * cim + er, ni = qr * cim + qi * cr + ei; cr = nr; cim = ni; } }
    __syncthreads();
    float cr = ci[(seg * 32 + pl) * 2], cim = ci[(seg * 32 + pl) * 2 + 1];
#pragma unroll
    for (int i = 0; i < 16; ++i) { bf16_t* dst = AG + (size_t)(g * NCH + b * 256 + seg * 16 + i) * AGW; dst[p] = f2bf(cr); dst[64 + p] = f2bf(cim);
        const float nr = ar * cr - ai * cim + sre[i], ni = ar * cim + ai * cr + sim[i]; cr = nr; cim = ni; }
    __syncthreads();
}

constexpr float QSC = 0.07216878364870322f * 1.4426950408889634f;
constexpr float SQ8 = 0.3226727f;
constexpr float QMUL = ATT_FP8 ? (ATT_PV8 ? 8.0f * SQ8 : SQ8) : QSC, KMUL = ATT_FP8 ? SQ8 : 1.0f;
struct QkRaw { u32x4 zq; u32x2 zkv; unsigned zkr; u32x4 qn0, qn1, qr, kn0, kn1, v0, v1; f32x4 cq0, cq1, sq0, sq1; float ck, sk; };
struct QkGain { float qn[16], qr[8], kn[16], kr; };
__device__ __forceinline__ QkGain p4_gains(int lane, const float* __restrict__ q_nope_g, const float* __restrict__ q_rope_g, const float* __restrict__ k_nope_g, const float* __restrict__ k_rope_g) {
    QkGain g; const int s = lane & 7;
#pragma unroll
    for (int i = 0; i < 16; ++i) { g.qn[i] = q_nope_g[s * 16 + i] * QMUL; g.kn[i] = k_nope_g[s * 16 + i] * KMUL; }
#pragma unroll
    for (int i = 0; i < 8; ++i) g.qr[i] = q_rope_g[s * 8 + i] * QMUL;
    g.kr = k_rope_g[lane] * KMUL; return g;
}
__device__ __forceinline__ QkRaw p4_load(int t, int lane, const bf16_t* __restrict__ Z2, const bf16_t* __restrict__ QRAW, const bf16_t* __restrict__ KVRAW, const float* __restrict__ COS, const float* __restrict__ SIN) {
    QkRaw r; const int h = lane >> 3, s = lane & 7; const bf16_t* z = Z2 + (size_t)t * AGW;
    r.zq = *(const u32x4*)(z + lane * 8); r.zkv = *(const u32x2*)(z + 512 + lane * 4); r.zkr = z[768 + lane];
    const bf16_t* q = QRAW + (size_t)t * 1536; r.qn0 = __builtin_nontemporal_load((const u32x4*)(q + h * 128 + s * 16)); r.qn1 = __builtin_nontemporal_load((const u32x4*)(q + h * 128 + s * 16 + 8)); r.qr = __builtin_nontemporal_load((const u32x4*)(q + 1024 + h * 64 + s * 8));
    const bf16_t* kv = KVRAW + (size_t)t * 2048 + h * 256 + s * 16; r.kn0 = __builtin_nontemporal_load((const u32x4*)kv); r.kn1 = __builtin_nontemporal_load((const u32x4*)(kv + 8)); r.v0 = __builtin_nontemporal_load((const u32x4*)(kv + 128)); r.v1 = __builtin_nontemporal_load((const u32x4*)(kv + 136));
    const float* cp = COS + (size_t)t * 32; const float* sp = SIN + (size_t)t * 32;
    r.cq0 = *(const f32x4*)(cp + (s & 3) * 8); r.cq1 = *(const f32x4*)(cp + (s & 3) * 8 + 4); r.sq0 = *(const f32x4*)(sp + (s & 3) * 8); r.sq1 = *(const f32x4*)(sp + (s & 3) * 8 + 4);
    r.ck = cp[lane & 31]; r.sk = sp[lane & 31]; return r;
}
#define UNPK8(W_, X_, O_) do { const u32x4 w_ = (W_); X_[O_ + 0] = bflo(w_[0]); X_[O_ + 1] = bfhi(w_[0]); X_[O_ + 2] = bflo(w_[1]); X_[O_ + 3] = bfhi(w_[1]); X_[O_ + 4] = bflo(w_[2]); X_[O_ + 5] = bfhi(w_[2]); X_[O_ + 6] = bflo(w_[3]); X_[O_ + 7] = bfhi(w_[3]); } while (0)
__device__ __forceinline__ void p4_proc(int t, int lane, const QkRaw& r, const QkGain& g, bf16_t* __restrict__ Q, bf16_t* __restrict__ KN, bf16_t* __restrict__ V, bf16_t* __restrict__ KR, LAS unsigned char* vtile) {
    const int h = lane >> 3, s = lane & 7, b = t >> 14, l = t & (SEQ - 1);
    float rq, rkv;
    { float x[8]; UNPK8(r.zq, x, 0); float ss = 0.f;
#pragma unroll
      for (int i = 0; i < 8; ++i) ss += x[i] * x[i];
      rq = 1.0f / sqrtf(wave_sum(ss) * (1.0f / 512.0f) + EPS); }
    { const float ss = bflo(r.zkv.x) * bflo(r.zkv.x) + bfhi(r.zkv.x) * bfhi(r.zkv.x) + bflo(r.zkv.y) * bflo(r.zkv.y) + bfhi(r.zkv.y) * bfhi(r.zkv.y);
      rkv = 1.0f / sqrtf(wave_sum(ss) * (1.0f / 256.0f) + EPS); }
    { float x = bf2f((unsigned short)r.zkr); const float rr = 1.0f / sqrtf(wave_sum(x * x) * (1.0f / 64.0f) + EPS); x = x * rr * g.kr;
      const float other = __shfl_xor(x, 32); const float o = (lane < 32) ? (x * r.ck - other * r.sk) : (x * r.ck + other * r.sk);
#if ATT_FP8
      ((unsigned char*)KR)[(size_t)t * 64 + lane] = (unsigned char)(pk4_fp8(o, o, o, o) & 0xffu); }
#else
      KR[(size_t)t * 64 + lane] = f2bf(o); }
#endif
    { float x[16]; UNPK8(r.qn0, x, 0); UNPK8(r.qn1, x, 8); float ss = 0.f;
#pragma unroll
      for (int i = 0; i < 16; ++i) { x[i] *= rq; ss += x[i] * x[i]; }
      ss += __shfl_xor(ss, 1); ss += __shfl_xor(ss, 2); ss += __shfl_xor(ss, 4);
      const float rr = 1.0f / sqrtf(ss * (1.0f / 128.0f) + EPS); unsigned o[8];
#pragma unroll
#if ATT_FP8
      for (int i = 0; i < 16; ++i) x[i] = x[i] * rr * g.qn[i];
      (void)o;
      *(u32x4*)((unsigned char*)Q + ((size_t)((b * NH + h) * SEQ + l)) * 192 + s * 16) = (u32x4){pk4_fp8(x[0], x[1], x[2], x[3]), pk4_fp8(x[4], x[5], x[6], x[7]), pk4_fp8(x[8], x[9], x[10], x[11]), pk4_fp8(x[12], x[13], x[14], x[15])}; }
#else
      for (int i = 0; i < 8; ++i) o[i] = cvt_pk_bf16(x[2 * i] * rr * g.qn[2 * i], x[2 * i + 1] * rr * g.qn[2 * i + 1]);
      bf16_t* dst = Q + ((size_t)((b * NH + h) * SEQ + l)) * 192 + s * 16;
      *(u32x4*)dst = (u32x4){o[0], o[1], o[2], o[3]}; *(u32x4*)(dst + 8) = (u32x4){o[4], o[5], o[6], o[7]}; }
#endif
    { float x[8]; UNPK8(r.qr, x, 0); float ss = 0.f;
#pragma unroll
      for (int i = 0; i < 8; ++i) { x[i] *= rq; ss += x[i] * x[i]; }
      ss += __shfl_xor(ss, 1); ss += __shfl_xor(ss, 2); ss += __shfl_xor(ss, 4);
      const float rr = 1.0f / sqrtf(ss * (1.0f / 64.0f) + EPS); float y[8];
      const float cs[8] = {r.cq0[0], r.cq0[1], r.cq0[2], r.cq0[3], r.cq1[0], r.cq1[1], r.cq1[2], r.cq1[3]}, sn[8] = {r.sq0[0], r.sq0[1], r.sq0[2], r.sq0[3], r.sq1[0], r.sq1[1], r.sq1[2], r.sq1[3]};
#pragma unroll
      for (int i = 0; i < 8; ++i) x[i] = x[i] * rr * g.qr[i];
#pragma unroll
      for (int i = 0; i < 8; ++i) { const float other = __shfl_xor(x[i], 4); y[i] = (s < 4) ? (x[i] * cs[i] - other * sn[i]) : (x[i] * cs[i] + other * sn[i]); }
#if ATT_FP8
      *(u32x2*)((unsigned char*)Q + ((size_t)((b * NH + h) * SEQ + l)) * 192 + 128 + s * 8) = (u32x2){pk4_fp8(y[0], y[1], y[2], y[3]), pk4_fp8(y[4], y[5], y[6], y[7])}; }
#else
      bf16_t* dst = Q + ((size_t)((b * NH + h) * SEQ + l)) * 192 + 128 + s * 8;
      *(u32x4*)dst = (u32x4){cvt_pk_bf16(y[0], y[1]), cvt_pk_bf16(y[2], y[3]), cvt_pk_bf16(y[4], y[5]), cvt_pk_bf16(y[6], y[7])}; }
#endif
    { float x[16]; UNPK8(r.kn0, x, 0); UNPK8(r.kn1, x, 8); float ss = 0.f;
#pragma unroll
      for (int i = 0; i < 16; ++i) { x[i] *= rkv; ss += x[i] * x[i]; }
      ss += __shfl_xor(ss, 1); ss += __shfl_xor(ss, 2); ss += __shfl_xor(ss, 4);
      const float rr = 1.0f / sqrtf(ss * (1.0f / 128.0f) + EPS); unsigned o[8];
#pragma unroll
#if ATT_FP8
      for (int i = 0; i < 16; ++i) x[i] = x[i] * rr * g.kn[i];
      (void)o;
      *(u32x4*)((unsigned char*)KN + ((size_t)((b * NH + h) * SEQ + l)) * 128 + s * 16) = (u32x4){pk4_fp8(x[0], x[1], x[2], x[3]), pk4_fp8(x[4], x[5], x[6], x[7]), pk4_fp8(x[8], x[9], x[10], x[11]), pk4_fp8(x[12], x[13], x[14], x[15])}; }
#else
      for (int i = 0; i < 8; ++i) o[i] = cvt_pk_bf16(x[2 * i] * rr * g.kn[2 * i], x[2 * i + 1] * rr * g.kn[2 * i + 1]);
      bf16_t* dst = KN + ((size_t)((b * NH + h) * SEQ + l)) * 128 + s * 16;
      *(u32x4*)dst = (u32x4){o[0], o[1], o[2], o[3]}; *(u32x4*)(dst + 8) = (u32x4){o[4], o[5], o[6], o[7]}; }
#endif
#if ATT_PV8
    { const unsigned ww[8] = {r.v0[0], r.v0[1], r.v0[2], r.v0[3], r.v1[0], r.v1[1], r.v1[2], r.v1[3]}; unsigned q8[4];
#pragma unroll
      for (int i = 0; i < 4; ++i) q8[i] = pk4_fp8(bflo(ww[2 * i]) * rkv, bfhi(ww[2 * i]) * rkv, bflo(ww[2 * i + 1]) * rkv, bfhi(ww[2 * i + 1]) * rkv);
      const int k = t & 63, slot = 2 * ((k >> 2) & 1) + (k >> 5), bis = (k & 3) + 4 * ((k & 31) >> 3);
#pragma unroll
      for (int j = 0; j < 16; ++j) { const int d = s * 16 + j; vtile[(h * 128 + d) * 64 + ((slot ^ ((d >> 2) & 3)) << 4) + bis] = (unsigned char)((q8[j >> 2] >> (8 * (j & 3))) & 0xffu); } }
#else
    { unsigned o[8]; const unsigned ww[8] = {r.v0.x, r.v0.y, r.v0.z, r.v0.w, r.v1.x, r.v1.y, r.v1.z, r.v1.w};
#pragma unroll
      for (int i = 0; i < 8; ++i) o[i] = cvt_pk_bf16(bflo(ww[i]) * rkv, bfhi(ww[i]) * rkv);
      bf16_t* dst = V + ((size_t)((b * NH + h) * SEQ + l)) * 128 + s * 16;
      *(u32x4*)dst = (u32x4){o[0], o[1], o[2], o[3]}; *(u32x4*)(dst + 8) = (u32x4){o[4], o[5], o[6], o[7]}; }
    (void)vtile;
#endif
}

struct MixRaw { u32x4 s0, s1; f32x4 m[4]; };
__device__ __forceinline__ MixRaw p6_load(int t, int lane, const bf16_t* __restrict__ YS, const float* __restrict__ YM) {
    MixRaw r; const bf16_t* ys = YS + (size_t)t * 1024 + lane * 16; r.s0 = __builtin_nontemporal_load((const u32x4*)ys); r.s1 = __builtin_nontemporal_load((const u32x4*)(ys + 8));
    const float* ym = YM + (size_t)t * 1024 + lane * 16;
#pragma unroll
    for (int j = 0; j < 4; ++j) r.m[j] = __builtin_nontemporal_load((const f32x4*)(ym + 4 * j));
    return r;
}
__device__ __forceinline__ void p6_proc(int t, int lane, const MixRaw& r, bf16_t* __restrict__ MIX) {
    float x[16]; UNPK8(r.s0, x, 0); UNPK8(r.s1, x, 8);
    float ss = 0.f, sm = 0.f;
#pragma unroll
    for (int i = 0; i < 16; ++i) ss += x[i] * x[i];
#pragma unroll
    for (int j = 0; j < 4; ++j) sm += (r.m[j][0] * r.m[j][0] + r.m[j][1] * r.m[j][1]) + (r.m[j][2] * r.m[j][2] + r.m[j][3] * r.m[j][3]);
    const float rs = 1.0f / sqrtf(wave_sum(ss) * (1.0f / 1024.0f) + EPS), rm = 1.0f / sqrtf(wave_sum(sm) * (1.0f / 1024.0f) + EPS);
#if OUT_FP8
    unsigned char* d0 = (unsigned char*)MIX + (size_t)t * 2048 + lane * 16;
    *(u32x4*)d0 = (u32x4){pk4_fp8(x[0] * rs, x[1] * rs, x[2] * rs, x[3] * rs), pk4_fp8(x[4] * rs, x[5] * rs, x[6] * rs, x[7] * rs), pk4_fp8(x[8] * rs, x[9] * rs, x[10] * rs, x[11] * rs), pk4_fp8(x[12] * rs, x[13] * rs, x[14] * rs, x[15] * rs)};
    *(u32x4*)(d0 + 1024) = (u32x4){pk4_fp8(r.m[0][0] * rm, r.m[0][1] * rm, r.m[0][2] * rm, r.m[0][3] * rm), pk4_fp8(r.m[1][0] * rm, r.m[1][1] * rm, r.m[1][2] * rm, r.m[1][3] * rm),
                                   pk4_fp8(r.m[2][0] * rm, r.m[2][1] * rm, r.m[2][2] * rm, r.m[2][3] * rm), pk4_fp8(r.m[3][0] * rm, r.m[3][1] * rm, r.m[3][2] * rm, r.m[3][3] * rm)};
#else
    bf16_t* d0 = MIX + (size_t)t * 2048 + lane * 16; unsigned o[8];
#pragma unroll
    for (int i = 0; i < 8; ++i) o[i] = cvt_pk_bf16(x[2 * i] * rs, x[2 * i + 1] * rs);
    *(u32x4*)d0 = (u32x4){o[0], o[1], o[2], o[3]}; *(u32x4*)(d0 + 8) = (u32x4){o[4], o[5], o[6], o[7]};
    bf16_t* d1 = d0 + 1024;
#pragma unroll
    for (int j = 0; j < 4; ++j) { o[2 * j] = cvt_pk_bf16(r.m[j][0] * rm, r.m[j][1] * rm); o[2 * j + 1] = cvt_pk_bf16(r.m[j][2] * rm, r.m[j][3] * rm); }
    *(u32x4*)d1 = (u32x4){o[0], o[1], o[2], o[3]}; *(u32x4*)(d1 + 8) = (u32x4){o[4], o[5], o[6], o[7]};
#endif
}

__device__ __forceinline__ void p8_group(int grp, int lane, LAS float* wl  , const bf16_t* __restrict__ X1, const float* __restrict__ FA2, const float* __restrict__ FB2,
                                         const bf16_t* __restrict__ WRT_HI, const bf16_t* __restrict__ WRT_LO, const float* __restrict__ b_router, unsigned char* __restrict__ H8,
                                         int* __restrict__ RIDX, float* __restrict__ RGATE, int* __restrict__ RPOS, unsigned* __restrict__ CNT) {
    const int t0 = grp * 16, b = t0 >> 14, fr = lane & 15, fq = lane >> 4;
    float rstd_mine = 0.f;
    { f32x4 fa[4][2], fb[4][2];
#pragma unroll
      for (int j = 0; j < 4; ++j)
#pragma unroll
        for (int q = 0; q < 2; ++q) { fa[j][q] = *(const f32x4*)(FA2 + b * 2048 + 8 * lane + 512 * j + 4 * q); fb[j][q] = *(const f32x4*)(FB2 + b * 2048 + 8 * lane + 512 * j + 4 * q); }
#pragma unroll 1
      for (int i = 0; i < 16; i += 4) { constexpr int HB = MOE_FP8 ? 2048 : 4096;
          const RowRawB r0 = hnorm_b_load(X1 + (size_t)(t0 + i) * 2048, lane), r1 = hnorm_b_load(X1 + (size_t)(t0 + i + 1) * 2048, lane), r2 = hnorm_b_load(X1 + (size_t)(t0 + i + 2) * 2048, lane), r3 = hnorm_b_load(X1 + (size_t)(t0 + i + 3) * 2048, lane);
          const float q0 = hnorm_b_proc(r0, H8 + (size_t)(t0 + i) * HB, fa, fb, lane), q1 = hnorm_b_proc(r1, H8 + (size_t)(t0 + i + 1) * HB, fa, fb, lane), q2 = hnorm_b_proc(r2, H8 + (size_t)(t0 + i + 2) * HB, fa, fb, lane), q3 = hnorm_b_proc(r3, H8 + (size_t)(t0 + i + 3) * HB, fa, fb, lane);
          rstd_mine = (fr == i) ? q0 : (fr == i + 1) ? q1 : (fr == i + 2) ? q2 : (fr == i + 3) ? q3 : rstd_mine; } }
    f32x4 acc0 = {0.f, 0.f, 0.f, 0.f}, acc1 = {0.f, 0.f, 0.f, 0.f};
    const bf16_t* xrow = X1 + (size_t)(t0 + fr) * 2048 + fq * 8;
    const float* fap = FA2 + b * 2048 + fq * 8; const float* fbp = FB2 + b * 2048 + fq * 8;
    const bf16_t* wh0 = WRT_HI + (size_t)fr * 2048 + fq * 8; const bf16_t* wl0 = WRT_LO + (size_t)fr * 2048 + fq * 8;
#pragma unroll 4
    for (int ks = 0; ks < 64; ++ks) {
        const u32x4 xw = *(const u32x4*)(xrow + ks * 32); const f32x4 x0 = {bflo(xw.x), bfhi(xw.x), bflo(xw.y), bfhi(xw.y)}, x1 = {bflo(xw.z), bfhi(xw.z), bflo(xw.w), bfhi(xw.w)};
        const f32x4 a0 = *(const f32x4*)(fap + ks * 32), a1 = *(const f32x4*)(fap + ks * 32 + 4), c0 = *(const f32x4*)(fbp + ks * 32), c1 = *(const f32x4*)(fbp + ks * 32 + 4);
        const f32x4 h0 = x0 * rstd_mine * a0 + c0, h1 = x1 * rstd_mine * a1 + c1;
        u32x4 hh; hh.x = cvt_pk_bf16(h0[0], h0[1]); hh.y = cvt_pk_bf16(h0[2], h0[3]); hh.z = cvt_pk_bf16(h1[0], h1[1]); hh.w = cvt_pk_bf16(h1[2], h1[3]);
        u32x4 hl; hl.x = cvt_pk_bf16(h0[0] - bflo(hh.x), h0[1] - bfhi(hh.x)); hl.y = cvt_pk_bf16(h0[2] - bflo(hh.y), h0[3] - bfhi(hh.y));
        hl.z = cvt_pk_bf16(h1[0] - bflo(hh.z), h1[1] - bfhi(hh.z)); hl.w = cvt_pk_bf16(h1[2] - bflo(hh.w), h1[3] - bfhi(hh.w));
        const bf16x8 hhi = *reinterpret_cast<bf16x8*>(&hh), hlo = *reinterpret_cast<bf16x8*>(&hl);
        const bf16x8 whi0 = *(const bf16x8*)(wh0 + ks * 32), wlo0 = *(const bf16x8*)(wl0 + ks * 32);
        const bf16x8 whi1 = *(const bf16x8*)(wh0 + 16 * 2048 + ks * 32), wlo1 = *(const bf16x8*)(wl0 + 16 * 2048 + ks * 32);
        acc0 = __builtin_amdgcn_mfma_f32_16x16x32_bf16(whi0, hhi, acc0, 0, 0, 0); acc0 = __builtin_amdgcn_mfma_f32_16x16x32_bf16(wlo0, hhi, acc0, 0, 0, 0); acc0 = __builtin_amdgcn_mfma_f32_16x16x32_bf16(whi0, hlo, acc0, 0, 0, 0);
        acc1 = __builtin_amdgcn_mfma_f32_16x16x32_bf16(whi1, hhi, acc1, 0, 0, 0); acc1 = __builtin_amdgcn_mfma_f32_16x16x32_bf16(wlo1, hhi, acc1, 0, 0, 0); acc1 = __builtin_amdgcn_mfma_f32_16x16x32_bf16(whi1, hlo, acc1, 0, 0, 0);
    }
    LAS float* lg = wl; LAS unsigned* hist = (LAS unsigned*)(wl + 16 * 33); LAS unsigned* basel = hist + 32;
#pragma unroll
    for (int e = 0; e < 4; ++e) { lg[fr * 33 + 4 * fq + e] = acc0[e] + b_router[4 * fq + e]; lg[fr * 33 + 16 + 4 * fq + e] = acc1[e] + b_router[16 + 4 * fq + e]; }
    if (lane < 32) hist[lane] = 0u;
    LDS_FENCE();
    int ie[4] = {0, 0, 0, 0}; float gt[4] = {0.f, 0.f, 0.f, 0.f}; unsigned rk[4] = {0u, 0u, 0u, 0u};
    if (lane < 16) {
        float v0 = -3.0e38f, v1 = -3.0e38f, v2 = -3.0e38f, v3 = -3.0e38f; int i0 = 0, i1 = 0, i2 = 0, i3 = 0;
#pragma unroll 4
        for (int e = 0; e < 32; ++e) { const float x = lg[lane * 33 + e];
            if (x > v0) { v3 = v2; i3 = i2; v2 = v1; i2 = i1; v1 = v0; i1 = i0; v0 = x; i0 = e; }
            else if (x > v1) { v3 = v2; i3 = i2; v2 = v1; i2 = i1; v1 = x; i1 = e; }
            else if (x > v2) { v3 = v2; i3 = i2; v2 = x; i2 = e; }
            else if (x > v3) { v3 = x; i3 = e; } }
        const float e1 = __expf(v1 - v0), e2 = __expf(v2 - v0), e3 = __expf(v3 - v0), inv = 1.0f / (1.0f + e1 + e2 + e3);
        ie[0] = i0; ie[1] = i1; ie[2] = i2; ie[3] = i3; gt[0] = inv; gt[1] = e1 * inv; gt[2] = e2 * inv; gt[3] = e3 * inv;
#pragma unroll
        for (int k = 0; k < 4; ++k) rk[k] = __hip_atomic_fetch_add((LAS unsigned*)&hist[ie[k]], 1u, __ATOMIC_RELAXED, __HIP_MEMORY_SCOPE_WORKGROUP);
    }
    LDS_FENCE();
    if (lane < 32) { const unsigned cnt = hist[lane]; unsigned base = 0u; if (cnt) base = __hip_atomic_fetch_add(CNT + lane, cnt, __ATOMIC_RELAXED, __HIP_MEMORY_SCOPE_AGENT); basel[lane] = base; }
    LDS_FENCE();
    if (lane < 16) { const int t = t0 + lane;
#pragma unroll
        for (int k = 0; k < 4; ++k) { RIDX[t * 4 + k] = ie[k]; RGATE[t * 4 + k] = gt[k]; RPOS[t * 4 + k] = (int)(basel[ie[k]] + rk[k]); } }
    LDS_FENCE();
}

__device__ __forceinline__ void moe_tables(const Ctx& c, const unsigned* __restrict__ CNT, volatile LAS int* tab) {
    if (c.tid < 64) { const int e = c.tid & 31;
        const int n = (int)__hip_atomic_load(CNT + e, __ATOMIC_RELAXED, __HIP_MEMORY_SCOPE_AGENT); const int nb = (n + 255) >> 8;
        int incl = nb;
#pragma unroll
        for (int d = 1; d < 32; d <<= 1) { const int t = __shfl_up(incl, d, 32); if (e >= d) incl += t; }
        if (c.tid < 32) { const int excl = incl - nb; tab[e] = nb; tab[32 + e] = excl; tab[96 + e] = n; if (e == 31) tab[64] = incl;
            for (int i = 0; i < nb; ++i) tab[128 + excl + i] = e; } }
    __syncthreads();
}

__device__ const float INVF[32] = {1.0f, 0.7498942017555237f, 0.5623413324356079f, 0.4216965138912201f, 0.3162277638912201f, 0.23713737726211548f, 0.17782793939113617f, 0.1333521455526352f, 0.10000000149011612f, 0.0749894231557846f, 0.05623413249850273f, 0.04216964915394783f, 0.03162277489900589f, 0.023713737726211548f, 0.017782794311642647f, 0.013335213996469975f, 0.009999999776482582f, 0.007498942315578461f, 0.005623413249850273f, 0.0042169648222625256f, 0.003162277629598975f, 0.0023713738191872835f, 0.0017782794311642647f, 0.0013335214462131262f, 0.0010000000474974513f, 0.0007498941849917173f, 0.000562341301701963f, 0.0004216965171508491f, 0.0003162277571391314f, 0.00023713737027719617f, 0.00017782794020604342f, 0.0001333521504420787f};

struct Args { const void* in[33]; float* out; unsigned char* ws; int ph_lo, ph_hi; };

__global__ void __launch_bounds__(512, 2) mk_fwd(Args a) {
    extern __shared__ __attribute__((aligned(16))) unsigned char lds_raw[];
    Ctx c; c.lds = (LAS unsigned char*)lds_raw; c.tid = threadIdx.x; c.lane = c.tid & 63; c.wave = __builtin_amdgcn_readfirstlane(c.tid >> 6); c.G = gridDim.x;
    { const int bx = blockIdx.x; c.vcu = (c.G % 8 == 0) ? (bx % 8) * (c.G / 8) + bx / 8 : bx; }
    volatile LAS unsigned* MISC = (volatile LAS unsigned*)(c.lds + MISC_OFF);
    for (int u = c.tid; u < 1024; u += 512) MISC[u] = 0u;
    __syncthreads();
    unsigned char* ws = a.ws;
    unsigned* ctl = (unsigned*)(ws + WS_CTL);
    volatile LAS int* tab = (volatile LAS int*)(c.lds + MISC_OFF + 256);
#if MK_N_LAUNCHES == 1
    XcdBarrier bar = xcd_barrier_post(ctl + CW_BAR, MISC);
#define GRID_BAR() xcd_barrier(bar)
#else
#define GRID_BAR() do { } while (0)
#endif
    const int lo = a.ph_lo, hi = a.ph_hi;
#ifndef PHASE_MASK
#define PHASE_MASK 0xFFFF
#endif
#define IN(k) ((((PHASE_MASK) >> (k)) & 1) && lo <= (k) && (k) < hi)
#define BOTH(k) (IN(k) && IN((k) + 1))
#ifndef PROBE_ATT
#ifndef PROBE_ABL
#define PROBE_ABL 0
#endif
#ifndef PROBE_GU
#define PROBE_GU 0
#endif
#define PROBE_ATT 1
#endif
#ifndef PROBE_DUP
#define PROBE_DUP 0
#endif
#define NREP(k) (1 + (((PROBE_DUP) >> (k)) & 1))
#define REP_BEGIN(k) _Pragma("unroll 1") for (int rep_ = 0; rep_ < NREP(k); ++rep_) {
#define REP_END(k) if (rep_ + 1 < NREP(k)) GRID_BAR(); }
    const int gw = c.vcu * 8 + c.wave, NGW = c.G * 8, gtid = c.vcu * 512 + c.tid, NTHR = c.G * 512, lane = c.lane;
    const float* x = (const float*)a.in[0]; const float* cvec = (const float*)a.in[1]; const int* positions = (const int*)a.in[2];
    const float* w_ada = (const float*)a.in[3]; const float* b_ada = (const float*)a.in[4]; const float* norm_mix_g = (const float*)a.in[5]; const float* w_in = (const float*)a.in[6];
    const float* ssm_A_re = (const float*)a.in[7]; const float* ssm_A_im = (const float*)a.in[8]; const float* ssm_B_re = (const float*)a.in[9]; const float* ssm_B_im = (const float*)a.in[10];
    const float* ssm_C_re = (const float*)a.in[11]; const float* ssm_C_im = (const float*)a.in[12]; const float* ssm_D = (const float*)a.in[13]; const float* ssm_log_dt = (const float*)a.in[14];
    const float* q_lat_g = (const float*)a.in[15]; const float* kv_lat_g = (const float*)a.in[16]; const float* w_uq = (const float*)a.in[17]; const float* w_ukv = (const float*)a.in[18];
    const float* q_nope_g = (const float*)a.in[19]; const float* q_rope_g = (const float*)a.in[20]; const float* k_nope_g = (const float*)a.in[21]; const float* k_rope_g = (const float*)a.in[22];
    const float* out_ssm_g = (const float*)a.in[23]; const float* out_mla_g = (const float*)a.in[24]; const float* w_out = (const float*)a.in[25]; const float* norm_ffn_g = (const float*)a.in[26];
    const float* w_router = (const float*)a.in[27]; const float* b_router = (const float*)a.in[28]; const float* w_gate_up = (const float*)a.in[29]; const float* b_gate_up = (const float*)a.in[30];
    const float* w_down = (const float*)a.in[31]; const float* b_down = (const float*)a.in[32];
    float* out = a.out;
    float* MOD = (float*)(ws + WS_MOD); float* FA2 = (float*)(ws + WS_FAB2); float* FB2 = FA2 + 4096;
    float* APOW = (float*)(ws + WS_APOW); float* A64 = (float*)(ws + WS_A64); float* A1024 = (float*)(ws + WS_A1024); float* BB = (float*)(ws + WS_BB); float* KC = (float*)(ws + WS_KC);
    float* COS = (float*)(ws + WS_COS); float* SIN = (float*)(ws + WS_SIN);
    int* RIDX = (int*)(ws + WS_RIDX); float* RGATE = (float*)(ws + WS_RGATE); int* RPOS = (int*)(ws + WS_RPOS); int* SLOT = (int*)(ws + WS_SLOT); float* ROWGATE = (float*)(ws + WS_ROWGATE);
    bf16_t* WRT_HI = (bf16_t*)(ws + WS_WRT); bf16_t* WRT_LO = WRT_HI + 32 * 2048;
    bf16_t* WUQ = (bf16_t*)(ws + WS_WUQ); bf16_t* WUKV = (bf16_t*)(ws + WS_WUKV); bf16_t* WIN = (bf16_t*)(ws + WS_WIN); bf16_t* WOUT = (bf16_t*)(ws + WS_WOUT); bf16_t* WG = (bf16_t*)(ws + WS_WG);
    float* SEND = (float*)(ws + WS_SEND); bf16_t* KR = (bf16_t*)(ws + WS_KR); bf16_t* BTG = (bf16_t*)(ws + WS_BTG); bf16_t* AG = (bf16_t*)(ws + WS_AG); bf16_t* GS = (bf16_t*)(ws + WS_GS);
    bf16_t* Z2 = (bf16_t*)(ws + WS_Z2); bf16_t* H = (bf16_t*)(ws + WS_H); bf16_t* QRAW = (bf16_t*)(ws + WS_QRAW); bf16_t* KVRAW = (bf16_t*)(ws + WS_KVRAW);
    bf16_t* Q = (bf16_t*)(ws + WS_Q); bf16_t* KN = (bf16_t*)(ws + WS_KN); bf16_t* V = (bf16_t*)(ws + WS_V); bf16_t* YS = (bf16_t*)(ws + WS_YS); float* YM = (float*)(ws + WS_YM); bf16_t* MIX = (bf16_t*)(ws + WS_MIX);
    unsigned char* WGU = ws + WS_WGU; unsigned char* WDN = ws + WS_WDN; unsigned char* ACT = ws + WS_ACT; unsigned char* YB = ws + WS_YB; bf16_t* X1B = (bf16_t*)(ws + WS_YM);     unsigned char* XS = ws + WS_XS; unsigned char* H8 = ws + WS_H;
    unsigned* CNT = ctl + CW_CNT;

    if (IN(0)) {
        REP_BEGIN(0)
        for (int it = c.vcu; it < 192; it += c.G) p0_mod_chunk(c, it, cvec, w_ada, b_ada, MOD);
        for (int it = c.vcu; it < 256; it += c.G) p0_kc_item(c, it, ssm_A_re, ssm_A_im, ssm_B_re, ssm_B_im, ssm_C_re, ssm_C_im, ssm_D, ssm_log_dt, KC, BB);
        for (int i = gtid; i < 64 * 65 * 64; i += NTHR) { const int g = i / 4160, k = (i >> 6) % 65, p = i & 63; const float dt = expf(ssm_log_dt[g]), are = ssm_A_re[g * 64 + p], aim = ssm_A_im[g * 64 + p];
            float cs, sn; sincos_d((double)k * (double)dt * (double)aim, cs, sn); const float ex = expf((float)k * dt * are); APOW[2 * (size_t)i] = ex * cs; APOW[2 * (size_t)i + 1] = ex * sn; }
        for (int i = gtid; i < 4096; i += NTHR) { const int g = i >> 6; const float dt = expf(ssm_log_dt[g]), are = ssm_A_re[i], aim = ssm_A_im[i]; float cs, sn;
            sincos_d(64.0 * (double)dt * (double)aim, cs, sn); float ex = expf(64.0f * dt * are); A64[2 * i] = ex * cs; A64[2 * i + 1] = ex * sn;
            sincos_d(1024.0 * (double)dt * (double)aim, cs, sn); ex = expf(1024.0f * dt * are); A1024[2 * i] = ex * cs; A1024[2 * i + 1] = ex * sn; }
        for (int i = gtid; i < NTOK * 32; i += NTHR) { const int t = i >> 5, k = i & 31; const float ang = (float)positions[t] * INVF[k]; float cs, sn; sincos_d((double)ang, cs, sn); COS[i] = cs; SIN[i] = sn; }
        { const u32x4 z4 = {0u, 0u, 0u, 0u};
          u32x4* zw = (u32x4*)(WIN + (size_t)DIN * 2048); for (int i = gtid; i < (DINP - DIN) * 2048 / 8; i += NTHR) zw[i] = z4;
          for (int i = gtid; i < 64 * 128 * 1024 / 8; i += NTHR) { const int g = i >> 14, r = i & 16383; ((u32x4*)(WG + ((size_t)g * 256 + 128) * 1024))[r] = z4; } }
        for (int i = gtid; i < 32 * 2048; i += NTHR) { const int e = i >> 11, k = i & 2047; const float w = w_router[k * 32 + e]; const unsigned short hb = f2bf(w); WRT_HI[i] = hb; WRT_LO[i] = f2bf(w - bf2f(hb)); }
                constexpr int I_IN = 32 * 45, I_UQ = 8 * 24, I_UKV = 4 * 32, I_OUT = 32 * 32;
        constexpr int NIT = I_IN + I_UQ + I_UKV + I_OUT;
        for (int it = gw; it < NIT; it += NGW) {
            int r = it;
            if (r < I_IN) { tr_item<0>(w_in, DIN, nullptr, WIN, 2048, r / 45, r % 45, lane); continue; } r -= I_IN;
#if OUT_FP8
            if (r < I_OUT) { if (r < 16 * 32) { const int kb = r / 32; tr_item8<0>(w_out, 2048, (unsigned char*)WOUT, 2048, kb, r % 32, lane, kb < 8 ? out_ssm_g : out_mla_g - 1024); } continue; } r -= I_OUT;
#else
            if (r < I_OUT) { const int kb = r / 32; tr_item<0>(w_out, 2048, kb < 16 ? out_ssm_g : out_mla_g - 1024, WOUT, 2048, kb, r % 32, lane); continue; } r -= I_OUT;
#endif
            if (r < I_UQ) { tr_item<1>(w_uq, 1536, q_lat_g, WUQ, 1024, r / 24, r % 24, lane); continue; } r -= I_UQ;
            tr_item<0>(w_ukv, 2048, kv_lat_g, WUKV, 1024, r / 32, r % 32, lane);
        }
        REP_END(0)
        if (BOTH(0)) GRID_BAR();
    }
    if (IN(1)) {
        REP_BEGIN(1)
#pragma unroll 1
        for (int b = 0; b < 2; ++b) { f32x4 fa[8], fb[8];
#pragma unroll
            for (int j = 0; j < 8; ++j) { const int col = 4 * lane + 256 * j; const f32x4 g4 = *(const f32x4*)(norm_mix_g + col), sc4 = *(const f32x4*)(MOD + b * 12288 + 2048 + col); fa[j] = g4 * (1.0f + sc4); fb[j] = *(const f32x4*)(MOD + b * 12288 + col); }
#pragma unroll 1
            for (int row = b * SEQ + gw; row < (b + 1) * SEQ; row += 2 * NGW) { const int row1 = row + NGW; const bool two = row1 < (b + 1) * SEQ;
                const RowRaw ra = hnorm_load(x + (size_t)row * 2048, lane), rb = hnorm_load(x + (size_t)(two ? row1 : row) * 2048, lane);
                (void)hnorm_proc(ra, H + (size_t)row * 2048, fa, fb, lane); if (two) (void)hnorm_proc(rb, H + (size_t)row1 * 2048, fa, fb, lane); } }
        for (int i = gtid; i < 4096; i += NTHR) { const int b = i >> 11, k = i & 2047; FA2[i] = norm_ffn_g[k] * (1.0f + MOD[b * 12288 + 8192 + k]); FB2[i] = MOD[b * 12288 + 6144 + k]; }
        for (int i = gtid; i < 64 * 64 * 16 * 64 * 2; i += NTHR) { const int hh8 = i & 1, j = (i >> 1) & 63, h = (i >> 7) & 15, l = (i >> 11) & 63, g = i >> 17;
            if (j >= 16 * ((l >> 4) + 1)) continue;
            u32x4 w = {0u, 0u, 0u, 0u};
            if (j <= l) { const float* src = KC + ((size_t)(g * 64 + (l - j)) * 16 + h) * 16 + hh8 * 8; const f32x4 k0 = *(const f32x4*)src, k1 = *(const f32x4*)(src + 4);
                w.x = cvt_pk_bf16(k0[0], k0[1]); w.y = cvt_pk_bf16(k0[2], k0[3]); w.z = cvt_pk_bf16(k1[0], k1[1]); w.w = cvt_pk_bf16(k1[2], k1[3]); }
            *(u32x4*)(BTG + ((size_t)(g * 1024 + l * 16 + h)) * AGW + 128 + j * 16 + hh8 * 8) = w; }
        for (int i = gtid; i < 64 * 64 * 16 * 16; i += NTHR) { const int cg = i & 15, h = (i >> 4) & 15, l = (i >> 8) & 63, g = i >> 14, part = cg >> 3, p0 = (cg & 7) * 8; float v[8];
#pragma unroll
            for (int e = 0; e < 8; ++e) { const int p = p0 + e; const float cr = ssm_C_re[(g * 16 + h) * 64 + p], ci = ssm_C_im[(g * 16 + h) * 64 + p]; const float ar = APOW[((size_t)(g * 65 + l + 1) * 64 + p) * 2], ai = APOW[((size_t)(g * 65 + l + 1) * 64 + p) * 2 + 1];
                v[e] = part ? -(cr * ai + ci * ar) : (cr * ar - ci * ai); }
            u32x4 w; w.x = cvt_pk_bf16(v[0], v[1]); w.y = cvt_pk_bf16(v[2], v[3]); w.z = cvt_pk_bf16(v[4], v[5]); w.w = cvt_pk_bf16(v[6], v[7]);
            *(u32x4*)(BTG + ((size_t)(g * 1024 + l * 16 + h)) * AGW + cg * 8) = w; }
        for (int i = gtid; i < 64 * 128 * 64 * 2; i += NTHR) { const int hh8 = i & 1, j = (i >> 1) & 63, prow = (i >> 7) & 127, g = i >> 14, p = prow & 63, part = prow >> 6;
            const float ar = APOW[((size_t)(g * 65 + 63 - j) * 64 + p) * 2], ai = APOW[((size_t)(g * 65 + 63 - j) * 64 + p) * 2 + 1]; float v[8];
#pragma unroll
            for (int e = 0; e < 8; ++e) { const float br = BB[((size_t)(g * 64 + p) * 16 + hh8 * 8 + e) * 2], bi = BB[((size_t)(g * 64 + p) * 16 + hh8 * 8 + e) * 2 + 1]; v[e] = part ? (ar * bi + ai * br) : (ar * br - ai * bi); }
            u32x4 w; w.x = cvt_pk_bf16(v[0], v[1]); w.y = cvt_pk_bf16(v[2], v[3]); w.z = cvt_pk_bf16(v[4], v[5]); w.w = cvt_pk_bf16(v[6], v[7]);
            *(u32x4*)(WG + ((size_t)(g * 256 + prow)) * 1024 + j * 16 + hh8 * 8) = w; }
        REP_END(1)
        if (BOTH(1)) GRID_BAR();
    }
    if (IN(2)) {
        REP_BEGIN(2)
        SchedDense S{(const char*)H, (const char*)WIN, 4096u, 4096u, 128, 12, 32, c.G, (int)blockIdx.x}; EpiZ E{AG, GS, Z2};
        pg8::gemm_phase<EpiZ, SchedDense>(c.lds, 4096u, 4096u, S, E);
        REP_END(2)
        if (BOTH(2)) GRID_BAR();
    }
    if (IN(3)) {
        REP_BEGIN(3)
        SchedP3 S{(const char*)AG, (const char*)WG, (const char*)Z2, (const char*)WUQ, (const char*)WUKV, c.G, (int)blockIdx.x}; EpiP3 E{QRAW, KVRAW, SEND};
        pg8::gemm_phase<EpiP3, SchedP3>(c.lds, (unsigned)(AGW * 2), 2048u, S, E);
        REP_END(3)
        if (BOTH(3)) GRID_BAR();
    }
    if (IN(4)) {
        REP_BEGIN(4)
        for (int it = c.vcu; it < 256; it += c.G) p4_carry_item(c, it, SEND, A64, A1024, AG);
        { const QkGain gn = p4_gains(lane, q_nope_g, q_rope_g, k_nope_g, k_rope_g);
#if ATT_PV8
#pragma unroll 1
          for (int tile = c.vcu; tile < NTOK / 64; tile += c.G) {
#pragma unroll 1
              for (int i = 0; i < 8; i += 2) { const int t = tile * 64 + c.wave * 8 + i;
                  const QkRaw ra = p4_load(t, lane, Z2, QRAW, KVRAW, COS, SIN), rb = p4_load(t + 1, lane, Z2, QRAW, KVRAW, COS, SIN);
                  p4_proc(t, lane, ra, gn, Q, KN, V, KR, c.lds); p4_proc(t + 1, lane, rb, gn, Q, KN, V, KR, c.lds); }
              __syncthreads();
              { const int b = tile >> 8, tl = tile & 255; unsigned char* V8T = (unsigned char*)V;
#pragma unroll
                for (int q = 0; q < 8; ++q) { const int o = (c.tid + 512 * q) * 16, h = o >> 13, within = o & 8191;
                    *(u32x4*)(V8T + ((size_t)((b * NH + h) * 256 + tl)) * 8192 + within) = *(const LAS u32x4*)(c.lds + o); } }
              __syncthreads(); }
#else
#pragma unroll 1
          for (int t = gw; t < NTOK; t += 2 * NGW) { const int t1 = t + NGW; const bool two = t1 < NTOK;
              const QkRaw ra = p4_load(t, lane, Z2, QRAW, KVRAW, COS, SIN), rb = p4_load(two ? t1 : t, lane, Z2, QRAW, KVRAW, COS, SIN);
              p4_proc(t, lane, ra, gn, Q, KN, V, KR, c.lds); if (two) p4_proc(t1, lane, rb, gn, Q, KN, V, KR, c.lds); }
#endif
        }
        REP_END(4)
        if (BOTH(4)) GRID_BAR();
    }
    if (IN(5)) {
        REP_BEGIN(5)
#ifndef NO_SSM
        { SchedSsm S{(const char*)AG, (const char*)BTG, c.G, (int)blockIdx.x}; EpiSsm E{GS, YS};
          pg8::gemm_phase<EpiSsm, SchedSsm>(c.lds, (unsigned)(AGW * 2), (unsigned)(AGW * 2), S, E); }
#endif
        __syncthreads();
#ifndef NO_ATT
        { const bool spread = (c.G % 4 == 0); const bool conv = spread ? ((int)blockIdx.x < (c.G >> 1)) : true;
          if (conv) { const int gwc = spread ? (int)blockIdx.x * 8 + c.wave : gw, NGWC = spread ? (c.G >> 1) * 8 : NGW;
#if MOE_FP8
            constexpr int I_GU = 16 * 64, I_DN = 16 * 32;
#else
            constexpr int I_GU = 32 * 64, I_DN = 32 * 32;
#endif
#pragma unroll 1
            for (int it = gwc; it < 32 * (I_GU + I_DN); it += NGWC) {
                if (it < 32 * I_GU) { const int e = it / I_GU, q = it % I_GU;
#if MOE_FP8
                    tr_item8<2>(w_gate_up + (size_t)e * 2048 * 4096, 4096, WGU + (size_t)e * 4096 * 2048, 2048, q / 64, q % 64, lane);
#else
                    tr_item<2>(w_gate_up + (size_t)e * 2048 * 4096, 4096, nullptr, (bf16_t*)WGU + (size_t)e * 4096 * 2048, 2048, q / 64, q % 64, lane);
#endif
                } else { const int r = it - 32 * I_GU, e = r / I_DN, q = r % I_DN;
#if MOE_FP8
                    tr_item8<0>(w_down + (size_t)e * 2048 * 2048, 2048, WDN + (size_t)e * 2048 * 2048, 2048, q / 32, q % 32, lane);
#else
                    tr_item<0>(w_down + (size_t)e * 2048 * 2048, 2048, nullptr, (bf16_t*)WDN + (size_t)e * 2048 * 2048, 2048, q / 32, q % 32, lane);
#endif
                } } } }
#pragma unroll 1
        for (;;) {
            __syncthreads();
            if (c.tid == 0) MISC[16] = __hip_atomic_fetch_add(ctl + CW_ATT, 1u, __ATOMIC_RELAXED, __HIP_MEMORY_SCOPE_AGENT);
            __syncthreads();
            const unsigned u = MISC[16];
            if (u >= 1024u * PROBE_ATT) break;
            const int uu = (int)(u & 1023u), qb = 63 - (uu >> 4), bh = uu & 15, b = bh >> 3, h = bh & 7;
#if ATT_FP8 && ATT_PV8
#if PROBE_ABL
            if (u >= 1024u) att::attn_block9<PROBE_ABL>((const unsigned char*)Q + ((size_t)(b * NH + h) * SEQ + qb * 256) * 192, (const unsigned char*)KN + (size_t)(b * NH + h) * SEQ * 128, (const unsigned char*)V + (size_t)(b * NH + h) * 256 * 8192, (const unsigned char*)KR + (size_t)b * SEQ * 64,
                             YM + ((size_t)(b * SEQ + qb * 256)) * 1024 + h * 128, qb, (char*)lds_raw); else
#endif
            att::attn_block9((const unsigned char*)Q + ((size_t)(b * NH + h) * SEQ + qb * 256) * 192, (const unsigned char*)KN + (size_t)(b * NH + h) * SEQ * 128, (const unsigned char*)V + (size_t)(b * NH + h) * 256 * 8192, (const unsigned char*)KR + (size_t)b * SEQ * 64,
                             YM + ((size_t)(b * SEQ + qb * 256)) * 1024 + h * 128, qb, (char*)lds_raw);
#elif ATT_FP8
            att::attn_block8((const unsigned char*)Q + ((size_t)(b * NH + h) * SEQ + qb * 256) * 192, (const unsigned char*)KN + (size_t)(b * NH + h) * SEQ * 128, V + (size_t)(b * NH + h) * SEQ * 128, (const unsigned char*)KR + (size_t)b * SEQ * 64,
                             YM + ((size_t)(b * SEQ + qb * 256)) * 1024 + h * 128, qb, (char*)lds_raw);
#else
            att::attn_block(Q + ((size_t)(b * NH + h) * SEQ + qb * 256) * 192, KN + (size_t)(b * NH + h) * SEQ * 128, V + (size_t)(b * NH + h) * SEQ * 128, KR + (size_t)b * SEQ * 64,
                            YM + ((size_t)(b * SEQ + qb * 256)) * 1024 + h * 128, qb, (char*)lds_raw);
#endif
        }
#endif
        REP_END(5)
        if (BOTH(5)) GRID_BAR();
    }
    if (IN(6)) {
        REP_BEGIN(6)
#pragma unroll 1
        for (int t = gw; t < NTOK; t += 4 * NGW) { const int t1 = t + NGW, t2 = t + 2 * NGW, t3 = t + 3 * NGW;
            const MixRaw ra = p6_load(t, lane, YS, YM), rb = p6_load(t1 < NTOK ? t1 : t, lane, YS, YM), rc = p6_load(t2 < NTOK ? t2 : t, lane, YS, YM), rd = p6_load(t3 < NTOK ? t3 : t, lane, YS, YM);
            p6_proc(t, lane, ra, MIX); if (t1 < NTOK) p6_proc(t1, lane, rb, MIX); if (t2 < NTOK) p6_proc(t2, lane, rc, MIX); if (t3 < NTOK) p6_proc(t3, lane, rd, MIX); }
        REP_END(6)
        if (BOTH(6)) GRID_BAR();
    }
    if (IN(7)) {
        REP_BEGIN(7)
        constexpr unsigned OB = OUT_FP8 ? 2048u : 4096u;
        SchedDense S{(const char*)MIX, (const char*)WOUT, OB, OB, 128, 8, OUT_FP8 ? 16 : 32, c.G, (int)blockIdx.x}; EpiOut E{x, X1B, MOD};
        pg8::gemm_phase<EpiOut, SchedDense, OUT_FP8 != 0>(c.lds, OB, OB, S, E);
        REP_END(7)
        if (BOTH(7)) GRID_BAR();
    }
    if (IN(8)) {
        REP_BEGIN(8)
        for (int grp = gw; grp < NTOK / 16; grp += NGW) p8_group(grp, lane, (LAS float*)(c.lds + c.wave * 4096), X1B, FA2, FB2, WRT_HI, WRT_LO, b_router, H8, RIDX, RGATE, RPOS, CNT);
        REP_END(8)
        if (BOTH(8)) GRID_BAR();
    }
    if (IN(9)) {
        REP_BEGIN(9)
        moe_tables(c, CNT, tab);
#pragma unroll 1
        for (int t = gw; t < NTOK; t += NGW) { constexpr int RB = MOE_FP8 ? 2048 : 4096;
            const u32x4 ev = *(const u32x4*)(RIDX + t * 4), pv = *(const u32x4*)(RPOS + t * 4); const f32x4 gv = *(const f32x4*)(RGATE + t * 4);
            const u32x4* src = (const u32x4*)(H8 + (size_t)t * RB); u32x4 vv[RB / 1024];
#pragma unroll
            for (int j = 0; j < RB / 1024; ++j) vv[j] = src[lane + 64 * j];
            const int sl[4] = {tab[32 + (int)ev.x] * 256 + (int)pv.x, tab[32 + (int)ev.y] * 256 + (int)pv.y, tab[32 + (int)ev.z] * 256 + (int)pv.z, tab[32 + (int)ev.w] * 256 + (int)pv.w};
#pragma unroll
            for (int k = 0; k < 4; ++k) { u32x4* dst = (u32x4*)(XS + (size_t)sl[k] * RB);
#pragma unroll
                for (int j = 0; j < RB / 1024; ++j) dst[lane + 64 * j] = vv[j]; }
            if (lane == 0) { ROWGATE[sl[0]] = gv[0]; ROWGATE[sl[1]] = gv[1]; ROWGATE[sl[2]] = gv[2]; ROWGATE[sl[3]] = gv[3]; *(u32x4*)(SLOT + t * 4) = (u32x4){(unsigned)sl[0], (unsigned)sl[1], (unsigned)sl[2], (unsigned)sl[3]}; } }
        for (int it = gw; it < 32 * 256; it += NGW) { const int e = it >> 8, r = it & 255, n = tab[96 + e];
            if (n + r < tab[e] * 256) { const int slot = tab[32 + e] * 256 + n + r; constexpr int RB = MOE_FP8 ? 2048 : 4096; u32x4* dst = (u32x4*)(XS + (size_t)slot * RB); const u32x4 z4 = {0u, 0u, 0u, 0u};
#pragma unroll
                for (int j = 0; j < RB / 1024; ++j) dst[lane + 64 * j] = z4;
                if (lane == 0) ROWGATE[slot] = 0.f; } }
        REP_END(9)
        if (BOTH(9)) GRID_BAR();
    }
    if (IN(10)) {
        REP_BEGIN(10)
        moe_tables(c, CNT, tab);
        constexpr unsigned RB = MOE_FP8 ? 2048u : 4096u;
        SchedMoe S{(const char*)XS, (const char*)WGU, tab, 16, c.G, (int)blockIdx.x, (size_t)4096 * RB, RB, MOE_FP8 ? 16 : 32}; EpiGu E{b_gate_up, ACT};
        pg8::gemm_phase<EpiGu, SchedMoe, MOE_FP8 != 0>(c.lds, RB, RB, S, E);
#if PROBE_GU
        __syncthreads(); pg8::gemm_phase<EpiGu, SchedMoe, MOE_FP8 != 0, PROBE_GU>(c.lds, RB, RB, S, E); __syncthreads();
#endif
        REP_END(10)
        if (BOTH(10)) GRID_BAR();
    }
    if (IN(11)) {
        REP_BEGIN(11)
        moe_tables(c, CNT, tab);
        constexpr unsigned RB = MOE_FP8 ? 2048u : 4096u;
        SchedMoe S{(const char*)ACT, (const char*)WDN, tab, 8, c.G, (int)blockIdx.x, (size_t)2048 * RB, RB, MOE_FP8 ? 16 : 32}; EpiDn E{b_down, ROWGATE, YB};
        pg8::gemm_phase<EpiDn, SchedMoe, MOE_FP8 != 0>(c.lds, RB, RB, S, E);
        REP_END(11)
        if (BOTH(11)) GRID_BAR();
    }
    if (IN(12)) {
        typedef float f32x2_t __attribute__((ext_vector_type(2)));
        u32x4 slq = (gw < NTOK) ? *(const u32x4*)(SLOT + gw * 4) : (u32x4){0u, 0u, 0u, 0u};
#pragma unroll 1
        for (int t = gw; t < NTOK; t += NGW) { const int b = t >> 14; const int s0 = (int)slq[0], s1 = (int)slq[1], s2 = (int)slq[2], s3 = (int)slq[3];
            if (t + NGW < NTOK) slq = *(const u32x4*)(SLOT + (t + NGW) * 4);
#pragma unroll
            for (int j = 0; j < 4; ++j) { const int col = 8 * lane + 512 * j;
                const u32x2 y0 = __builtin_nontemporal_load((const u32x2*)(YB + (size_t)s0 * 2048 + col)), y1 = __builtin_nontemporal_load((const u32x2*)(YB + (size_t)s1 * 2048 + col)), y2 = __builtin_nontemporal_load((const u32x2*)(YB + (size_t)s2 * 2048 + col)), y3 = __builtin_nontemporal_load((const u32x2*)(YB + (size_t)s3 * 2048 + col));
                const f32x4 g0 = *(const f32x4*)(MOD + b * 12288 + 10240 + col) * YB_INV, g1 = *(const f32x4*)(MOD + b * 12288 + 10240 + col + 4) * YB_INV;
                const u32x4 xw = *(const u32x4*)(X1B + (size_t)t * 2048 + col);
                f32x4 o0 = {bflo(xw.x), bfhi(xw.x), bflo(xw.y), bfhi(xw.y)}, o1 = {bflo(xw.z), bfhi(xw.z), bflo(xw.w), bfhi(xw.w)};
#define SUM4(W, HI) (((__builtin_amdgcn_cvt_pk_f32_fp8((int)y0.W, HI) + __builtin_amdgcn_cvt_pk_f32_fp8((int)y1.W, HI)) + __builtin_amdgcn_cvt_pk_f32_fp8((int)y2.W, HI)) + __builtin_amdgcn_cvt_pk_f32_fp8((int)y3.W, HI))
                const f32x2_t a0 = SUM4(x, false), a1 = SUM4(x, true), a2 = SUM4(y, false), a3 = SUM4(y, true);
#undef SUM4
                o0[0] += g0[0] * a0[0]; o0[1] += g0[1] * a0[1]; o0[2] += g0[2] * a1[0]; o0[3] += g0[3] * a1[1];
                o1[0] += g1[0] * a2[0]; o1[1] += g1[1] * a2[1]; o1[2] += g1[2] * a3[0]; o1[3] += g1[3] * a3[1];
                float* op = out + (size_t)t * 2048 + col; __builtin_nontemporal_store(o0, (f32x4*)op); __builtin_nontemporal_store(o1, (f32x4*)(op + 4)); } }
    }
#undef IN
#undef BOTH
#undef GRID_BAR
}

extern "C" void kernel_launch(void* const* d_in, const int* in_sizes, int n_in, void* d_out, int out_size, void* d_ws, size_t ws_size, hipStream_t stream) {
    static int grid = 0;
    if (grid == 0) {
        if (n_in != 33 || out_size != NTOK * DM || ws_size < WS_END) { fprintf(stderr, "kernel_launch: unexpected shapes (n_in %d out %d ws %zu, need ws >= %zu)\n", n_in, out_size, ws_size, (size_t)WS_END); grid = -1; return; }
        int dev = 0, cus = 0, per_cu = 0;
        if (hipGetDevice(&dev) != hipSuccess || hipDeviceGetAttribute(&cus, hipDeviceAttributeMultiprocessorCount, dev) != hipSuccess) { grid = -1; return; }
        if (hipFuncSetAttribute((const void*)mk_fwd, hipFuncAttributeMaxDynamicSharedMemorySize, LDS_BYTES) != hipSuccess) { fprintf(stderr, "kernel_launch: hipFuncSetAttribute failed\n"); grid = -1; return; }
        if (hipOccupancyMaxActiveBlocksPerMultiprocessor(&per_cu, (const void*)mk_fwd, 512, LDS_BYTES) != hipSuccess || per_cu < 1) fprintf(stderr, "kernel_launch: occupancy query reports %d\n", per_cu);
        (void)hipGetLastError();
        grid = cus;
    }
    if (grid < 0) return;
    (void)hipMemsetAsync((char*)d_ws + WS_CTL, 0, CTL_BYTES, stream);
    Args a{};
    for (int i = 0; i < 33; ++i) a.in[i] = d_in[i];
    a.out = (float*)d_out; a.ws = (unsigned char*)d_ws;
#if MK_N_LAUNCHES == 1
    a.ph_lo = 0; a.ph_hi = NPHASE;
    hipLaunchKernelGGL(mk_fwd, dim3(grid), dim3(512), LDS_BYTES, stream, a);
#else
    for (int k = 0; k < NPHASE; ++k) { a.ph_lo = k; a.ph_hi = k + 1; hipLaunchKernelGGL(mk_fwd, dim3(grid), dim3(512), LDS_BYTES, stream, a); }
#endif
    const hipError_t le = hipPeekAtLastError();
    if (le != hipSuccess) fprintf(stderr, "kernel_launch: launch failed: %s\n", hipGetErrorName(le));
}
```

```cpp
#include <hip/hip_runtime.h>
#include <cstdio>
#include <cstdint>

#ifndef ATT_PV8
#define ATT_PV8 1
#endif
#ifndef ATT_FP8
#define ATT_FP8 1
#endif
#ifndef MOE_FP8
#define MOE_FP8 1
#endif
#ifndef MK_N_LAUNCHES
#define MK_N_LAUNCHES 1
#endif

#define LAS __attribute__((address_space(3)))
#define GAS __attribute__((address_space(1)))
typedef unsigned short bf16_t;
typedef short bf16x8 __attribute__((ext_vector_type(8)));
typedef short s16x4 __attribute__((ext_vector_type(4)));
typedef float f32x4 __attribute__((ext_vector_type(4)));
typedef float f32x2 __attribute__((ext_vector_type(2)));
typedef float f32x16 __attribute__((ext_vector_type(16)));
typedef unsigned u32x4 __attribute__((ext_vector_type(4)));
typedef unsigned u32x2 __attribute__((ext_vector_type(2)));

constexpr int NB = 2, SEQ = 16384, NTOK = NB * SEQ, DM = 2048;
constexpr int DSSM = 1024, NG = 64, SG = 16, SP = 64, NCH = NTOK / 64;
constexpr int NH = 8, QL = 512, KVL = 256;
constexpr int DIN = 2880, DINP = 3072;
constexpr int NE = 32, DFF = 2048;
constexpr int AGW = 1152;
constexpr int MAXBLK = 544, MAXROWS = MAXBLK * 256;
constexpr float EPS = 1e-6f;
constexpr int NPHASE = 13;

constexpr size_t MiB = 1u << 20;
constexpr size_t WS_CTL = 0, CTL_BYTES = 1 * MiB;
constexpr size_t WS_MOD = 1 * MiB;
constexpr size_t WS_FAB2 = WS_MOD + 512 * 1024;
constexpr size_t WS_APOW = 2 * MiB;
constexpr size_t WS_A64 = 5 * MiB;
constexpr size_t WS_A1024 = WS_A64 + 64 * 1024;
constexpr size_t WS_BB = WS_A64 + 128 * 1024;
constexpr size_t WS_KC = 6 * MiB;
constexpr size_t WS_COS = 10 * MiB, WS_SIN = 14 * MiB;
constexpr size_t WS_RIDX = 18 * MiB;
constexpr size_t WS_RGATE = WS_RIDX + 512 * 1024;
constexpr size_t WS_RPOS = WS_RGATE + 512 * 1024;
constexpr size_t WS_SLOT = WS_RPOS + 512 * 1024;
constexpr size_t WS_ROWGATE = 20 * MiB;
constexpr size_t WS_WRT = 21 * MiB;
constexpr size_t WS_WUQ = 22 * MiB, WS_WUKV = 25 * MiB, WS_WIN = 30 * MiB, WS_WOUT = 42 * MiB, WS_WG = 50 * MiB, WS_SEND = 82 * MiB, WS_KR = 98 * MiB;
constexpr size_t WS_BTG = 104 * MiB, WS_AG = 248 * MiB, WS_GS = 320 * MiB, WS_Z2 = 384 * MiB, WS_H = 456 * MiB, WS_QRAW = 584 * MiB, WS_KVRAW = 680 * MiB;
constexpr size_t WS_Q = 808 * MiB, WS_KN = 904 * MiB, WS_V = 968 * MiB, WS_YS = 1032 * MiB, WS_YM = 1096 * MiB, WS_MIX = 1224 * MiB;
constexpr size_t WS_WGU = 1352 * MiB, WS_WDN = 1864 * MiB, WS_ACT = 2120 * MiB, WS_YB = 2664 * MiB, WS_END = 3208 * MiB;
constexpr size_t WS_XS = WS_QRAW;
static_assert(WS_XS + (size_t)MAXROWS * 2048 * 2 <= WS_MIX, "XS overlay must end before MIX");
constexpr int CW_CNT = 64;
constexpr int CW_BAR = 4096;
constexpr int CW_ATT = 128;

constexpr int RING_BYTES = 131072;
constexpr int MISC_OFF = RING_BYTES;
constexpr int LDS_BYTES = 147456;
constexpr int AUX_OFF = MISC_OFF + 4096;

__device__ __forceinline__ float wave_sum(float v) {
#pragma unroll
    for (int o = 1; o < 64; o <<= 1) v += __shfl_xor(v, o);
    return v;
}
__device__ __forceinline__ unsigned cvt_pk_bf16(float lo, float hi) { unsigned r; asm volatile("v_cvt_pk_bf16_f32 %0, %1, %2" : "=v"(r) : "v"(lo), "v"(hi)); return r; }
__device__ __forceinline__ float bf2f(unsigned short b) { return __uint_as_float(((unsigned)b) << 16); }
__device__ __forceinline__ float bflo(unsigned w) { return __uint_as_float(w << 16); }
__device__ __forceinline__ float bfhi(unsigned w) { return __uint_as_float(w & 0xffff0000u); }
__device__ __forceinline__ unsigned short f2bf(float f) { return (unsigned short)(cvt_pk_bf16(f, 0.f) & 0xffffu); }
__device__ __forceinline__ float sigmoidf_(float x) { return __builtin_amdgcn_rcpf(1.0f + __builtin_amdgcn_exp2f(-1.4426950408889634f * x)); }
__device__ __forceinline__ void sincos_d(double theta, float& c, float& s) {
    double t = theta * 0.15915494309189535; t -= rint(t);
    const double r = t * 6.283185307179586;
    const double q = rint(r * 0.6366197723675814);
    const double y = r - q * 1.5707963267948966, y2 = y * y;
    const double sn = y * (1.0 + y2 * (-1.0 / 6 + y2 * (1.0 / 120 + y2 * (-1.0 / 5040 + y2 * (1.0 / 362880 + y2 * (-1.0 / 39916800))))));
    const double cs = 1.0 + y2 * (-0.5 + y2 * (1.0 / 24 + y2 * (-1.0 / 720 + y2 * (1.0 / 40320 + y2 * (-1.0 / 3628800 + y2 * (1.0 / 479001600))))));
    const int qi = ((int)q) & 3;
    const double co = (qi == 0) ? cs : (qi == 1) ? -sn : (qi == 2) ? -cs : sn;
    const double si = (qi == 0) ? sn : (qi == 1) ? cs : (qi == 2) ? -sn : -cs;
    c = (float)co; s = (float)si;
}

#define XB_TMO      128
#define XB_XCNT(j)  (256  + 64 * (j))
#define XB_XSUB(j)  (1280 + 64 * (j))
#define XB_XGEN(j)  (2304 + 64 * (j))
#define XB_TOP      3328
#define XB_TOPGEN   3392
#define XCD_BAR_WORDS 3456
#define XB_SPIN_CAP (1u << 22)
__device__ __forceinline__ unsigned xb_ld(unsigned* p)              { return __hip_atomic_load(p, __ATOMIC_RELAXED, __HIP_MEMORY_SCOPE_AGENT); }
__device__ __forceinline__ unsigned xb_add(unsigned* p, unsigned v) { return __hip_atomic_fetch_add(p, v, __ATOMIC_RELAXED, __HIP_MEMORY_SCOPE_AGENT); }
__device__ __forceinline__ unsigned xb_xcc_id() { return (unsigned)__builtin_amdgcn_s_getreg((3 << 11) | 20) & 0xFu; }
#define XB_SPIN(cond, bar) do { unsigned _sp = 0; while (cond) { __builtin_amdgcn_s_sleep(1); \
    if ((++_sp & 255u) == 0u) { if (xb_ld(&(bar)[XB_TMO])) break; if (_sp > XB_SPIN_CAP) { atomicAdd(&(bar)[XB_TMO], 1u); break; } } } } while (0)
struct XcdBarrier { unsigned* bar; unsigned x; volatile LAS unsigned* st; };
__device__ __forceinline__ XcdBarrier xcd_barrier_post(unsigned* bar, volatile LAS unsigned* st) {
    XcdBarrier b; b.bar = bar; b.x = xb_xcc_id(); b.st = st;
    if (threadIdx.x == 0) (void)xb_add(&bar[XB_XCNT(b.x)], 1u);
    return b;
}
__device__ __forceinline__ void xcd_barrier_complete(unsigned* bar, unsigned x, unsigned& nloc, unsigned& nx) {
    const unsigned G = gridDim.x * gridDim.y * gridDim.z;
    unsigned sum, cnt, mine, sp = 0u;
    for (;;) {
        sum = 0u; cnt = 0u; mine = 0u;
#pragma unroll
        for (unsigned j = 0; j < 16; ++j) { const unsigned c = xb_ld(&bar[XB_XCNT(j)]); sum += c; cnt += (c > 0u) ? 1u : 0u; mine = (j == x) ? c : mine; }
        if (sum == G) break;
        __builtin_amdgcn_s_sleep(1);
        if ((++sp & 255u) == 0u) { if (xb_ld(&bar[XB_TMO])) break; if (sp > XB_SPIN_CAP) { atomicAdd(&bar[XB_TMO], 1u); break; } }
    }
    nloc = mine > 0u ? mine : 1u; nx = cnt > 0u ? cnt : 1u;
}
__device__ __forceinline__ void xcd_barrier(const XcdBarrier& b) {
    asm volatile("s_waitcnt vmcnt(0)" ::: "memory");
    __syncthreads();
    if (threadIdx.x == 0) {
        unsigned* bar = b.bar;
        __builtin_amdgcn_s_waitcnt(0);
        unsigned nloc = b.st[0], nx = b.st[1];
        if (nloc == 0u) { xcd_barrier_complete(bar, b.x, nloc, nx); b.st[0] = nloc; b.st[1] = nx; }
        const unsigned old = xb_add(&bar[XB_XSUB(b.x)], 1u);
        const unsigned gen = old / nloc;
        if (old + 1u == (gen + 1u) * nloc) {
            __builtin_amdgcn_fence(__ATOMIC_RELEASE, "agent");
            asm volatile("s_waitcnt vmcnt(0)" ::: "memory");
            const unsigned og = xb_add(&bar[XB_TOP], 1u);
            const unsigned tg = og / nx;
            if (og + 1u == (tg + 1u) * nx) xb_add(&bar[XB_TOPGEN], 1u);
            else XB_SPIN(xb_ld(&bar[XB_TOPGEN]) == tg, bar);
            __builtin_amdgcn_fence(__ATOMIC_ACQUIRE, "agent");
            xb_add(&bar[XB_XGEN(b.x)], 1u);
            asm volatile("s_waitcnt vmcnt(0)" ::: "memory");
        } else {
            XB_SPIN(xb_ld(&bar[XB_XGEN(b.x)]) == gen, bar);
            __builtin_amdgcn_fence(__ATOMIC_ACQUIRE, "agent");
            asm volatile("s_waitcnt vmcnt(0)" ::: "memory");
        }
    }
    __syncthreads();
}

namespace pg8 {
constexpr int BM = 256, BK = 64, HALF = 128, HTB = HALF * BK * 2, STAGE_BYTES = 8 * HTB, NXCD = 8, WGM = 8;
__host__ __device__ __forceinline__ int lds_byte(int r, int c) { const int st = (r >> 4) * 2 + (c >> 5), rr = r & 15, cc = c & 31, ob = rr * 64 + cc * 2; return st * 1024 + (ob ^ (((ob >> 9) & 1) << 5)); }
__host__ __device__ __forceinline__ void stage_rc(int b, int& R, int& C) { const int st = b / 1024, sb = b % 1024, swz = sb ^ (((sb >> 9) & 1) << 5); R = (st >> 1) * 16 + swz / 64; C = (st & 1) * 32 + (swz % 64) / 2; }
__host__ __device__ __forceinline__ int perm32(int rho) { const int n = rho >> 4, i = rho & 15; return 8 * (i >> 2) + 4 * n + (i & 3); }

struct Unit { const char* A; const char* B; int nt, pm, pn, aux; };

__device__ __forceinline__ void dense_map(int L, int nM, int nN, int& pm, int& pn) {
    const int nwg = nM * nN; int wgid = L;
    { const int q = nwg / NXCD, r = nwg % NXCD, xcd = wgid % NXCD, off = wgid / NXCD; wgid = (xcd < r ? xcd * (q + 1) : r * (q + 1) + (xcd - r) * q) + off; }
    const int nig = WGM * nN, gid = wgid / nig, fm = gid * WGM, gsz = (nM - fm) < WGM ? (nM - fm) : WGM;
    pm = fm + ((wgid % nig) % gsz); pn = (wgid % nig) / gsz;
}

typedef int v8i_t __attribute__((ext_vector_type(8)));
typedef int v4i_t __attribute__((ext_vector_type(4)));
template <class Epi, class Sched, bool FP8 = false, int PRB = 0>
__device__ __forceinline__ void gemm_phase(LAS unsigned char* lds, const unsigned lda, const unsigned ldb, const Sched& S, const Epi& E) {
    const int tid = threadIdx.x, wid = __builtin_amdgcn_readfirstlane(tid >> 6), lane = tid & 63, wr = wid >> 2, wc = wid & 3, fr = lane & 15, fq = lane >> 4;
    unsigned voffA[2], voffB[2];
#pragma unroll
    for (int i = 0; i < 2; ++i) { int R, C; stage_rc(tid * 16 + i * 8192, R, C); const int Rb = Epi::PERM ? ((R & ~31) + perm32(R & 31)) : R;
        voffA[i] = (unsigned)R * lda + (unsigned)C * 2u; voffB[i] = (unsigned)Rb * ldb + (unsigned)C * 2u; }
    const size_t kstep = (size_t)(BK * 2);
    const size_t hstepA = (size_t)HALF * lda, hstepB = (size_t)HALF * ldb;
    const unsigned ldsw = (unsigned)wid * 1024u;
    const int aoff = lds_byte(wr * 64 + fr, fq * 8), boff = lds_byte(wc * 32 + fr, fq * 8);
#define PG8_SA(b, h) (((b) * 2 + (h)) * HTB)
#define PG8_SB(b, h) ((4 + (b) * 2 + (h)) * HTB)
#define PG8_STAGE(bufoff, gbase, voff) do { if constexpr (PRB != 1) { _Pragma("unroll") for (int _i = 0; _i < 2; ++_i) \
        __builtin_amdgcn_global_load_lds((const unsigned*)((const char*)(gbase) + (voff)[_i]), (LAS unsigned*)(lds + (bufoff) + ldsw + _i * 8192), 16, 0, 0); } } while (0)
#define PG8_LDA(dst, b, h) do { _Pragma("unroll") for (int m = 0; m < 4; ++m) { const v4i_t lo_ = *(const LAS v4i_t*)(lds + PG8_SA(b, h) + aoff + m * 2048), hi_ = *(const LAS v4i_t*)(lds + PG8_SA(b, h) + aoff + m * 2048 + 1024); dst[m] = __builtin_shufflevector(lo_, hi_, 0, 1, 2, 3, 4, 5, 6, 7); } } while (0)
#define PG8_LDB(dst, b, h) do { _Pragma("unroll") for (int n = 0; n < 2; ++n) { const v4i_t lo_ = *(const LAS v4i_t*)(lds + PG8_SB(b, h) + boff + n * 2048), hi_ = *(const LAS v4i_t*)(lds + PG8_SB(b, h) + boff + n * 2048 + 1024); dst[n] = __builtin_shufflevector(lo_, hi_, 0, 1, 2, 3, 4, 5, 6, 7); } } while (0)
#define PG8_LO(x) __builtin_bit_cast(bf16x8, __builtin_shufflevector(x, x, 0, 1, 2, 3))
#define PG8_HI(x) __builtin_bit_cast(bf16x8, __builtin_shufflevector(x, x, 4, 5, 6, 7))
#define PG8_MMA(ai, bj, At, Bt) do { __builtin_amdgcn_s_setprio(1); \
        if constexpr (PRB == 2) {} else if constexpr (FP8) { _Pragma("unroll") for (int m = 0; m < 4; ++m) _Pragma("unroll") for (int n = 0; n < 2; ++n) \
            asm volatile("v_mfma_f32_16x16x128_f8f6f4 %0, %1, %2, %0" : "+v"(acc[ai][bj][m][n]) : "v"(Bt[n]), "v"(At[m])); \
            } \
        else { _Pragma("unroll") for (int m = 0; m < 4; ++m) _Pragma("unroll") for (int n = 0; n < 2; ++n) { \
            acc[ai][bj][m][n] = __builtin_amdgcn_mfma_f32_16x16x32_bf16(PG8_LO(Bt[n]), PG8_LO(At[m]), acc[ai][bj][m][n], 0, 0, 0); \
            acc[ai][bj][m][n] = __builtin_amdgcn_mfma_f32_16x16x32_bf16(PG8_HI(Bt[n]), PG8_HI(At[m]), acc[ai][bj][m][n], 0, 0, 0); } } \
        __builtin_amdgcn_s_setprio(0); } while (0)
#define PG8_WAIT_V(n) asm volatile("s_waitcnt vmcnt(" #n ")" ::: "memory")
#define PG8_WAIT_L(n) asm volatile("s_waitcnt lgkmcnt(" #n ")" ::: "memory")
#define PG8_BAR __builtin_amdgcn_s_barrier()
#define PG8_SCHED __builtin_amdgcn_sched_barrier(0)
    Unit cur, nxt; int ui = 0;
    if (!S.next(0, cur)) return;
    if constexpr (Epi::AUXT) E.prefetch(cur, lds + AUX_OFF, wid, lane);
    f32x4 acc[2][2][4][2];
#pragma unroll
    for (int a = 0; a < 2; ++a)
#pragma unroll
        for (int b = 0; b < 2; ++b)
#pragma unroll
            for (int m = 0; m < 4; ++m)
#pragma unroll
                for (int n = 0; n < 2; ++n) acc[a][b][m][n] = (f32x4){0.f, 0.f, 0.f, 0.f};
    v8i_t At[4], B0[2], B1[2];
    const char* cA = cur.A; const char* cB = cur.B;
    PG8_STAGE(PG8_SB(0, 0), cB, voffB); PG8_STAGE(PG8_SA(0, 0), cA, voffA); PG8_STAGE(PG8_SB(0, 1), cB + hstepB, voffB); PG8_STAGE(PG8_SA(0, 1), cA + hstepA, voffA);
    if (wr == 1) PG8_BAR;
    PG8_WAIT_V(4); PG8_BAR;
    PG8_STAGE(PG8_SB(1, 0), cB + kstep, voffB); PG8_STAGE(PG8_SA(1, 0), cA + kstep, voffA); PG8_STAGE(PG8_SB(1, 1), cB + hstepB + kstep, voffB);
    PG8_WAIT_V(6); PG8_BAR;
    for (;;) {
        const bool has_next = S.next(ui + 1, nxt);
        const char* nA = has_next ? nxt.A : cA; const char* nB = has_next ? nxt.B : cB;
        const int nt = cur.nt;
        for (int t = 0; t < nt; t += 2) {
            const bool last = (t == nt - 2);
            if constexpr (Epi::AUXT) { if (last && has_next) E.prefetch(nxt, lds + AUX_OFF + ((ui + 1) & 1) * 2048, wid, lane); }
            const char* a1 = cA + (size_t)(t + 1) * kstep;
            const char* a2 = last ? nA : cA + (size_t)(t + 2) * kstep; const char* b2 = last ? nB : cB + (size_t)(t + 2) * kstep;
            const char* a3 = a2 + kstep; const char* b3 = b2 + kstep;
            PG8_LDB(B0, 0, 0); PG8_SCHED; PG8_LDA(At, 0, 0); PG8_STAGE(PG8_SA(1, 1), a1 + hstepA, voffA);
            PG8_WAIT_L(8); PG8_BAR; PG8_WAIT_L(0); PG8_MMA(0, 0, At, B0); PG8_BAR; PG8_SCHED;
            PG8_LDB(B1, 0, 1); PG8_STAGE(PG8_SB(0, 0), b2, voffB);
            PG8_BAR; PG8_WAIT_L(0); PG8_MMA(0, 1, At, B1); PG8_BAR;
            PG8_LDA(At, 0, 1); PG8_STAGE(PG8_SA(0, 0), a2, voffA);
            PG8_BAR; PG8_WAIT_L(0); PG8_MMA(1, 0, At, B0); PG8_BAR; PG8_SCHED;
            PG8_STAGE(PG8_SB(0, 1), b2 + hstepB, voffB);
            PG8_WAIT_V(6); PG8_BAR; PG8_MMA(1, 1, At, B1); PG8_BAR;
            PG8_LDB(B0, 1, 0); PG8_SCHED; PG8_LDA(At, 1, 0); PG8_STAGE(PG8_SA(0, 1), a2 + hstepA, voffA);
            PG8_WAIT_L(8); PG8_BAR; PG8_WAIT_L(0); PG8_MMA(0, 0, At, B0); PG8_BAR; PG8_SCHED;
            PG8_LDB(B1, 1, 1); PG8_STAGE(PG8_SB(1, 0), b3, voffB);
            PG8_BAR; PG8_WAIT_L(0); PG8_MMA(0, 1, At, B1); PG8_BAR;
            PG8_LDA(At, 1, 1); PG8_STAGE(PG8_SA(1, 0), a3, voffA);
            PG8_BAR; PG8_WAIT_L(0); PG8_MMA(1, 0, At, B0); PG8_BAR; PG8_SCHED;
            PG8_STAGE(PG8_SB(1, 1), b3 + hstepB, voffB);
            PG8_WAIT_V(6); PG8_BAR; PG8_MMA(1, 1, At, B1); PG8_BAR;
        }
        if constexpr (FP8) asm volatile("s_nop 15\n\ts_nop 15" ::: "memory");
        if constexpr (PRB == 0) { if constexpr (Epi::AUXT) E(acc, cur, wr, wc, fr, fq, lds + AUX_OFF + (ui & 1) * 2048); else E(acc, cur, wr, wc, fr, fq); }
        if (!has_next) break;
#pragma unroll
        for (int a = 0; a < 2; ++a)
#pragma unroll
            for (int b = 0; b < 2; ++b)
#pragma unroll
                for (int m = 0; m < 4; ++m)
#pragma unroll
                    for (int n = 0; n < 2; ++n) acc[a][b][m][n] = (f32x4){0.f, 0.f, 0.f, 0.f};
        cur = nxt; cA = nA; cB = nB; ++ui;
    }
    PG8_WAIT_V(0);
    if (wr == 0) PG8_BAR;
    PG8_BAR;
#undef PG8_SA
#undef PG8_SB
#undef PG8_STAGE
#undef PG8_LDA
#undef PG8_LDB
#undef PG8_LO
#undef PG8_HI
#undef PG8_MMA
#undef PG8_WAIT_V
#undef PG8_WAIT_L
#undef PG8_BAR
#undef PG8_SCHED
}
}
using pg8::Unit;

struct SchedDense {
    const char* A; const char* B; unsigned lda, ldb; int nM, nN, nt, G, c;
    __device__ __forceinline__ bool next(int i, Unit& u) const {
        const long L = (long)i * G + c; if (L >= (long)nM * nN) return false;
        int pm, pn; pg8::dense_map((int)L, nM, nN, pm, pn);
        u.A = A + (size_t)pm * 256 * lda; u.B = B + (size_t)pn * 256 * ldb; u.nt = nt; u.pm = pm; u.pn = pn; u.aux = 0; return true;
    }
};
struct SchedP3 {
    const char* AG; const char* WG; const char* Z2; const char* WUQ; const char* WUKV; int G, c;
    __device__ __forceinline__ bool next(int i, Unit& u) const {
        int kind, L;
        if (G == 256) {
            if (c < 128) { if (i == 0) { kind = 2; L = c; } else if (i <= 3) { kind = 0; L = (i - 1) * 256 + c; } else if (i == 4) { kind = 0; L = 2 * 256 + c + 128; } else if (i == 5) { kind = 1; L = 3 * 256 + c; } else return false; }
            else { if (i <= 1) { kind = 0; L = i * 256 + c; } else if (i <= 5) { kind = 1; L = (i - 2) * 256 + c; } else if (i <= 8) { kind = 1; L = (i - 6) * 256 + (c - 128); } else return false; }
        } else { const int Lg = i * G + c; if (Lg < 128) { kind = 2; L = Lg; } else if (Lg < 896) { kind = 0; L = Lg - 128; } else if (Lg < 1920) { kind = 1; L = Lg - 896; } else return false; }
        if (kind == 2) { const int g = L >> 1, pmm = L & 1; u.A = AG + ((size_t)(g * NCH + pmm * 256) * AGW + 128) * 2; u.B = WG + (size_t)g * 256 * 1024 * 2; u.nt = 16; u.pm = g * 2 + pmm; u.pn = 0; u.aux = 2; return true; }
        if (kind == 0) { int pm, pn; pg8::dense_map(L, 128, 6, pm, pn); u.A = Z2 + (size_t)pm * 256 * (AGW * 2); u.B = WUQ + (size_t)pn * 256 * 2048; u.nt = 8; u.pm = pm; u.pn = pn; u.aux = 0; return true; }
        { int pm, pn; pg8::dense_map(L, 128, 8, pm, pn); u.A = Z2 + (size_t)pm * 256 * (AGW * 2) + 1024; u.B = WUKV + (size_t)pn * 256 * 2048; u.nt = 4; u.pm = pm; u.pn = pn; u.aux = 1; return true; }
    }
};
struct SchedSsm {
    const char* AG; const char* BTG; int G, c;
    __device__ __forceinline__ bool next(int i, Unit& u) const {
        int pn, gp;
        if (G == 256) { if (i > 1) return false; pn = (i == 0) ? ((c < 128) ? 3 : 2) : ((c < 128) ? 0 : 1); gp = c & 127; }
        else { const int L = i * G + c; if (L >= 512) return false; pn = 3 - (L >> 7); gp = L & 127; }
        const int g = gp >> 1, pmm = gp & 1;
        u.A = AG + (size_t)(g * NCH + pmm * 256) * AGW * 2; u.B = BTG + ((size_t)g * 1024 + pn * 256) * AGW * 2; u.nt = 2 + 4 * (pn + 1); u.pm = pmm; u.pn = pn; u.aux = g; return true;
    }
};
struct SchedMoe {
    const char* A; const char* W; const volatile LAS int* tab; int NPN, G, c; size_t wstride; unsigned rowb; int nt;
    __device__ __forceinline__ bool next(int i, Unit& u) const {
        const int total = __builtin_amdgcn_readfirstlane(tab[64]);
        int grb, pn;
        if ((G & 255) == 0) {
            const int L = i * G + c, x = L & 7, j = (L >> 3) & 31, R = (L >> 8) * 8 + x;
            const int s = (NPN == 16) ? (R >> 1) : R;
            grb = 4 * s + (j & 3); pn = ((NPN == 16) ? 8 * (R & 1) : 0) + (j >> 2);
            if (4 * s >= total) return false;
            if (grb >= total) { grb = total - 1; u.aux = -1; }
        } else { const int L = i * G + c; if (L >= total * NPN) return false; grb = L / NPN; pn = L % NPN; }
        const int e = __builtin_amdgcn_readfirstlane(tab[128 + grb]);
        u.A = A + (size_t)grb * 256 * rowb; u.B = W + (size_t)e * wstride + (size_t)pn * 256 * rowb; u.nt = nt; u.pm = grb; u.pn = pn; u.aux = e; return true;
    }
};

struct EpiZ {
    static constexpr bool PERM = true; static constexpr bool AUXT = false;
    bf16_t* AG; bf16_t* GS; bf16_t* Z2;
    __device__ __forceinline__ void operator()(const f32x4 (&acc)[2][2][4][2], const Unit& u, int wr, int wc, int fr, int fq) const {
        const int row0 = u.pm * 256 + wr * 64 + fr, colt = u.pn * 256 + wc * 32 + 8 * fq;
#pragma unroll
        for (int ai = 0; ai < 2; ++ai)
#pragma unroll
            for (int m = 0; m < 4; ++m) { const int row = row0 + ai * 128 + m * 16; const int chunk = row >> 6, j = row & 63;
#pragma unroll
                for (int bj = 0; bj < 2; ++bj) { const int col = colt + bj * 128; const f32x4 v0 = acc[ai][bj][m][0], v1 = acc[ai][bj][m][1];
                    u32x4 w; w.x = cvt_pk_bf16(v0[0], v0[1]); w.y = cvt_pk_bf16(v0[2], v0[3]); w.z = cvt_pk_bf16(v1[0], v1[1]); w.w = cvt_pk_bf16(v1[2], v1[3]);
                    bf16_t* dst;
                    if (u.pn < 4) { const int g = col >> 4, h0 = col & 15; dst = AG + ((size_t)(g * NCH + chunk) * AGW + 128 + j * 16 + h0); }
                    else if (u.pn < 8) { const int ch = col - 1024, g = ch >> 4, h0 = ch & 15; dst = GS + ((size_t)(g * NCH + chunk) * 1024 + j * 16 + h0); }
                    else dst = Z2 + (size_t)row * AGW + (col - 2048);
                    *(u32x4*)dst = w; } }
    }
};
struct EpiP3 {
    static constexpr bool PERM = true; static constexpr bool AUXT = false;
    bf16_t* QRAW; bf16_t* KVRAW; float* SEND;
    __device__ __forceinline__ void operator()(const f32x4 (&acc)[2][2][4][2], const Unit& u, int wr, int wc, int fr, int fq) const {
        if (u.aux == 2) {
            const int row0 = u.pm * 256 + wr * 64 + fr, col0 = wc * 32 + 8 * fq;
#pragma unroll
            for (int ai = 0; ai < 2; ++ai)
#pragma unroll
                for (int m = 0; m < 4; ++m) { float* rowp = SEND + (size_t)(row0 + ai * 128 + m * 16) * 128 + col0;
                    *(f32x4*)rowp = acc[ai][0][m][0]; *(f32x4*)(rowp + 4) = acc[ai][0][m][1]; }
        } else {
            bf16_t* O = (u.aux == 0) ? QRAW : KVRAW; const int ldc = (u.aux == 0) ? 1536 : 2048;
            const int row0 = u.pm * 256 + wr * 64 + fr, col0 = u.pn * 256 + wc * 32 + 8 * fq;
#pragma unroll
            for (int ai = 0; ai < 2; ++ai)
#pragma unroll
                for (int m = 0; m < 4; ++m) { bf16_t* rowp = O + (size_t)(row0 + ai * 128 + m * 16) * ldc + col0;
#pragma unroll
                    for (int bj = 0; bj < 2; ++bj) { const f32x4 v0 = acc[ai][bj][m][0], v1 = acc[ai][bj][m][1];
                        u32x4 w; w.x = cvt_pk_bf16(v0[0], v0[1]); w.y = cvt_pk_bf16(v0[2], v0[3]); w.z = cvt_pk_bf16(v1[0], v1[1]); w.w = cvt_pk_bf16(v1[2], v1[3]);
                        *(u32x4*)(rowp + bj * 128) = w; } }
        }
    }
};
__device__ __forceinline__ float gelu_tanh(float x) { const float u = 0.7978845608028654f * (x + 0.044715f * x * x * x); return x * sigmoidf_(2.0f * u); }
struct EpiSsm {
    static constexpr bool PERM = true; static constexpr bool AUXT = false;
    const bf16_t* GS; bf16_t* YS;
    __device__ __forceinline__ void operator()(const f32x4 (&acc)[2][2][4][2], const Unit& u, int wr, int wc, int fr, int fq) const {
        const int g = u.aux, row0 = u.pm * 256 + wr * 64 + fr, colt = u.pn * 256 + wc * 32 + 8 * fq;
#pragma unroll
        for (int ai = 0; ai < 2; ++ai)
#pragma unroll
            for (int m = 0; m < 4; ++m) { const int chunk = row0 + ai * 128 + m * 16;
#pragma unroll
                for (int bj = 0; bj < 2; ++bj) { const int col = colt + bj * 128, l = col >> 4, h0 = col & 15;
                    const u32x4 gw = *(const u32x4*)(GS + ((size_t)(g * NCH + chunk) * 1024 + col));
                    const f32x4 v0 = acc[ai][bj][m][0], v1 = acc[ai][bj][m][1];
                    float o[8];
                    o[0] = gelu_tanh(v0[0]) * sigmoidf_(bflo(gw.x)); o[1] = gelu_tanh(v0[1]) * sigmoidf_(bfhi(gw.x));
                    o[2] = gelu_tanh(v0[2]) * sigmoidf_(bflo(gw.y)); o[3] = gelu_tanh(v0[3]) * sigmoidf_(bfhi(gw.y));
                    o[4] = gelu_tanh(v1[0]) * sigmoidf_(bflo(gw.z)); o[5] = gelu_tanh(v1[1]) * sigmoidf_(bfhi(gw.z));
                    o[6] = gelu_tanh(v1[2]) * sigmoidf_(bflo(gw.w)); o[7] = gelu_tanh(v1[3]) * sigmoidf_(bfhi(gw.w));
                    u32x4 w; w.x = cvt_pk_bf16(o[0], o[1]); w.y = cvt_pk_bf16(o[2], o[3]); w.z = cvt_pk_bf16(o[4], o[5]); w.w = cvt_pk_bf16(o[6], o[7]);
                    *(u32x4*)(YS + ((size_t)(chunk * 64 + l) * 1024 + g * 16 + h0)) = w; } }
    }
};
#ifndef OUT_FP8
#define OUT_FP8 0
#endif
struct EpiOut {
    static constexpr float OUT_SC = OUT_FP8 ? (1.0f / 64.0f) : 1.0f;
    static constexpr bool PERM = true; static constexpr bool AUXT = false;
    const float* X; bf16_t* X1B; const float* MOD;
    __device__ __forceinline__ void operator()(const f32x4 (&acc)[2][2][4][2], const Unit& u, int wr, int wc, int fr, int fq) const {
        const int row0 = u.pm * 256 + wr * 64 + fr, col0 = u.pn * 256 + wc * 32 + 8 * fq;
        const int b = (u.pm * 256) >> 14;
        f32x4 gv[2][2];
#pragma unroll
        for (int bj = 0; bj < 2; ++bj)
#pragma unroll
            for (int n = 0; n < 2; ++n) gv[bj][n] = *(const f32x4*)(MOD + b * 12288 + 4096 + col0 + bj * 128 + 4 * n);
#pragma unroll
        for (int ai = 0; ai < 2; ++ai)
#pragma unroll
            for (int m = 0; m < 4; ++m) { const size_t off = (size_t)(row0 + ai * 128 + m * 16) * DM + col0;
#pragma unroll
                for (int bj = 0; bj < 2; ++bj) { const f32x4 x0 = *(const f32x4*)(X + off + bj * 128), x1 = *(const f32x4*)(X + off + bj * 128 + 4);
                    const f32x4 v0 = x0 + gv[bj][0] * (acc[ai][bj][m][0] * OUT_SC), v1 = x1 + gv[bj][1] * (acc[ai][bj][m][1] * OUT_SC);
                    u32x4 w; w.x = cvt_pk_bf16(v0[0], v0[1]); w.y = cvt_pk_bf16(v0[2], v0[3]); w.z = cvt_pk_bf16(v1[0], v1[1]); w.w = cvt_pk_bf16(v1[2], v1[3]);
                    *(u32x4*)(X1B + off + bj * 128) = w; } }
    }
};
__device__ __forceinline__ unsigned pk4_fp8(float a, float b, float c, float d) { unsigned w = 0u; w = __builtin_amdgcn_cvt_pk_fp8_f32(a, b, w, false); w = __builtin_amdgcn_cvt_pk_fp8_f32(c, d, w, true); return w; }
constexpr float W8_SCALE = 64.0f, W8_INV = 1.0f / 64.0f;
__device__ __forceinline__ u32x4 pair16(const u32x2& X, const u32x2& Y) {
    const auto r0 = __builtin_amdgcn_permlane16_swap(X.x, Y.x, false, false), r1 = __builtin_amdgcn_permlane16_swap(X.y, Y.y, false, false);
    return (u32x4){r0[0], r1[0], r0[1], r1[1]};
}
struct EpiGu {
    static constexpr bool PERM = true; static constexpr bool AUXT = true;
    const float* BGU; unsigned char* ACT;
    __device__ __forceinline__ void prefetch(const Unit& u, LAS unsigned char* aux, int wid, int lane) const {
        if (wid == 0) __builtin_amdgcn_global_load_lds((const unsigned*)(BGU + (size_t)u.aux * 4096 + u.pn * 256 + lane * 4), (LAS unsigned*)aux, 16, 0, 0);
    }
    __device__ __forceinline__ void operator()(const f32x4 (&acc)[2][2][4][2], const Unit& u, int wr, int wc, int fr, int fq, const LAS unsigned char* aux) const {
        const int row0 = u.pm * 256 + wr * 64 + fr, j0 = u.pn * 128 + wc * 32 + 8 * fq;
        const LAS f32x4* bp = (const LAS f32x4*)(aux + (wc * 32 + 8 * fq) * 8);
        const f32x4 b0 = bp[0], b1 = bp[1], b2 = bp[2], b3 = bp[3];
        const float bg[8] = {b0[0], b0[2], b1[0], b1[2], b2[0], b2[2], b3[0], b3[2]}, bu[8] = {b0[1], b0[3], b1[1], b1[3], b2[1], b2[3], b3[1], b3[3]};
        constexpr float SC = MOE_FP8 ? W8_INV : 1.0f;
        const bool odd = (fq & 1) != 0;
#pragma unroll
        for (int ai = 0; ai < 2; ++ai)
#pragma unroll
            for (int mp = 0; mp < 2; ++mp) { u32x2 wq[2];
#pragma unroll
                for (int mm = 0; mm < 2; ++mm) { const int m = 2 * mp + mm; float o[8];
#pragma unroll
                    for (int n = 0; n < 2; ++n)
#pragma unroll
                        for (int e = 0; e < 4; ++e) { float gt = acc[ai][0][m][n][e] * SC + bg[4 * n + e], up = acc[ai][1][m][n][e] * SC + bu[4 * n + e];
                            gt = fminf(gt, 7.0f); up = fminf(fmaxf(up, -7.0f), 7.0f); o[4 * n + e] = (up + 1.0f) * gt * sigmoidf_(1.702f * gt); }
                    wq[mm].x = pk4_fp8(o[0], o[1], o[2], o[3]); wq[mm].y = pk4_fp8(o[4], o[5], o[6], o[7]); }
                const u32x4 w = pair16(wq[0], wq[1]);
                *(u32x4*)(ACT + (size_t)(row0 + ai * 128 + (2 * mp + (odd ? 1 : 0)) * 16) * 2048 + (odd ? j0 - 8 : j0)) = w; }
    }
};
constexpr float YB_SCALE = 16.0f, YB_INV = 1.0f / 16.0f;
struct EpiDn {
    static constexpr bool PERM = true; static constexpr bool AUXT = true;
    const float* BD; const float* ROWGATE; unsigned char* YB;
    __device__ __forceinline__ void prefetch(const Unit& u, LAS unsigned char* aux, int wid, int lane) const {
        if (wid == 0) __builtin_amdgcn_global_load_lds((const unsigned*)(BD + (size_t)u.aux * 2048 + u.pn * 256 + lane * 4), (LAS unsigned*)aux, 16, 0, 0);
        if (wid == 1) __builtin_amdgcn_global_load_lds((const unsigned*)(ROWGATE + (size_t)u.pm * 256 + lane * 4), (LAS unsigned*)(aux + 1024), 16, 0, 0);
    }
    __device__ __forceinline__ void operator()(const f32x4 (&acc)[2][2][4][2], const Unit& u, int wr, int wc, int fr, int fq, const LAS unsigned char* aux) const {
        const int row0 = u.pm * 256 + wr * 64 + fr, col0 = u.pn * 256 + wc * 32 + 8 * fq;
        f32x4 bv[2][2];
#pragma unroll
        for (int bj = 0; bj < 2; ++bj)
#pragma unroll
            for (int n = 0; n < 2; ++n) bv[bj][n] = *(const LAS f32x4*)(aux + (wc * 32 + 8 * fq + bj * 128 + 4 * n) * 4);
        const LAS float* gp = (const LAS float*)(aux + 1024) + wr * 64 + fr;
        const bool odd = (fq & 1) != 0;
#pragma unroll
        for (int ai = 0; ai < 2; ++ai)
#pragma unroll
            for (int m = 0; m < 4; ++m) { const int row = row0 + ai * 128 + m * 16; const float gt = gp[ai * 128 + m * 16] * YB_SCALE; u32x2 wq[2];
#pragma unroll
                for (int bj = 0; bj < 2; ++bj) { constexpr float SC = MOE_FP8 ? W8_INV : 1.0f; const f32x4 v0 = (acc[ai][bj][m][0] * SC + bv[bj][0]) * gt, v1 = (acc[ai][bj][m][1] * SC + bv[bj][1]) * gt;
                    wq[bj].x = pk4_fp8(v0[0], v0[1], v0[2], v0[3]); wq[bj].y = pk4_fp8(v1[0], v1[1], v1[2], v1[3]); }
                const u32x4 w = pair16(wq[0], wq[1]);
                *(u32x4*)(YB + (size_t)row * 2048 + (odd ? col0 - 8 + 128 : col0)) = w; }
    }
};

namespace att {
constexpr int D = 128, NW = 8, QBLK = 32, KVBLK = 64;
constexpr float SCALE = 0.07216878364870322f;
constexpr float THR = 8.f;
#ifndef ATT_SDEPTH
#define ATT_SDEPTH 2
#endif
constexpr int SDEPTH = ATT_SDEPTH;
constexpr int LDQ = 192, LDK = 128, LDR = 64, LDO = 1024;
constexpr int SHM_V = KVBLK * D * 2, SHM_K = KVBLK * D * 2, SHM_R = KVBLK * 64 * 2;
constexpr int OFF_V = 0, OFF_K = 2 * SHM_V, OFF_R = OFF_K + 2 * SHM_K, OFF_WS = OFF_R + 2 * SHM_R, SHM_ATTN = OFF_WS + NW * 64 * 4;
#define KSWZ(row, colB) ((row) * 256 + ((colB) ^ (((row) & 15) << 4)))
#define RSWZ(row, colB) ((row) * 128 + ((colB) ^ ((((row) >> 1) & 7) << 4)))
#define SBAR() __builtin_amdgcn_sched_barrier(0)
__device__ __forceinline__ int crow(int r, int hi) { return (r & 3) + 8 * (r >> 2) + 4 * hi; }

__device__ __forceinline__ void partialSM(f32x16& p0, f32x16& p1, float& m_reg, float& mn, float& alpha) {
  constexpr float C = SCALE * 1.4426950408889634f;
  float pmax = p0[0];
#pragma unroll
  for (int r = 1; r < 16; ++r) pmax = fmaxf(pmax, p0[r]);
#pragma unroll
  for (int r = 0; r < 16; ++r) pmax = fmaxf(pmax, p1[r]);
  { auto rr = __builtin_amdgcn_permlane32_swap(__float_as_uint(pmax), __float_as_uint(pmax), false, false);
    pmax = fmaxf(__uint_as_float(rr[0]), __uint_as_float(rr[1])); }
  if (__builtin_expect(__all(pmax - m_reg <= THR / SCALE), 1)) { mn = m_reg; alpha = 1.f; }
  else { mn = fmaxf(m_reg, pmax); alpha = __builtin_amdgcn_exp2f((m_reg - mn) * C); m_reg = mn; }
  float mnC = -mn * C;
#pragma unroll
  for (int r = 0; r < 16; ++r) p0[r] = fmaf(p0[r], C, mnC);
#pragma unroll
  for (int r = 0; r < 16; ++r) p1[r] = fmaf(p1[r], C, mnC);
#pragma unroll
  for (int r = 0; r < 16; ++r) p0[r] = __builtin_amdgcn_exp2f(p0[r]);
}
__device__ __forceinline__ void finishSM(f32x16& p0, f32x16& p1, float alpha, float& l_reg, bf16x8& pa0, bf16x8& pa1, bf16x8& pa2, bf16x8& pa3) {
#pragma unroll
  for (int r = 0; r < 16; ++r) p1[r] = __builtin_amdgcn_exp2f(p1[r]);
  float ps = 0;
#pragma unroll
  for (int r = 0; r < 16; ++r) ps += p0[r];
#pragma unroll
  for (int r = 0; r < 16; ++r) ps += p1[r];
  { auto rr = __builtin_amdgcn_permlane32_swap(__float_as_uint(ps), __float_as_uint(ps), false, false);
    ps = __uint_as_float(rr[0]) + __uint_as_float(rr[1]); }
  l_reg = l_reg * alpha + ps;
#define PK4(P, BASE, OUT) do { unsigned a0 = cvt_pk_bf16(P[BASE + 0], P[BASE + 1]), a1 = cvt_pk_bf16(P[BASE + 2], P[BASE + 3]);   \
    unsigned b0 = cvt_pk_bf16(P[BASE + 4], P[BASE + 5]), b1 = cvt_pk_bf16(P[BASE + 6], P[BASE + 7]);                              \
    auto r0 = __builtin_amdgcn_permlane32_swap(a0, b0, false, false); auto r1 = __builtin_amdgcn_permlane32_swap(a1, b1, false, false); \
    u32x4 w = {r0[0], r1[0], r0[1], r1[1]}; OUT = *reinterpret_cast<bf16x8*>(&w); } while (0)
  PK4(p0, 0, pa0); PK4(p0, 8, pa1); PK4(p1, 0, pa2); PK4(p1, 8, pa3);
#undef PK4
}
__device__ __forceinline__ void softmax_nomax(f32x16& p0, f32x16& p1, float& l_reg, bf16x8& pa0, bf16x8& pa1, bf16x8& pa2, bf16x8& pa3) {
#pragma unroll
  for (int r = 0; r < 16; ++r) p0[r] = __builtin_amdgcn_exp2f(p0[r]);
#pragma unroll
  for (int r = 0; r < 16; ++r) p1[r] = __builtin_amdgcn_exp2f(p1[r]);
  float ps = 0;
#pragma unroll
  for (int r = 0; r < 16; ++r) ps += p0[r];
#pragma unroll
  for (int r = 0; r < 16; ++r) ps += p1[r];
  l_reg += ps;
#define PK4(P, BASE, OUT) do { unsigned a0 = cvt_pk_bf16(P[BASE + 0], P[BASE + 1]), a1 = cvt_pk_bf16(P[BASE + 2], P[BASE + 3]);   \
    unsigned b0 = cvt_pk_bf16(P[BASE + 4], P[BASE + 5]), b1 = cvt_pk_bf16(P[BASE + 6], P[BASE + 7]);                              \
    auto r0 = __builtin_amdgcn_permlane32_swap(a0, b0, false, false); auto r1 = __builtin_amdgcn_permlane32_swap(a1, b1, false, false); \
    u32x4 w = {r0[0], r1[0], r0[1], r1[1]}; OUT = *reinterpret_cast<bf16x8*>(&w); } while (0)
  PK4(p0, 0, pa0); PK4(p0, 8, pa1); PK4(p1, 0, pa2); PK4(p1, 8, pa3);
#undef PK4
}
__device__ __forceinline__ void qkt(f32x16& p0, f32x16& p1, const char* Ks, const char* Rs, const bf16x8* qr, int r32, int hi, bool masked) {
  p0 = f32x16{}; p1 = f32x16{};
#pragma unroll
  for (int d0 = 0; d0 < 8; ++d0) { int cb = (d0 * 16 + hi * 8) * 2;
    bf16x8 b0 = *reinterpret_cast<const bf16x8*>(Ks + KSWZ(r32, cb));
    bf16x8 b1 = *reinterpret_cast<const bf16x8*>(Ks + KSWZ(32 + r32, cb));
    p0 = __builtin_amdgcn_mfma_f32_32x32x16_bf16(b0, qr[d0], p0, 0, 0, 0);
    p1 = __builtin_amdgcn_mfma_f32_32x32x16_bf16(b1, qr[d0], p1, 0, 0, 0); }
#pragma unroll
  for (int d0 = 0; d0 < 4; ++d0) { int cb = (d0 * 16 + hi * 8) * 2;
    bf16x8 b0 = *reinterpret_cast<const bf16x8*>(Rs + RSWZ(r32, cb));
    bf16x8 b1 = *reinterpret_cast<const bf16x8*>(Rs + RSWZ(32 + r32, cb));
    p0 = __builtin_amdgcn_mfma_f32_32x32x16_bf16(b0, qr[8 + d0], p0, 0, 0, 0);
    p1 = __builtin_amdgcn_mfma_f32_32x32x16_bf16(b1, qr[8 + d0], p1, 0, 0, 0); }
  (void)masked;
}
__device__ __forceinline__ int v_st(int k, int c) { const int kk = (k & ~0xC) | ((k & 4) << 1) | ((k & 8) >> 1); return ((kk >> 3) * 4 + (c >> 5)) * 512 + ((kk & 7) * 32 + (c & 31)) * 2; }
__device__ __forceinline__ int v_rd_base(int lane) { return ((lane & 3) << 3) | (((lane >> 2) & 3) << 6) | (((lane >> 4) & 1) << 5) | (((lane >> 5) & 1) << 8); }
constexpr int v_rd_off(int d0, int ks, int half) { return d0 * 512 + ks * 4096 + half * 2048; }
template <int OFF> __device__ __forceinline__ s16x4 tr_read(int vb) {
  s16x4 r; asm volatile("ds_read_b64_tr_b16 %0, %1 offset:%2" : "=&v"(r) : "v"(vb), "i"(OFF) : "memory"); return r;
}
template <int D0> __device__ __forceinline__ void pv_one(f32x16& od, int vb, bf16x8 pa0, bf16x8 pa1, bf16x8 pa2, bf16x8 pa3) {
  const s16x4 l0 = tr_read<v_rd_off(D0, 0, 0)>(vb), h0 = tr_read<v_rd_off(D0, 0, 1)>(vb), l1 = tr_read<v_rd_off(D0, 1, 0)>(vb), h1 = tr_read<v_rd_off(D0, 1, 1)>(vb);
  const s16x4 l2 = tr_read<v_rd_off(D0, 2, 0)>(vb), h2 = tr_read<v_rd_off(D0, 2, 1)>(vb), l3 = tr_read<v_rd_off(D0, 3, 0)>(vb), h3 = tr_read<v_rd_off(D0, 3, 1)>(vb);
  asm volatile("s_waitcnt lgkmcnt(0)" ::: "memory"); SBAR();
#define PK(L, H) (bf16x8){L[0], L[1], L[2], L[3], H[0], H[1], H[2], H[3]}
  od = __builtin_amdgcn_mfma_f32_32x32x16_bf16(pa0, PK(l0, h0), od, 0, 0, 0);
  od = __builtin_amdgcn_mfma_f32_32x32x16_bf16(pa1, PK(l1, h1), od, 0, 0, 0);
  od = __builtin_amdgcn_mfma_f32_32x32x16_bf16(pa2, PK(l2, h2), od, 0, 0, 0);
  od = __builtin_amdgcn_mfma_f32_32x32x16_bf16(pa3, PK(l3, h3), od, 0, 0, 0);
#undef PK
}
__device__ __forceinline__ void pv_d0(f32x16* o, int vb, bf16x8 pa0, bf16x8 pa1, bf16x8 pa2, bf16x8 pa3) {
  pv_one<0>(o[0], vb, pa0, pa1, pa2, pa3); pv_one<1>(o[1], vb, pa0, pa1, pa2, pa3); pv_one<2>(o[2], vb, pa0, pa1, pa2, pa3); pv_one<3>(o[3], vb, pa0, pa1, pa2, pa3);
}

#define PK(L, H) (bf16x8){L[0], L[1], L[2], L[3], H[0], H[1], H[2], H[3]}
#define PV_READ(D0, S) const s16x4 l0##S = tr_read<v_rd_off(D0, 0, 0)>(vb), h0##S = tr_read<v_rd_off(D0, 0, 1)>(vb), l1##S = tr_read<v_rd_off(D0, 1, 0)>(vb), h1##S = tr_read<v_rd_off(D0, 1, 1)>(vb), \
    l2##S = tr_read<v_rd_off(D0, 2, 0)>(vb), h2##S = tr_read<v_rd_off(D0, 2, 1)>(vb), l3##S = tr_read<v_rd_off(D0, 3, 0)>(vb), h3##S = tr_read<v_rd_off(D0, 3, 1)>(vb)
#define PV_MMA(D0, S) do { o[D0] = __builtin_amdgcn_mfma_f32_32x32x16_bf16(pa0, PK(l0##S, h0##S), o[D0], 0, 0, 0); o[D0] = __builtin_amdgcn_mfma_f32_32x32x16_bf16(pa1, PK(l1##S, h1##S), o[D0], 0, 0, 0); \
    o[D0] = __builtin_amdgcn_mfma_f32_32x32x16_bf16(pa2, PK(l2##S, h2##S), o[D0], 0, 0, 0); o[D0] = __builtin_amdgcn_mfma_f32_32x32x16_bf16(pa3, PK(l3##S, h3##S), o[D0], 0, 0, 0); } while (0)
__device__ __forceinline__ void pv_pipe(f32x16* o, int vb, bf16x8 pa0, bf16x8 pa1, bf16x8 pa2, bf16x8 pa3) {
  PV_READ(0, a); PV_READ(1, b);
  asm volatile("s_waitcnt lgkmcnt(8)" ::: "memory"); SBAR(); PV_MMA(0, a); SBAR();
  PV_READ(2, c);
  asm volatile("s_waitcnt lgkmcnt(8)" ::: "memory"); SBAR(); PV_MMA(1, b); SBAR();
  PV_READ(3, d);
  asm volatile("s_waitcnt lgkmcnt(8)" ::: "memory"); SBAR(); PV_MMA(2, c); SBAR();
  asm volatile("s_waitcnt lgkmcnt(0)" ::: "memory"); SBAR(); PV_MMA(3, d);
}
#undef PV_READ
#undef PV_MMA
#undef PK

constexpr int STG = SHM_V + SHM_K + SHM_R;
constexpr int OFF_WS3 = 3 * STG;
__device__ __forceinline__ void attn_block(const bf16_t* __restrict__ Qb, const bf16_t* __restrict__ Kh, const bf16_t* __restrict__ Vh, const bf16_t* __restrict__ Rh,
                                           float* __restrict__ Ob, int qb, char* lds) {
  const int tid = threadIdx.x, wid = __builtin_amdgcn_readfirstlane(tid >> 6), lane = tid & 63, r32 = lane & 31, hi = lane >> 5;
  float* ws = (float*)(lds + OFF_WS3) + wid * 64; float* li_l = ws; float* al_l = ws + 32;
  float l_reg = 0; f32x16 o[4] = {}; bf16x8 qr[12];
  const bf16_t* Qw = Qb + (long)(wid * QBLK + r32) * LDQ + hi * 8;
#pragma unroll
  for (int d0 = 0; d0 < 12; ++d0) qr[d0] = *reinterpret_cast<const bf16x8*>(Qw + d0 * 16);
  unsigned kof[2], vof[2], rof;
#pragma unroll
  for (int u = 0; u < 2; ++u) { const int c = 2 * wid + u;
    { const int row = 4 * c + (lane >> 4), slot = lane & 15; kof[u] = (unsigned)(row * 256 + ((slot ^ (row & 15)) << 4)); }
    { const int sub = 2 * c + (lane >> 5), i5 = lane & 31, kk = (sub >> 2) * 8 + (i5 >> 2), col = (sub & 3) * 32 + (i5 & 3) * 8, k = (kk & ~0xC) | ((kk & 4) << 1) | ((kk & 8) >> 1); vof[u] = (unsigned)(k * 256 + col * 2); } }
  { const int row = 8 * wid + (lane >> 3), slot = lane & 7; rof = (unsigned)(row * 128 + ((slot ^ ((row >> 1) & 7)) << 4)); }
  const int wchunk = wid >> 1, t0 = 4 * qb, NT = 4 * qb + 4;
  const LAS unsigned char* ldsb = (const LAS unsigned char*)lds;
#define DMA(tile, st) do { const char* kp = (const char*)Kh + (size_t)(tile) * (KVBLK * 256); const char* vp = (const char*)Vh + (size_t)(tile) * (KVBLK * 256); const char* rp = (const char*)Rh + (size_t)(tile) * (KVBLK * 128); \
    LAS unsigned char* sb = (LAS unsigned char*)ldsb + (st) * STG; \
    __builtin_amdgcn_global_load_lds((const unsigned*)(vp + vof[0]), (LAS unsigned*)(sb + (2 * wid) * 1024), 16, 0, 0); __builtin_amdgcn_global_load_lds((const unsigned*)(vp + vof[1]), (LAS unsigned*)(sb + (2 * wid + 1) * 1024), 16, 0, 0); \
    __builtin_amdgcn_global_load_lds((const unsigned*)(kp + kof[0]), (LAS unsigned*)(sb + SHM_V + (2 * wid) * 1024), 16, 0, 0); __builtin_amdgcn_global_load_lds((const unsigned*)(kp + kof[1]), (LAS unsigned*)(sb + SHM_V + (2 * wid + 1) * 1024), 16, 0, 0); \
    __builtin_amdgcn_global_load_lds((const unsigned*)(rp + rof), (LAS unsigned*)(sb + SHM_V + SHM_K + wid * 1024), 16, 0, 0); } while (0)
#define RESC(a) do { if (__any((a) < 1.f)) { if (hi == 0) al_l[r32] = (a); asm volatile("s_waitcnt lgkmcnt(0)" ::: "memory"); \
    _Pragma("unroll") for (int d = 0; d < 4; ++d) _Pragma("unroll") for (int r = 0; r < 16; ++r) o[d][r] *= al_l[crow(r, hi)]; } } while (0)
#define MASKED(j) (((j) - t0) > wchunk)
  f32x16 p0, p1; bf16x8 pa0, pa1, pa2, pa3;
  DMA(0, 0); DMA(1, 1);
  asm volatile("s_waitcnt vmcnt(5)" ::: "memory"); __builtin_amdgcn_s_barrier(); asm volatile("" ::: "memory");
  int st = 0;
#pragma unroll 1
  for (int j = 0; j < NT; ++j) {
    const bool more = (j + 2 < NT);
    if (more) { const int st2 = (st >= 1) ? st - 1 : 2; DMA(j + 2, st2); }
    char* sb = lds + st * STG;
    if (!MASKED(j)) {
      SBAR(); qkt(p0, p1, sb + SHM_V, sb + SHM_V + SHM_K, qr, r32, hi, false);
      softmax_nomax(p0, p1, l_reg, pa0, pa1, pa2, pa3); SBAR();
      pv_pipe(o, (int)(uintptr_t)sb + v_rd_base(lane), pa0, pa1, pa2, pa3);
    }
    if (more) asm volatile("s_waitcnt vmcnt(5)" ::: "memory"); else asm volatile("s_waitcnt vmcnt(0)" ::: "memory");
    __builtin_amdgcn_s_barrier(); asm volatile("" ::: "memory");
    st = (st == 2) ? 0 : st + 1;
  }
  { auto rr = __builtin_amdgcn_permlane32_swap(__float_as_uint(l_reg), __float_as_uint(l_reg), false, false); l_reg = __uint_as_float(rr[0]) + __uint_as_float(rr[1]); }
  if (hi == 0) li_l[r32] = l_reg; asm volatile("s_waitcnt lgkmcnt(0)" ::: "memory");
  float rli[16];
#pragma unroll
  for (int r = 0; r < 16; ++r) rli[r] = __builtin_amdgcn_rcpf(li_l[crow(r, hi)]);
  float* Ow = Ob + (long)(wid * QBLK) * LDO;
#pragma unroll
  for (int r = 0; r < 16; ++r) { int orow = crow(r, hi);
#pragma unroll
    for (int d0 = 0; d0 < 4; ++d0) Ow[(long)orow * LDO + d0 * 32 + r32] = o[d0][r] * rli[r]; }
#undef DMA
#undef RESC
#undef MASKED
}

constexpr int S8_V = 16384, S8_K = 8192, S8_R = 4096, STG8 = S8_V + S8_K + S8_R, OFF_WS8 = 3 * STG8;
#define KS8(row, b) ((row) * 128 + ((b) ^ ((((row) >> 1) & 7) << 4)))
#define RS8(row, b) ((row) * 64 + ((b) ^ ((((row) >> 2) & 3) << 4)))
typedef int v8i_a __attribute__((ext_vector_type(8)));
typedef int v4i_a __attribute__((ext_vector_type(4)));
__device__ __forceinline__ v8i_a ld32(const char* p0, const char* p1) { const v4i_a a = *reinterpret_cast<const v4i_a*>(p0), b = *reinterpret_cast<const v4i_a*>(p1); return __builtin_shufflevector(a, b, 0, 1, 2, 3, 4, 5, 6, 7); }
__device__ __forceinline__ void qkt8(f32x16& p0, f32x16& p1, const char* Ks, const char* Rs, const v8i_a* qf, int r32, int hi, float init = 0.f) {
#pragma unroll
  for (int r = 0; r < 16; ++r) { p0[r] = init; p1[r] = init; }
#pragma unroll
  for (int s = 0; s < 2; ++s) { const int b0 = 64 * s + 32 * hi;
    const v8i_a a0 = ld32(Ks + KS8(r32, b0), Ks + KS8(r32, b0 + 16)), a1 = ld32(Ks + KS8(32 + r32, b0), Ks + KS8(32 + r32, b0 + 16));
    p0 = __builtin_amdgcn_mfma_scale_f32_32x32x64_f8f6f4(a0, qf[s], p0, 0, 0, 0, 0, 0, 0);
    p1 = __builtin_amdgcn_mfma_scale_f32_32x32x64_f8f6f4(a1, qf[s], p1, 0, 0, 0, 0, 0, 0); }
  { const int b0 = 32 * hi;
    const v8i_a a0 = ld32(Rs + RS8(r32, b0), Rs + RS8(r32, b0 + 16)), a1 = ld32(Rs + RS8(32 + r32, b0), Rs + RS8(32 + r32, b0 + 16));
    p0 = __builtin_amdgcn_mfma_scale_f32_32x32x64_f8f6f4(a0, qf[2], p0, 0, 0, 0, 0, 0, 0);
    p1 = __builtin_amdgcn_mfma_scale_f32_32x32x64_f8f6f4(a1, qf[2], p1, 0, 0, 0, 0, 0, 0); }
}
__device__ __forceinline__ void attn_block8(const unsigned char* __restrict__ Qb, const unsigned char* __restrict__ Kh, const bf16_t* __restrict__ Vh, const unsigned char* __restrict__ Rh,
                                            float* __restrict__ Ob, int qb, char* lds) {
  const int tid = threadIdx.x, wid = __builtin_amdgcn_readfirstlane(tid >> 6), lane = tid & 63, r32 = lane & 31, hi = lane >> 5;
  float* ws = (float*)(lds + OFF_WS8) + wid * 64; float* li_l = ws;
  float l_reg = 0; f32x16 o[4] = {}; v8i_a qf[3];
  { const unsigned char* Qw = Qb + (long)(wid * QBLK + r32) * 192 + 32 * hi;
#pragma unroll
    for (int s = 0; s < 3; ++s) { const v4i_a a = *reinterpret_cast<const v4i_a*>(Qw + 64 * s), b = *reinterpret_cast<const v4i_a*>(Qw + 64 * s + 16); qf[s] = __builtin_shufflevector(a, b, 0, 1, 2, 3, 4, 5, 6, 7); } }
  unsigned vof[2], kof, rof;
#pragma unroll
  for (int u = 0; u < 2; ++u) { const int c = 2 * wid + u;
    const int sub = 2 * c + (lane >> 5), i5 = lane & 31, kk = (sub >> 2) * 8 + (i5 >> 2), col = (sub & 3) * 32 + (i5 & 3) * 8, k = (kk & ~0xC) | ((kk & 4) << 1) | ((kk & 8) >> 1); vof[u] = (unsigned)(k * 256 + col * 2); }
  { const int row = 8 * wid + (lane >> 3), slot = lane & 7; kof = (unsigned)(row * 128 + ((slot ^ ((row >> 1) & 7)) << 4)); }
  { const int row = 16 * (wid & 3) + (lane >> 2), slot = lane & 3; rof = (unsigned)(row * 64 + ((slot ^ ((row >> 2) & 3)) << 4)); }
  const int wchunk = wid >> 1, t0 = 4 * qb, NT = 4 * qb + 4;
  const LAS unsigned char* ldsb = (const LAS unsigned char*)lds;
#define DMA8(tile, st) do { const char* kp = (const char*)Kh + (size_t)(tile) * (KVBLK * 128); const char* vp = (const char*)Vh + (size_t)(tile) * (KVBLK * 256); const char* rp = (const char*)Rh + (size_t)(tile) * (KVBLK * 64); \
    LAS unsigned char* sb_ = (LAS unsigned char*)ldsb + (st) * STG8; \
    __builtin_amdgcn_global_load_lds((const unsigned*)(vp + vof[0]), (LAS unsigned*)(sb_ + (2 * wid) * 1024), 16, 0, 0); __builtin_amdgcn_global_load_lds((const unsigned*)(vp + vof[1]), (LAS unsigned*)(sb_ + (2 * wid + 1) * 1024), 16, 0, 0); \
    __builtin_amdgcn_global_load_lds((const unsigned*)(kp + kof), (LAS unsigned*)(sb_ + S8_V + wid * 1024), 16, 0, 0); \
    __builtin_amdgcn_global_load_lds((const unsigned*)(rp + rof), (LAS unsigned*)(sb_ + S8_V + S8_K + (wid & 3) * 1024), 16, 0, 0); } while (0)
#define MASKED(j) (((j) - t0) > wchunk)
  f32x16 p0, p1; bf16x8 pa0, pa1, pa2, pa3;
  DMA8(0, 0); DMA8(1, 1);
  asm volatile("s_waitcnt vmcnt(4)" ::: "memory"); __builtin_amdgcn_s_barrier(); asm volatile("" ::: "memory");
  int st = 0;
#pragma unroll 1
  for (int j = 0; j < NT; ++j) {
    const bool more = (j + 2 < NT);
    if (more) { const int st2 = (st >= 1) ? st - 1 : 2; DMA8(j + 2, st2); }
    char* sb = lds + st * STG8;
    if (!MASKED(j)) {
      SBAR(); qkt8(p0, p1, sb + S8_V, sb + S8_V + S8_K, qf, r32, hi);
      softmax_nomax(p0, p1, l_reg, pa0, pa1, pa2, pa3); SBAR();
      pv_pipe(o, (int)(uintptr_t)sb + v_rd_base(lane), pa0, pa1, pa2, pa3);
    }
    if (more) asm volatile("s_waitcnt vmcnt(4)" ::: "memory"); else asm volatile("s_waitcnt vmcnt(0)" ::: "memory");
    __builtin_amdgcn_s_barrier(); asm volatile("" ::: "memory");
    st = (st == 2) ? 0 : st + 1;
  }
  { auto rr = __builtin_amdgcn_permlane32_swap(__float_as_uint(l_reg), __float_as_uint(l_reg), false, false); l_reg = __uint_as_float(rr[0]) + __uint_as_float(rr[1]); }
  if (hi == 0) li_l[r32] = l_reg; asm volatile("s_waitcnt lgkmcnt(0)" ::: "memory");
  float rli[16];
#pragma unroll
  for (int r = 0; r < 16; ++r) rli[r] = __builtin_amdgcn_rcpf(li_l[crow(r, hi)]);
  float* Ow = Ob + (long)(wid * QBLK) * LDO;
#pragma unroll
  for (int r = 0; r < 16; ++r) { int orow = crow(r, hi);
#pragma unroll
    for (int d0 = 0; d0 < 4; ++d0) Ow[(long)orow * LDO + d0 * 32 + r32] = o[d0][r] * rli[r]; }
#undef DMA8
#undef MASKED
}

constexpr int T8_V = 8192, T8_K = 8192, T8_R = 4096, STG9 = T8_V + T8_K + T8_R, OFF_WS9 = 3 * STG9;
#define VS8(d, b) ((d) * 64 + ((b) ^ ((((d) >> 2) & 3) << 4)))
template <int ABL = 0> __device__ __forceinline__ void attn_block9(const unsigned char* __restrict__ Qb, const unsigned char* __restrict__ Kh, const unsigned char* __restrict__ Vt, const unsigned char* __restrict__ Rh,
                                            float* __restrict__ Ob, int qb, char* lds) {
  const int tid = threadIdx.x, wid = __builtin_amdgcn_readfirstlane(tid >> 6), lane = tid & 63, r32 = lane & 31, hi = lane >> 5;
  float* ws = (float*)(lds + OFF_WS9) + wid * 64; float* li_l = ws;
  float l_reg = 0; f32x16 o[4] = {}; v8i_a qf[3];
  { const unsigned char* Qw = Qb + (long)(wid * QBLK + r32) * 192 + 32 * hi;
#pragma unroll
    for (int s = 0; s < 3; ++s) { const v4i_a a = *reinterpret_cast<const v4i_a*>(Qw + 64 * s), b = *reinterpret_cast<const v4i_a*>(Qw + 64 * s + 16); qf[s] = __builtin_shufflevector(a, b, 0, 1, 2, 3, 4, 5, 6, 7); } }
  unsigned kof, rof; const unsigned vof = (unsigned)(wid * 1024 + lane * 16);
  { const int row = 8 * wid + (lane >> 3), slot = lane & 7; kof = (unsigned)(row * 128 + ((slot ^ ((row >> 1) & 7)) << 4)); }
  { const int row = 16 * (wid & 3) + (lane >> 2), slot = lane & 3; rof = (unsigned)(row * 64 + ((slot ^ ((row >> 2) & 3)) << 4)); }
  const int wchunk = wid >> 1, t0 = 4 * qb, NT = 4 * qb + 4;
  const LAS unsigned char* ldsb = (const LAS unsigned char*)lds;
#define DMA9(tile, st) do { const char* kp = (const char*)Kh + (size_t)(tile) * (KVBLK * 128); const char* vp = (const char*)Vt + (size_t)(tile) * 8192; const char* rp = (const char*)Rh + (size_t)(tile) * (KVBLK * 64); \
    LAS unsigned char* sb_ = (LAS unsigned char*)ldsb + (st) * STG9; \
    __builtin_amdgcn_global_load_lds((const unsigned*)(vp + vof), (LAS unsigned*)(sb_ + wid * 1024), 16, 0, 0); \
    __builtin_amdgcn_global_load_lds((const unsigned*)(kp + kof), (LAS unsigned*)(sb_ + T8_V + wid * 1024), 16, 0, 0); \
    __builtin_amdgcn_global_load_lds((const unsigned*)(rp + rof), (LAS unsigned*)(sb_ + T8_V + T8_K + (wid & 3) * 1024), 16, 0, 0); } while (0)
#define MASKED(j) (((j) - t0) > wchunk)
  f32x16 p0, p1; v8i_a P8 = {0, 0, 0, 0, 0, 0, 0, 0};
#ifndef ATT_DEPHASE
#define ATT_DEPHASE 0
#endif
#if ATT_DEPHASE
  const int half = wid >> 2;
  DMA9(0, 0); DMA9(1, 1);
  asm volatile("s_waitcnt vmcnt(3)" ::: "memory"); __builtin_amdgcn_s_barrier(); asm volatile("" ::: "memory");
  f32x16 cinit;
#pragma unroll
  for (int r = 0; r < 16; ++r) cinit[r] = -2.0f;
  asm volatile("" : "+v"(cinit));
  if (half == 1) { __builtin_amdgcn_s_barrier(); asm volatile("" ::: "memory"); }
  int st = 0;
#pragma unroll 1
  for (int j = 0; j < NT; ++j) {
    char* sb = lds + st * STG9; const bool live = !MASKED(j);
    v8i_a vf[4];
    if (live) {
      const char* Ks = sb + T8_V; const char* Rs = sb + T8_V + T8_K;
      SBAR();
      v8i_a kf[6];
#pragma unroll
      for (int s2 = 0; s2 < 2; ++s2) { const int b0 = 64 * s2 + 32 * hi;
        kf[2 * s2] = ld32(Ks + KS8(r32, b0), Ks + KS8(r32, b0 + 16)); kf[2 * s2 + 1] = ld32(Ks + KS8(32 + r32, b0), Ks + KS8(32 + r32, b0 + 16)); }
      kf[4] = ld32(Rs + RS8(r32, 32 * hi), Rs + RS8(r32, 32 * hi + 16)); kf[5] = ld32(Rs + RS8(32 + r32, 32 * hi), Rs + RS8(32 + r32, 32 * hi + 16));
      SBAR();
      p0 = __builtin_amdgcn_mfma_scale_f32_32x32x64_f8f6f4(kf[0], qf[0], cinit, 0, 0, 0, 0, 0, 0);
      p1 = __builtin_amdgcn_mfma_scale_f32_32x32x64_f8f6f4(kf[1], qf[0], cinit, 0, 0, 0, 0, 0, 0);
      p0 = __builtin_amdgcn_mfma_scale_f32_32x32x64_f8f6f4(kf[2], qf[1], p0, 0, 0, 0, 0, 0, 0);
      p1 = __builtin_amdgcn_mfma_scale_f32_32x32x64_f8f6f4(kf[3], qf[1], p1, 0, 0, 0, 0, 0, 0);
      p0 = __builtin_amdgcn_mfma_scale_f32_32x32x64_f8f6f4(kf[4], qf[2], p0, 0, 0, 0, 0, 0, 0);
      p1 = __builtin_amdgcn_mfma_scale_f32_32x32x64_f8f6f4(kf[5], qf[2], p1, 0, 0, 0, 0, 0, 0);
      SBAR();
#pragma unroll
      for (int d0 = 0; d0 < 4; ++d0) { const int d = d0 * 32 + r32; vf[d0] = ld32(sb + VS8(d, 32 * hi), sb + VS8(d, 32 * hi + 16)); }
      SBAR();
      float ps = 0;
#pragma unroll
      for (int r = 0; r < 16; ++r) { p0[r] = fminf(__builtin_amdgcn_exp2f(p0[r]), 448.0f); ps += p0[r]; }
      l_reg += ps;
      P8[0] = (int)pk4_fp8(p0[0], p0[1], p0[2], p0[3]); P8[1] = (int)pk4_fp8(p0[4], p0[5], p0[6], p0[7]); P8[2] = (int)pk4_fp8(p0[8], p0[9], p0[10], p0[11]); P8[3] = (int)pk4_fp8(p0[12], p0[13], p0[14], p0[15]);
      SBAR(); }
    asm volatile("s_waitcnt vmcnt(0)" ::: "memory");
    __builtin_amdgcn_s_barrier(); asm volatile("" ::: "memory");
    if (j + 2 < NT) { const int st2 = (st >= 1) ? st - 1 : 2; DMA9(j + 2, st2); }
    if (live) {
      SBAR();
      float ps = 0;
#pragma unroll
      for (int r = 0; r < 16; ++r) { p1[r] = fminf(__builtin_amdgcn_exp2f(p1[r]), 448.0f); ps += p1[r]; }
      l_reg += ps;
      P8[4] = (int)pk4_fp8(p1[0], p1[1], p1[2], p1[3]); P8[5] = (int)pk4_fp8(p1[4], p1[5], p1[6], p1[7]); P8[6] = (int)pk4_fp8(p1[8], p1[9], p1[10], p1[11]); P8[7] = (int)pk4_fp8(p1[12], p1[13], p1[14], p1[15]);
      SBAR();
#pragma unroll
      for (int d0 = 0; d0 < 4; ++d0) o[d0] = __builtin_amdgcn_mfma_scale_f32_32x32x64_f8f6f4(P8, vf[d0], o[d0], 0, 0, 0, 0, 0, 0);
      SBAR(); }
    __builtin_amdgcn_s_barrier(); asm volatile("" ::: "memory");
    st = (st == 2) ? 0 : st + 1;
  }
  if (half == 0) { __builtin_amdgcn_s_barrier(); asm volatile("" ::: "memory"); }
#else
#define DMA9V(tile, st) __builtin_amdgcn_global_load_lds((const unsigned*)((const char*)Vt + (size_t)(tile) * 8192 + vof), (LAS unsigned*)((LAS unsigned char*)ldsb + (st) * STG9 + wid * 1024), 16, 0, 0)
#define DMA9K(tile, st) __builtin_amdgcn_global_load_lds((const unsigned*)((const char*)Kh + (size_t)(tile) * (KVBLK * 128) + kof), (LAS unsigned*)((LAS unsigned char*)ldsb + (st) * STG9 + T8_V + wid * 1024), 16, 0, 0)
#define DMA9R(tile, st) __builtin_amdgcn_global_load_lds((const unsigned*)((const char*)Rh + (size_t)(tile) * (KVBLK * 64) + rof), (LAS unsigned*)((LAS unsigned char*)ldsb + (st) * STG9 + T8_V + T8_K + (wid & 3) * 1024), 16, 0, 0)
  const bool rdma = (wid < 4);
  DMA9V(0, 0); DMA9K(0, 0); if (rdma) DMA9R(0, 0);
  DMA9V(1, 1); DMA9K(1, 1); if (rdma) DMA9R(1, 1);
  if (rdma) asm volatile("s_waitcnt vmcnt(3)" ::: "memory"); else asm volatile("s_waitcnt vmcnt(2)" ::: "memory");
  __builtin_amdgcn_s_barrier(); asm volatile("" ::: "memory");
  f32x16 osum = {};
  v8i_a ones = {0x38383838, 0x38383838, 0x38383838, 0x38383838, 0x38383838, 0x38383838, 0x38383838, 0x38383838};
  asm volatile("" : "+v"(ones));
  int st = 0, j = 0;
#pragma unroll 1
  for (; j < t0; ++j) {
    const int st2 = (st >= 1) ? st - 1 : 2;
    if constexpr (ABL != 2) DMA9V(j + 2, st2);
    char* sb = lds + st * STG9;
      { const char* Ks = sb + T8_V; const char* Rs = sb + T8_V + T8_K;
      SBAR();
      v8i_a kf[6];
#pragma unroll
      for (int s2 = 0; s2 < 2; ++s2) { const int b0 = 64 * s2 + 32 * hi;
        kf[2 * s2] = ld32(Ks + KS8(r32, b0), Ks + KS8(r32, b0 + 16)); kf[2 * s2 + 1] = ld32(Ks + KS8(32 + r32, b0), Ks + KS8(32 + r32, b0 + 16)); }
      kf[4] = ld32(Rs + RS8(r32, 32 * hi), Rs + RS8(r32, 32 * hi + 16)); kf[5] = ld32(Rs + RS8(32 + r32, 32 * hi), Rs + RS8(32 + r32, 32 * hi + 16));
      SBAR();
#pragma unroll
      for (int r = 0; r < 16; ++r) { p0[r] = 40.25f; p1[r] = 40.25f; }
      p0 = __builtin_amdgcn_mfma_scale_f32_32x32x64_f8f6f4(kf[0], qf[0], p0, 0, 0, 0, 0, 0, 0);
      p1 = __builtin_amdgcn_mfma_scale_f32_32x32x64_f8f6f4(kf[1], qf[0], p1, 0, 0, 0, 0, 0, 0);
      p0 = __builtin_amdgcn_mfma_scale_f32_32x32x64_f8f6f4(kf[2], qf[1], p0, 0, 0, 0, 0, 0, 0);
      p1 = __builtin_amdgcn_mfma_scale_f32_32x32x64_f8f6f4(kf[3], qf[1], p1, 0, 0, 0, 0, 0, 0);
      p0 = __builtin_amdgcn_mfma_scale_f32_32x32x64_f8f6f4(kf[4], qf[2], p0, 0, 0, 0, 0, 0, 0);
      p1 = __builtin_amdgcn_mfma_scale_f32_32x32x64_f8f6f4(kf[5], qf[2], p1, 0, 0, 0, 0, 0, 0);
      SBAR();
      if constexpr (ABL != 2) { if (true) DMA9K(j + 2, st2); }
      v8i_a vf[4];
#pragma unroll
      for (int d0 = 0; d0 < 4; ++d0) { const int d = d0 * 32 + r32; vf[d0] = ld32(sb + VS8(d, 32 * hi), sb + VS8(d, 32 * hi + 16)); }
      SBAR();
#pragma unroll
      for (int k = 0; k < 4; ++k) { unsigned w0, w1; asm volatile("" : "=v"(w0), "=v"(w1));
#pragma unroll
        for (int b = 0; b < 4; ++b) { w0 = __builtin_amdgcn_cvt_pk_u8_f32(__builtin_amdgcn_fmed3f(p0[4 * k + b], 0.0f, 126.0f), b, w0); w1 = __builtin_amdgcn_cvt_pk_u8_f32(__builtin_amdgcn_fmed3f(p1[4 * k + b], 0.0f, 126.0f), b, w1); }
        P8[k] = (int)w0; P8[4 + k] = (int)w1; }
      SBAR();
      if constexpr (ABL != 2) { if (true && rdma) DMA9R(j + 2, st2); }
#pragma unroll
      for (int d0 = 0; d0 < 4; ++d0) o[d0] = __builtin_amdgcn_mfma_scale_f32_32x32x64_f8f6f4(P8, vf[d0], o[d0], 0, 0, 0, 0, 0, 0);
      osum = __builtin_amdgcn_mfma_scale_f32_32x32x64_f8f6f4(P8, ones, osum, 0, 0, 0, 0, 0, 0); }
    if (rdma) asm volatile("s_waitcnt vmcnt(3)" ::: "memory"); else asm volatile("s_waitcnt vmcnt(2)" ::: "memory");
    __builtin_amdgcn_s_barrier(); asm volatile("" ::: "memory");
    st = (st == 2) ? 0 : st + 1;
  }
#pragma unroll 1
  for (; j < NT; ++j) {
    const bool more = (j + 2 < NT); const int st2 = (st >= 1) ? st - 1 : 2;
    if constexpr (ABL != 2) { if (more) DMA9V(j + 2, st2); }
    char* sb = lds + st * STG9;
    if (!MASKED(j)) {
      { const char* Ks = sb + T8_V; const char* Rs = sb + T8_V + T8_K;
      SBAR();
      v8i_a kf[6];
#pragma unroll
      for (int s2 = 0; s2 < 2; ++s2) { const int b0 = 64 * s2 + 32 * hi;
        kf[2 * s2] = ld32(Ks + KS8(r32, b0), Ks + KS8(r32, b0 + 16)); kf[2 * s2 + 1] = ld32(Ks + KS8(32 + r32, b0), Ks + KS8(32 + r32, b0 + 16)); }
      kf[4] = ld32(Rs + RS8(r32, 32 * hi), Rs + RS8(r32, 32 * hi + 16)); kf[5] = ld32(Rs + RS8(32 + r32, 32 * hi), Rs + RS8(32 + r32, 32 * hi + 16));
      SBAR();
#pragma unroll
      for (int r = 0; r < 16; ++r) { p0[r] = 40.25f; p1[r] = 40.25f; }
      p0 = __builtin_amdgcn_mfma_scale_f32_32x32x64_f8f6f4(kf[0], qf[0], p0, 0, 0, 0, 0, 0, 0);
      p1 = __builtin_amdgcn_mfma_scale_f32_32x32x64_f8f6f4(kf[1], qf[0], p1, 0, 0, 0, 0, 0, 0);
      p0 = __builtin_amdgcn_mfma_scale_f32_32x32x64_f8f6f4(kf[2], qf[1], p0, 0, 0, 0, 0, 0, 0);
      p1 = __builtin_amdgcn_mfma_scale_f32_32x32x64_f8f6f4(kf[3], qf[1], p1, 0, 0, 0, 0, 0, 0);
      p0 = __builtin_amdgcn_mfma_scale_f32_32x32x64_f8f6f4(kf[4], qf[2], p0, 0, 0, 0, 0, 0, 0);
      p1 = __builtin_amdgcn_mfma_scale_f32_32x32x64_f8f6f4(kf[5], qf[2], p1, 0, 0, 0, 0, 0, 0);
      SBAR();
      if constexpr (ABL != 2) { if (more) DMA9K(j + 2, st2); }
      v8i_a vf[4];
#pragma unroll
      for (int d0 = 0; d0 < 4; ++d0) { const int d = d0 * 32 + r32; vf[d0] = ld32(sb + VS8(d, 32 * hi), sb + VS8(d, 32 * hi + 16)); }
      SBAR();
#pragma unroll
      for (int k = 0; k < 4; ++k) { unsigned w0, w1; asm volatile("" : "=v"(w0), "=v"(w1));
#pragma unroll
        for (int b = 0; b < 4; ++b) { w0 = __builtin_amdgcn_cvt_pk_u8_f32(__builtin_amdgcn_fmed3f(p0[4 * k + b], 0.0f, 126.0f), b, w0); w1 = __builtin_amdgcn_cvt_pk_u8_f32(__builtin_amdgcn_fmed3f(p1[4 * k + b], 0.0f, 126.0f), b, w1); }
        P8[k] = (int)w0; P8[4 + k] = (int)w1; }
      SBAR();
      if constexpr (ABL != 2) { if (more && rdma) DMA9R(j + 2, st2); }
#pragma unroll
      for (int d0 = 0; d0 < 4; ++d0) o[d0] = __builtin_amdgcn_mfma_scale_f32_32x32x64_f8f6f4(P8, vf[d0], o[d0], 0, 0, 0, 0, 0, 0);
      osum = __builtin_amdgcn_mfma_scale_f32_32x32x64_f8f6f4(P8, ones, osum, 0, 0, 0, 0, 0, 0); }
    } else {
      if constexpr (ABL != 2) { if (more) { DMA9K(j + 2, st2); if (rdma) DMA9R(j + 2, st2); } }
    }
    if (more) { if (rdma) asm volatile("s_waitcnt vmcnt(3)" ::: "memory"); else asm volatile("s_waitcnt vmcnt(2)" ::: "memory"); } else asm volatile("s_waitcnt vmcnt(0)" ::: "memory");
    __builtin_amdgcn_s_barrier(); asm volatile("" ::: "memory");
    st = (st == 2) ? 0 : st + 1;
  }
#undef DMA9V
#undef DMA9K
#undef DMA9R
#endif
#if ATT_DEPHASE
  { auto rr = __builtin_amdgcn_permlane32_swap(__float_as_uint(l_reg), __float_as_uint(l_reg), false, false); l_reg = __uint_as_float(rr[0]) + __uint_as_float(rr[1]); }
  if (hi == 0) li_l[r32] = l_reg; asm volatile("s_waitcnt lgkmcnt(0)" ::: "memory");
  float rli[16];
#pragma unroll
  for (int r = 0; r < 16; ++r) rli[r] = __builtin_amdgcn_rcpf(li_l[crow(r, hi)]);
#else
  float rli[16];
#pragma unroll
  for (int r = 0; r < 16; ++r) rli[r] = __builtin_amdgcn_rcpf(osum[r]);
  (void)li_l; (void)l_reg;
#endif
  float* Ow = Ob + (long)(wid * QBLK) * LDO;
  if (ABL == 0 || qb < 0) {
#pragma unroll
  for (int r = 0; r < 16; ++r) { int orow = crow(r, hi);
#pragma unroll
    for (int d0 = 0; d0 < 4; ++d0) Ow[(long)orow * LDO + d0 * 32 + r32] = o[d0][r] * rli[r]; } }
#undef DMA9
#undef MASKED
}
}

struct Ctx { int tid, lane, wave, vcu, G; LAS unsigned char* lds; };
#define LDS_FENCE() asm volatile("s_waitcnt lgkmcnt(0)" ::: "memory")

__device__ __forceinline__ void p0_mod_chunk(const Ctx& c, int chunk, const float* __restrict__ cvec, const float* __restrict__ w_ada, const float* __restrict__ b_ada, float* __restrict__ MOD) {
    const int n0 = chunk * 64, ncg = c.tid & 15, ks = c.tid >> 4;
    f32x4 a0 = {0.f, 0.f, 0.f, 0.f}, a1 = {0.f, 0.f, 0.f, 0.f};
#pragma unroll 8
    for (int k = ks; k < 2048; k += 32) {
        const f32x4 w = *(const f32x4*)(w_ada + (size_t)k * 12288 + n0 + 4 * ncg);
        const float c0 = cvec[k], c1 = cvec[2048 + k];
        const float s0 = c0 * sigmoidf_(c0), s1 = c1 * sigmoidf_(c1);
        a0 += s0 * w; a1 += s1 * w;
    }
    LAS float* red = (LAS float*)c.lds;
    *(LAS f32x4*)(red + (ks * 2 + 0) * 64 + 4 * ncg) = a0; *(LAS f32x4*)(red + (ks * 2 + 1) * 64 + 4 * ncg) = a1;
    __syncthreads();
    if (c.tid < 128) { const int b = c.tid >> 6, n = c.tid & 63; float s = 0.f;
#pragma unroll 8
        for (int k2 = 0; k2 < 32; ++k2) s += red[(k2 * 2 + b) * 64 + n];
        MOD[b * 12288 + n0 + n] = s + b_ada[n0 + n]; }
    __syncthreads();
}
__device__ __forceinline__ void p0_kc_item(const Ctx& c, int item, const float* __restrict__ A_re, const float* __restrict__ A_im, const float* __restrict__ B_re, const float* __restrict__ B_im,
                                           const float* __restrict__ C_re, const float* __restrict__ C_im, const float* __restrict__ Dv, const float* __restrict__ log_dt, float* __restrict__ KC, float* __restrict__ BB) {
    const int g = item >> 2, dq = item & 3;
    LAS float* Cre = (LAS float*)c.lds; LAS float* Cim = Cre + 1024; LAS float* Bre = Cim + 1024; LAS float* Bim = Bre + 1024; LAS float* Are = Bim + 1024; LAS float* Aim = Are + 1024;
    const float dt = expf(log_dt[g]);
    for (int idx = c.tid; idx < 1024; idx += 512) {
        { const int h = idx >> 6, p = idx & 63; Cre[idx] = C_re[(g * 16 + h) * 64 + p]; Cim[idx] = C_im[(g * 16 + h) * 64 + p]; }
        { const int p = idx >> 4, hh = idx & 15; const float are = A_re[g * 64 + p], aim = A_im[g * 64 + p];
          float cs, sn; sincos_d((double)dt * (double)aim, cs, sn); const float ex = expf(dt * are);
          const float nr = ex * cs - 1.0f, ni = ex * sn, den = are * are + aim * aim;
          const float cbr = (nr * are + ni * aim) / den, cbi = (ni * are - nr * aim) / den;
          const float br = B_re[(g * 64 + p) * 16 + hh], bi = B_im[(g * 64 + p) * 16 + hh];
          const float bbr = cbr * br - cbi * bi, bbi = cbr * bi + cbi * br;
          Bre[idx] = bbr; Bim[idx] = bbi;
          if (dq == 0) { BB[((size_t)(g * 64 + p) * 16 + hh) * 2] = bbr; BB[((size_t)(g * 64 + p) * 16 + hh) * 2 + 1] = bbi; } }
        { const int dd = idx >> 6, p = idx & 63, d = dq * 16 + dd; const float are = A_re[g * 64 + p], aim = A_im[g * 64 + p];
          float cs, sn; sincos_d((double)d * (double)dt * (double)aim, cs, sn); const float ex = expf((float)d * dt * are);
          Are[idx] = ex * cs; Aim[idx] = ex * sn; }
    }
    __syncthreads();
#pragma unroll 1
    for (int r = 0; r < 8; ++r) { const int e = c.tid + 512 * r, dd = e >> 8, h = (e >> 4) & 15, hh = e & 15; float s = 0.f;
#pragma unroll 8
        for (int p = 0; p < 64; ++p) { const float ar = Are[dd * 64 + p], ai = Aim[dd * 64 + p], br = Bre[p * 16 + hh], bi = Bim[p * 16 + hh];
            const float er = ar * br - ai * bi, ei = ar * bi + ai * br; s += Cre[h * 64 + p] * er - Cim[h * 64 + p] * ei; }
        const int d = dq * 16 + dd; if (d == 0 && h == hh) s += Dv[g * 16 + h];
        KC[((size_t)(g * 64 + d) * 16 + h) * 16 + hh] = s; }
    __syncthreads();
}
template <int MAP> __device__ __forceinline__ int rowmap(int n) {
    if (MAP == 1) { const int h = n / 192, d = n - h * 192; return d < 128 ? h * 128 + d : 1024 + h * 64 + (d - 128); }
    if (MAP == 2) { const int j = n >> 1, s = n & 1; return (j >> 7) * 256 + s * 128 + (j & 127); }
    return n;
}
template <int MAP> __device__ __forceinline__ void tr_item(const float* __restrict__ W, int N, const float* __restrict__ kscale, bf16_t* __restrict__ WT, int ldt, int kb, int nb, int lane) {
    const int kgrp = lane >> 3, nc = lane & 7, k0 = kb * 64 + 8 * kgrp;
    f32x4 v[2][8];
#pragma unroll
    for (int nn = 0; nn < 2; ++nn)
#pragma unroll
        for (int i = 0; i < 8; ++i) v[nn][i] = *(const f32x4*)(W + (size_t)(k0 + i) * N + nb * 64 + 32 * nn + 4 * nc);
    float sc[8];
#pragma unroll
    for (int i = 0; i < 8; ++i) sc[i] = kscale ? kscale[k0 + i] : 1.0f;
#pragma unroll
    for (int nn = 0; nn < 2; ++nn)
#pragma unroll
        for (int j = 0; j < 4; ++j) { const int row = rowmap<MAP>(nb * 64 + 32 * nn + 4 * nc + j);
            u32x4 w; w.x = cvt_pk_bf16(v[nn][0][j] * sc[0], v[nn][1][j] * sc[1]); w.y = cvt_pk_bf16(v[nn][2][j] * sc[2], v[nn][3][j] * sc[3]);
            w.z = cvt_pk_bf16(v[nn][4][j] * sc[4], v[nn][5][j] * sc[5]); w.w = cvt_pk_bf16(v[nn][6][j] * sc[6], v[nn][7][j] * sc[7]);
            *(u32x4*)(WT + (size_t)row * ldt + k0) = w; }
}

struct RowRaw { f32x4 v[8]; };
__device__ __forceinline__ RowRaw hnorm_load(const float* __restrict__ xrow, int lane) { RowRaw r;
#pragma unroll
    for (int j = 0; j < 8; ++j) r.v[j] = __builtin_nontemporal_load((const f32x4*)(xrow + 8 * lane + 512 * (j >> 1) + 4 * (j & 1)));
    return r; }
__device__ __forceinline__ float hnorm_proc(const RowRaw& r, bf16_t* __restrict__ hrow, const f32x4 (&fa)[8], const f32x4 (&fb)[8], int lane) {
    float ss = 0.f;
#pragma unroll
    for (int j = 0; j < 8; ++j) ss += (r.v[j][0] * r.v[j][0] + r.v[j][1] * r.v[j][1]) + (r.v[j][2] * r.v[j][2] + r.v[j][3] * r.v[j][3]);
    const float rstd = 1.0f / sqrtf(wave_sum(ss) * (1.0f / 2048.0f) + EPS);
#pragma unroll
    for (int jj = 0; jj < 4; ++jj) { const f32x4 y0 = r.v[2 * jj] * rstd * fa[2 * jj] + fb[2 * jj], y1 = r.v[2 * jj + 1] * rstd * fa[2 * jj + 1] + fb[2 * jj + 1];
        u32x4 w; w.x = cvt_pk_bf16(y0[0], y0[1]); w.y = cvt_pk_bf16(y0[2], y0[3]); w.z = cvt_pk_bf16(y1[0], y1[1]); w.w = cvt_pk_bf16(y1[2], y1[3]);
        *(u32x4*)(hrow + 8 * lane + 512 * jj) = w; }
    return rstd;
}
__device__ __forceinline__ float hnorm_row(const float* __restrict__ xrow, bf16_t* __restrict__ hrow, const f32x4 (&fa)[8], const f32x4 (&fb)[8], int lane) {
    const RowRaw r = hnorm_load(xrow, lane); return hnorm_proc(r, hrow, fa, fb, lane);
}

template <int MAP> __device__ __forceinline__ void tr_item8(const float* __restrict__ W, int N, unsigned char* __restrict__ WT, int ldt, int kb, int nb, int lane, const float* __restrict__ kscale = nullptr) {
    const int kgrp = lane >> 4, nc = lane & 15, k0 = kb * 128 + 32 * kgrp;
    f32x4 v[32];
#pragma unroll
    for (int i = 0; i < 32; ++i) v[i] = __builtin_nontemporal_load((const f32x4*)(W + (size_t)(k0 + i) * N + nb * 64 + 4 * nc));
    if (kscale) {
#pragma unroll
        for (int i = 0; i < 32; ++i) v[i] *= kscale[k0 + i]; }
#pragma unroll
    for (int j = 0; j < 4; ++j) { const int row = rowmap<MAP>(nb * 64 + 4 * nc + j);
#pragma unroll
        for (int hh = 0; hh < 2; ++hh) { const int q = 16 * hh;
            u32x4 w; w.x = pk4_fp8(v[q + 0][j] * W8_SCALE, v[q + 1][j] * W8_SCALE, v[q + 2][j] * W8_SCALE, v[q + 3][j] * W8_SCALE); w.y = pk4_fp8(v[q + 4][j] * W8_SCALE, v[q + 5][j] * W8_SCALE, v[q + 6][j] * W8_SCALE, v[q + 7][j] * W8_SCALE);
            w.z = pk4_fp8(v[q + 8][j] * W8_SCALE, v[q + 9][j] * W8_SCALE, v[q + 10][j] * W8_SCALE, v[q + 11][j] * W8_SCALE); w.w = pk4_fp8(v[q + 12][j] * W8_SCALE, v[q + 13][j] * W8_SCALE, v[q + 14][j] * W8_SCALE, v[q + 15][j] * W8_SCALE);
            *(u32x4*)(WT + (size_t)row * ldt + k0 + q) = w; } }
}
__device__ __forceinline__ float hnorm_row8(const float* __restrict__ xrow, unsigned char* __restrict__ hrow, const f32x4 (&fa)[8], const f32x4 (&fb)[8], int lane) {
    f32x4 v[8]; float ss = 0.f;
#pragma unroll
    for (int j = 0; j < 8; ++j) { v[j] = *(const f32x4*)(xrow + 4 * lane + 256 * j); ss += (v[j][0] * v[j][0] + v[j][1] * v[j][1]) + (v[j][2] * v[j][2] + v[j][3] * v[j][3]); }
    const float rstd = 1.0f / sqrtf(wave_sum(ss) * (1.0f / 2048.0f) + EPS);
#pragma unroll
    for (int j = 0; j < 8; ++j) { const f32x4 y = v[j] * rstd * fa[j] + fb[j]; *(unsigned*)(hrow + 4 * lane + 256 * j) = pk4_fp8(y[0], y[1], y[2], y[3]); }
    return rstd;
}

struct RowRawB { u32x4 w[4]; };
__device__ __forceinline__ RowRawB hnorm_b_load(const bf16_t* __restrict__ xrow, int lane) { RowRawB r;
#pragma unroll
    for (int j = 0; j < 4; ++j) r.w[j] = *(const u32x4*)(xrow + 8 * lane + 512 * j);
    return r; }
__device__ __forceinline__ float hnorm_b_proc(const RowRawB& r, unsigned char* __restrict__ hrow, const f32x4 (&fa)[4][2], const f32x4 (&fb)[4][2], int lane) {
    float v[4][8]; float ss = 0.f;
#pragma unroll
    for (int j = 0; j < 4; ++j) { const u32x4 w = r.w[j];
        v[j][0] = bflo(w[0]); v[j][1] = bfhi(w[0]); v[j][2] = bflo(w[1]); v[j][3] = bfhi(w[1]); v[j][4] = bflo(w[2]); v[j][5] = bfhi(w[2]); v[j][6] = bflo(w[3]); v[j][7] = bfhi(w[3]);
#pragma unroll
        for (int e = 0; e < 8; ++e) ss += v[j][e] * v[j][e]; }
    const float rstd = 1.0f / sqrtf(wave_sum(ss) * (1.0f / 2048.0f) + EPS);
#pragma unroll
    for (int j = 0; j < 4; ++j) { float y[8];
#pragma unroll
        for (int e = 0; e < 8; ++e) y[e] = v[j][e] * rstd * fa[j][e >> 2][e & 3] + fb[j][e >> 2][e & 3];
#if MOE_FP8
        u32x2 w; w.x = pk4_fp8(y[0], y[1], y[2], y[3]); w.y = pk4_fp8(y[4], y[5], y[6], y[7]); *(u32x2*)(hrow + 8 * lane + 512 * j) = w;
#else
        u32x4 w; w.x = cvt_pk_bf16(y[0], y[1]); w.y = cvt_pk_bf16(y[2], y[3]); w.z = cvt_pk_bf16(y[4], y[5]); w.w = cvt_pk_bf16(y[6], y[7]); *(u32x4*)((bf16_t*)hrow + 8 * lane + 512 * j) = w;
#endif
    }
    return rstd;
}

__device__ __forceinline__ void p4_carry_item(const Ctx& c, int item, const float* __restrict__ SEND, const float* __restrict__ A64, const float* __restrict__ A1024, bf16_t* __restrict__ AG) {
    const int g = item >> 2, b = (item >> 1) & 1, ph = item & 1, seg = c.tid >> 5, pl = c.tid & 31, p = ph * 32 + pl;
    const float ar = A64[(g * 64 + p) * 2], ai = A64[(g * 64 + p) * 2 + 1], qr = A1024[(g * 64 + p) * 2], qi = A1024[(g * 64 + p) * 2 + 1];
    float sre[16], sim[16];
#pragma unroll
    for (int i = 0; i < 16; ++i) { const size_t row = (size_t)(g * NCH + b * 256 + seg * 16 + i) * 128; sre[i] = SEND[row + p]; sim[i] = SEND[row + 64 + p]; }
    float lr = 0.f, li = 0.f;
#pragma unroll
    for (int i = 0; i < 16; ++i) { const float nr = ar * lr - ai * li + sre[i], ni = ar * li + ai * lr + sim[i]; lr = nr; li = ni; }
    LAS float* se = (LAS float*)c.lds;
    LAS float* ci = se + 1024;
    se[(seg * 32 + pl) * 2] = lr; se[(seg * 32 + pl) * 2 + 1] = li;
    __syncthreads();
    if (c.tid < 32) { float cr = 0.f, cim = 0.f;
#pragma unroll 1
        for (int s = 0; s < 16; ++s) { ci[(s * 32 + pl) * 2] = cr; ci[(s * 32 + pl) * 2 + 1] = cim; const float er = se[(s * 32 + pl) * 2], ei = se[(s * 32 + pl) * 2 + 1];
            const float nr = qr * cr - qi * cim + er, ni = qr * cim + qi * cr + ei; cr = nr; cim = ni; } }
    __syncthreads();
    float cr = ci[(seg * 32 + pl) * 2], cim = ci[(seg * 32 + pl) * 2 + 1];
#pragma unroll
    for (int i = 0; i < 16; ++i) { bf16_t* dst = AG + (size_t)(g * NCH + b * 256 + seg * 16 + i) * AGW; dst[p] = f2bf(cr); dst[64 + p] = f2bf(cim);
        const float nr = ar * cr - ai * cim + sre[i], ni = ar * cim + ai * cr + sim[i]; cr = nr; cim = ni; }
    __syncthreads();
}

constexpr float QSC = 0.07216878364870322f * 1.4426950408889634f;
constexpr float SQ8 = 0.3226727f;
constexpr float QMUL = ATT_FP8 ? (ATT_PV8 ? 8.0f * SQ8 : SQ8) : QSC, KMUL = ATT_FP8 ? SQ8 : 1.0f;
struct QkRaw { u32x4 zq; u32x2 zkv; unsigned zkr; u32x4 qn0, qn1, qr, kn0, kn1, v0, v1; f32x4 cq0, cq1, sq0, sq1; float ck, sk; };
struct QkGain { float qn[16], qr[8], kn[16], kr; };
__device__ __forceinline__ QkGain p4_gains(int lane, const float* __restrict__ q_nope_g, const float* __restrict__ q_rope_g, const float* __restrict__ k_nope_g, const float* __restrict__ k_rope_g) {
    QkGain g; const int s = lane & 7;
#pragma unroll
    for (int i = 0; i < 16; ++i) { g.qn[i] = q_nope_g[s * 16 + i] * QMUL; g.kn[i] = k_nope_g[s * 16 + i] * KMUL; }
#pragma unroll
    for (int i = 0; i < 8; ++i) g.qr[i] = q_rope_g[s * 8 + i] * QMUL;
    g.kr = k_rope_g[lane] * KMUL; return g;
}
__device__ __forceinline__ QkRaw p4_load(int t, int lane, const bf16_t* __restrict__ Z2, const bf16_t* __restrict__ QRAW, const bf16_t* __restrict__ KVRAW, const float* __restrict__ COS, const float* __restrict__ SIN) {
    QkRaw r; const int h = lane >> 3, s = lane & 7; const bf16_t* z = Z2 + (size_t)t * AGW;
    r.zq = *(const u32x4*)(z + lane * 8); r.zkv = *(const u32x2*)(z + 512 + lane * 4); r.zkr = z[768 + lane];
    const bf16_t* q = QRAW + (size_t)t * 1536; r.qn0 = __builtin_nontemporal_load((const u32x4*)(q + h * 128 + s * 16)); r.qn1 = __builtin_nontemporal_load((const u32x4*)(q + h * 128 + s * 16 + 8)); r.qr = __builtin_nontemporal_load((const u32x4*)(q + 1024 + h * 64 + s * 8));
    const bf16_t* kv = KVRAW + (size_t)t * 2048 + h * 256 + s * 16; r.kn0 = __builtin_nontemporal_load((const u32x4*)kv); r.kn1 = __builtin_nontemporal_load((const u32x4*)(kv + 8)); r.v0 = __builtin_nontemporal_load((const u32x4*)(kv + 128)); r.v1 = __builtin_nontemporal_load((const u32x4*)(kv + 136));
    const float* cp = COS + (size_t)t * 32; const float* sp = SIN + (size_t)t * 32;
    r.cq0 = *(const f32x4*)(cp + (s & 3) * 8); r.cq1 = *(const f32x4*)(cp + (s & 3) * 8 + 4); r.sq0 = *(const f32x4*)(sp + (s & 3) * 8); r.sq1 = *(const f32x4*)(sp + (s & 3) * 8 + 4);
    r.ck = cp[lane & 31]; r.sk = sp[lane & 31]; return r;
}
#define UNPK8(W_, X_, O_) do { const u32x4 w_ = (W_); X_[O_ + 0] = bflo(w_[0]); X_[O_ + 1] = bfhi(w_[0]); X_[O_ + 2] = bflo(w_[1]); X_[O_ + 3] = bfhi(w_[1]); X_[O_ + 4] = bflo(w_[2]); X_[O_ + 5] = bfhi(w_[2]); X_[O_ + 6] = bflo(w_[3]); X_[O_ + 7] = bfhi(w_[3]); } while (0)
__device__ __forceinline__ void p4_proc(int t, int lane, const QkRaw& r, const QkGain& g, bf16_t* __restrict__ Q, bf16_t* __restrict__ KN, bf16_t* __restrict__ V, bf16_t* __restrict__ KR, LAS unsigned char* vtile) {
    const int h = lane >> 3, s = lane & 7, b = t >> 14, l = t & (SEQ - 1);
    float rq, rkv;
    { float x[8]; UNPK8(r.zq, x, 0); float ss = 0.f;
#pragma unroll
      for (int i = 0; i < 8; ++i) ss += x[i] * x[i];
      rq = 1.0f / sqrtf(wave_sum(ss) * (1.0f / 512.0f) + EPS); }
    { const float ss = bflo(r.zkv.x) * bflo(r.zkv.x) + bfhi(r.zkv.x) * bfhi(r.zkv.x) + bflo(r.zkv.y) * bflo(r.zkv.y) + bfhi(r.zkv.y) * bfhi(r.zkv.y);
      rkv = 1.0f / sqrtf(wave_sum(ss) * (1.0f / 256.0f) + EPS); }
    { float x = bf2f((unsigned short)r.zkr); const float rr = 1.0f / sqrtf(wave_sum(x * x) * (1.0f / 64.0f) + EPS); x = x * rr * g.kr;
      const float other = __shfl_xor(x, 32); const float o = (lane < 32) ? (x * r.ck - other * r.sk) : (x * r.ck + other * r.sk);
#if ATT_FP8
      ((unsigned char*)KR)[(size_t)t * 64 + lane] = (unsigned char)(pk4_fp8(o, o, o, o) & 0xffu); }
#else
      KR[(size_t)t * 64 + lane] = f2bf(o); }
#endif
    { float x[16]; UNPK8(r.qn0, x, 0); UNPK8(r.qn1, x, 8); float ss = 0.f;
#pragma unroll
      for (int i = 0; i < 16; ++i) { x[i] *= rq; ss += x[i] * x[i]; }
      ss += __shfl_xor(ss, 1); ss += __shfl_xor(ss, 2); ss += __shfl_xor(ss, 4);
      const float rr = 1.0f / sqrtf(ss * (1.0f / 128.0f) + EPS); unsigned o[8];
#pragma unroll
#if ATT_FP8
      for (int i = 0; i < 16; ++i) x[i] = x[i] * rr * g.qn[i];
      (void)o;
      *(u32x4*)((unsigned char*)Q + ((size_t)((b * NH + h) * SEQ + l)) * 192 + s * 16) = (u32x4){pk4_fp8(x[0], x[1], x[2], x[3]), pk4_fp8(x[4], x[5], x[6], x[7]), pk4_fp8(x[8], x[9], x[10], x[11]), pk4_fp8(x[12], x[13], x[14], x[15])}; }
#else
      for (int i = 0; i < 8; ++i) o[i] = cvt_pk_bf16(x[2 * i] * rr * g.qn[2 * i], x[2 * i + 1] * rr * g.qn[2 * i + 1]);
      bf16_t* dst = Q + ((size_t)((b * NH + h) * SEQ + l)) * 192 + s * 16;
      *(u32x4*)dst = (u32x4){o[0], o[1], o[2], o[3]}; *(u32x4*)(dst + 8) = (u32x4){o[4], o[5], o[6], o[7]}; }
#endif
    { float x[8]; UNPK8(r.qr, x, 0); float ss = 0.f;
#pragma unroll
      for (int i = 0; i < 8; ++i) { x[i] *= rq; ss += x[i] * x[i]; }
      ss += __shfl_xor(ss, 1); ss += __shfl_xor(ss, 2); ss += __shfl_xor(ss, 4);
      const float rr = 1.0f / sqrtf(ss * (1.0f / 64.0f) + EPS); float y[8];
      const float cs[8] = {r.cq0[0], r.cq0[1], r.cq0[2], r.cq0[3], r.cq1[0], r.cq1[1], r.cq1[2], r.cq1[3]}, sn[8] = {r.sq0[0], r.sq0[1], r.sq0[2], r.sq0[3], r.sq1[0], r.sq1[1], r.sq1[2], r.sq1[3]};
#pragma unroll
      for (int i = 0; i < 8; ++i) x[i] = x[i] * rr * g.qr[i];
#pragma unroll
      for (int i = 0; i < 8; ++i) { const float other = __shfl_xor(x[i], 4); y[i] = (s < 4) ? (x[i] * cs[i] - other * sn[i]) : (x[i] * cs[i] + other * sn[i]); }
#if ATT_FP8
      *(u32x2*)((unsigned char*)Q + ((size_t)((b * NH + h) * SEQ + l)) * 192 + 128 + s * 8) = (u32x2){pk4_fp8(y[0], y[1], y[2], y[3]), pk4_fp8(y[4], y[5], y[6], y[7])}; }
#else
      bf16_t* dst = Q + ((size_t)((b * NH + h) * SEQ + l)) * 192 + 128 + s * 8;
      *(u32x4*)dst = (u32x4){cvt_pk_bf16(y[0], y[1]), cvt_pk_bf16(y[2], y[3]), cvt_pk_bf16(y[4], y[5]), cvt_pk_bf16(y[6], y[7])}; }
#endif
    { float x[16]; UNPK8(r.kn0, x, 0); UNPK8(r.kn1, x, 8); float ss = 0.f;
#pragma unroll
      for (int i = 0; i < 16; ++i) { x[i] *= rkv; ss += x[i] * x[i]; }
      ss += __shfl_xor(ss, 1); ss += __shfl_xor(ss, 2); ss += __shfl_xor(ss, 4);
      const float rr = 1.0f / sqrtf(ss * (1.0f / 128.0f) + EPS); unsigned o[8];
#pragma unroll
#if ATT_FP8
      for (int i = 0; i < 16; ++i) x[i] = x[i] * rr * g.kn[i];
      (void)o;
      *(u32x4*)((unsigned char*)KN + ((size_t)((b * NH + h) * SEQ + l)) * 128 + s * 16) = (u32x4){pk4_fp8(x[0], x[1], x[2], x[3]), pk4_fp8(x[4], x[5], x[6], x[7]), pk4_fp8(x[8], x[9], x[10], x[11]), pk4_fp8(x[12], x[13], x[14], x[15])}; }
#else
      for (int i = 0; i < 8; ++i) o[i] = cvt_pk_bf16(x[2 * i] * rr * g.kn[2 * i], x[2 * i + 1] * rr * g.kn[2 * i + 1]);
      bf16_t* dst = KN + ((size_t)((b * NH + h) * SEQ + l)) * 128 + s * 16;
      *(u32x4*)dst = (u32x4){o[0], o[1], o[2], o[3]}; *(u32x4*)(dst + 8) = (u32x4){o[4], o[5], o[6], o[7]}; }
#endif
#if ATT_PV8
    { const unsigned ww[8] = {r.v0[0], r.v0[1], r.v0[2], r.v0[3], r.v1[0], r.v1[1], r.v1[2], r.v1[3]}; unsigned q8[4];
#pragma unroll
      for (int i = 0; i < 4; ++i) q8[i] = pk4_fp8(bflo(ww[2 * i]) * rkv, bfhi(ww[2 * i]) * rkv, bflo(ww[2 * i + 1]) * rkv, bfhi(ww[2 * i + 1]) * rkv);
      const int k = t & 63, slot = 2 * ((k >> 2) & 1) + (k >> 5), bis = (k & 3) + 4 * ((k & 31) >> 3);
#pragma unroll
      for (int j = 0; j < 16; ++j) { const int d = s * 16 + j; vtile[(h * 128 + d) * 64 + ((slot ^ ((d >> 2) & 3)) << 4) + bis] = (unsigned char)((q8[j >> 2] >> (8 * (j & 3))) & 0xffu); } }
#else
    { unsigned o[8]; const unsigned ww[8] = {r.v0.x, r.v0.y, r.v0.z, r.v0.w, r.v1.x, r.v1.y, r.v1.z, r.v1.w};
#pragma unroll
      for (int i = 0; i < 8; ++i) o[i] = cvt_pk_bf16(bflo(ww[i]) * rkv, bfhi(ww[i]) * rkv);
      bf16_t* dst = V + ((size_t)((b * NH + h) * SEQ + l)) * 128 + s * 16;
      *(u32x4*)dst = (u32x4){o[0], o[1], o[2], o[3]}; *(u32x4*)(dst + 8) = (u32x4){o[4], o[5], o[6], o[7]}; }
    (void)vtile;
#endif
}

struct MixRaw { u32x4 s0, s1; f32x4 m[4]; };
__device__ __forceinline__ MixRaw p6_load(int t, int lane, const bf16_t* __restrict__ YS, const float* __restrict__ YM) {
    MixRaw r; const bf16_t* ys = YS + (size_t)t * 1024 + lane * 16; r.s0 = __builtin_nontemporal_load((const u32x4*)ys); r.s1 = __builtin_nontemporal_load((const u32x4*)(ys + 8));
    const float* ym = YM + (size_t)t * 1024 + lane * 4;
#pragma unroll
    for (int j = 0; j < 4; ++j) r.m[j] = __builtin_nontemporal_load((const f32x4*)(ym + 256 * j));
    return r;
}
__device__ __forceinline__ void p6_proc(int t, int lane, const MixRaw& r, bf16_t* __restrict__ MIX) {
    float x[16]; UNPK8(r.s0, x, 0); UNPK8(r.s1, x, 8);
    float ss = 0.f, sm = 0.f;
#pragma unroll
    for (int i = 0; i < 16; ++i) ss += x[i] * x[i];
#pragma unroll
    for (int j = 0; j < 4; ++j) sm += (r.m[j][0] * r.m[j][0] + r.m[j][1] * r.m[j][1]) + (r.m[j][2] * r.m[j][2] + r.m[j][3] * r.m[j][3]);
    const float rs = 1.0f / sqrtf(wave_sum(ss) * (1.0f / 1024.0f) + EPS), rm = 1.0f / sqrtf(wave_sum(sm) * (1.0f / 1024.0f) + EPS);
#if OUT_FP8
    unsigned char* d0 = (unsigned char*)MIX + (size_t)t * 2048 + lane * 16;
    *(u32x4*)d0 = (u32x4){pk4_fp8(x[0] * rs, x[1] * rs, x[2] * rs, x[3] * rs), pk4_fp8(x[4] * rs, x[5] * rs, x[6] * rs, x[7] * rs), pk4_fp8(x[8] * rs, x[9] * rs, x[10] * rs, x[11] * rs), pk4_fp8(x[12] * rs, x[13] * rs, x[14] * rs, x[15] * rs)};
    *(u32x4*)(d0 + 1024) = (u32x4){pk4_fp8(r.m[0][0] * rm, r.m[0][1] * rm, r.m[0][2] * rm, r.m[0][3] * rm), pk4_fp8(r.m[1][0] * rm, r.m[1][1] * rm, r.m[1][2] * rm, r.m[1][3] * rm),
                                   pk4_fp8(r.m[2][0] * rm, r.m[2][1] * rm, r.m[2][2] * rm, r.m[2][3] * rm), pk4_fp8(r.m[3][0] * rm, r.m[3][1] * rm, r.m[3][2] * rm, r.m[3][3] * rm)};
#else
    bf16_t* d0 = MIX + (size_t)t * 2048 + lane * 16; unsigned o[8];
#pragma unroll
    for (int i = 0; i < 8; ++i) o[i] = cvt_pk_bf16(x[2 * i] * rs, x[2 * i + 1] * rs);
    *(u32x4*)d0 = (u32x4){o[0], o[1], o[2], o[3]}; *(u32x4*)(d0 + 8) = (u32x4){o[4], o[5], o[6], o[7]};
    bf16_t* d1 = MIX + (size_t)t * 2048 + 1024 + lane * 4;
#pragma unroll
    for (int j = 0; j < 4; ++j) { u32x2 w; w.x = cvt_pk_bf16(r.m[j][0] * rm, r.m[j][1] * rm); w.y = cvt_pk_bf16(r.m[j][2] * rm, r.m[j][3] * rm); *(u32x2*)(d1 + 256 * j) = w; }
#endif
}

__device__ __forceinline__ void p8_group(int grp, int lane, LAS float* wl  , const bf16_t* __restrict__ X1, const float* __restrict__ FA2, const float* __restrict__ FB2,
                                         const bf16_t* __restrict__ WRT_HI, const bf16_t* __restrict__ WRT_LO, const float* __restrict__ b_router, unsigned char* __restrict__ H8,
                                         int* __restrict__ RIDX, float* __restrict__ RGATE, int* __restrict__ RPOS, unsigned* __restrict__ CNT) {
    const int t0 = grp * 16, b = t0 >> 14, fr = lane & 15, fq = lane >> 4;
    float rstd_mine = 0.f;
    { f32x4 fa[4][2], fb[4][2];
#pragma unroll
      for (int j = 0; j < 4; ++j)
#pragma unroll
        for (int q = 0; q < 2; ++q) { fa[j][q] = *(const f32x4*)(FA2 + b * 2048 + 8 * lane + 512 * j + 4 * q); fb[j][q] = *(const f32x4*)(FB2 + b * 2048 + 8 * lane + 512 * j + 4 * q); }
#pragma unroll 1
      for (int i = 0; i < 16; i += 4) { constexpr int HB = MOE_FP8 ? 2048 : 4096;
          const RowRawB r0 = hnorm_b_load(X1 + (size_t)(t0 + i) * 2048, lane), r1 = hnorm_b_load(X1 + (size_t)(t0 + i + 1) * 2048, lane), r2 = hnorm_b_load(X1 + (size_t)(t0 + i + 2) * 2048, lane), r3 = hnorm_b_load(X1 + (size_t)(t0 + i + 3) * 2048, lane);
          const float q0 = hnorm_b_proc(r0, H8 + (size_t)(t0 + i) * HB, fa, fb, lane), q1 = hnorm_b_proc(r1, H8 + (size_t)(t0 + i + 1) * HB, fa, fb, lane), q2 = hnorm_b_proc(r2, H8 + (size_t)(t0 + i + 2) * HB, fa, fb, lane), q3 = hnorm_b_proc(r3, H8 + (size_t)(t0 + i + 3) * HB, fa, fb, lane);
          rstd_mine = (fr == i) ? q0 : (fr == i + 1) ? q1 : (fr == i + 2) ? q2 : (fr == i + 3) ? q3 : rstd_mine; } }
    f32x4 acc0 = {0.f, 0.f, 0.f, 0.f}, acc1 = {0.f, 0.f, 0.f, 0.f};
    const bf16_t* xrow = X1 + (size_t)(t0 + fr) * 2048 + fq * 8;
    const float* fap = FA2 + b * 2048 + fq * 8; const float* fbp = FB2 + b * 2048 + fq * 8;
    const bf16_t* wh0 = WRT_HI + (size_t)fr * 2048 + fq * 8; const bf16_t* wl0 = WRT_LO + (size_t)fr * 2048 + fq * 8;
#pragma unroll 4
    for (int ks = 0; ks < 64; ++ks) {
        const u32x4 xw = *(const u32x4*)(xrow + ks * 32); const f32x4 x0 = {bflo(xw.x), bfhi(xw.x), bflo(xw.y), bfhi(xw.y)}, x1 = {bflo(xw.z), bfhi(xw.z), bflo(xw.w), bfhi(xw.w)};
        const f32x4 a0 = *(const f32x4*)(fap + ks * 32), a1 = *(const f32x4*)(fap + ks * 32 + 4), c0 = *(const f32x4*)(fbp + ks * 32), c1 = *(const f32x4*)(fbp + ks * 32 + 4);
        const f32x4 h0 = x0 * rstd_mine * a0 + c0, h1 = x1 * rstd_mine * a1 + c1;
        u32x4 hh; hh.x = cvt_pk_bf16(h0[0], h0[1]); hh.y = cvt_pk_bf16(h0[2], h0[3]); hh.z = cvt_pk_bf16(h1[0], h1[1]); hh.w = cvt_pk_bf16(h1[2], h1[3]);
        u32x4 hl; hl.x = cvt_pk_bf16(h0[0] - bflo(hh.x), h0[1] - bfhi(hh.x)); hl.y = cvt_pk_bf16(h0[2] - bflo(hh.y), h0[3] - bfhi(hh.y));
        hl.z = cvt_pk_bf16(h1[0] - bflo(hh.z), h1[1] - bfhi(hh.z)); hl.w = cvt_pk_bf16(h1[2] - bflo(hh.w), h1[3] - bfhi(hh.w));
        const bf16x8 hhi = *reinterpret_cast<bf16x8*>(&hh), hlo = *reinterpret_cast<bf16x8*>(&hl);
        const bf16x8 whi0 = *(const bf16x8*)(wh0 + ks * 32), wlo0 = *(const bf16x8*)(wl0 + ks * 32);
        const bf16x8 whi1 = *(const bf16x8*)(wh0 + 16 * 2048 + ks * 32), wlo1 = *(const bf16x8*)(wl0 + 16 * 2048 + ks * 32);
        acc0 = __builtin_amdgcn_mfma_f32_16x16x32_bf16(whi0, hhi, acc0, 0, 0, 0); acc0 = __builtin_amdgcn_mfma_f32_16x16x32_bf16(wlo0, hhi, acc0, 0, 0, 0); acc0 = __builtin_amdgcn_mfma_f32_16x16x32_bf16(whi0, hlo, acc0, 0, 0, 0);
        acc1 = __builtin_amdgcn_mfma_f32_16x16x32_bf16(whi1, hhi, acc1, 0, 0, 0); acc1 = __builtin_amdgcn_mfma_f32_16x16x32_bf16(wlo1, hhi, acc1, 0, 0, 0); acc1 = __builtin_amdgcn_mfma_f32_16x16x32_bf16(whi1, hlo, acc1, 0, 0, 0);
    }
    LAS float* lg = wl; LAS unsigned* hist = (LAS unsigned*)(wl + 16 * 33); LAS unsigned* basel = hist + 32;
#pragma unroll
    for (int e = 0; e < 4; ++e) { lg[fr * 33 + 4 * fq + e] = acc0[e] + b_router[4 * fq + e]; lg[fr * 33 + 16 + 4 * fq + e] = acc1[e] + b_router[16 + 4 * fq + e]; }
    if (lane < 32) hist[lane] = 0u;
    LDS_FENCE();
    int ie[4] = {0, 0, 0, 0}; float gt[4] = {0.f, 0.f, 0.f, 0.f}; unsigned rk[4] = {0u, 0u, 0u, 0u};
    if (lane < 16) {
        float v0 = -3.0e38f, v1 = -3.0e38f, v2 = -3.0e38f, v3 = -3.0e38f; int i0 = 0, i1 = 0, i2 = 0, i3 = 0;
#pragma unroll 4
        for (int e = 0; e < 32; ++e) { const float x = lg[lane * 33 + e];
            if (x > v0) { v3 = v2; i3 = i2; v2 = v1; i2 = i1; v1 = v0; i1 = i0; v0 = x; i0 = e; }
            else if (x > v1) { v3 = v2; i3 = i2; v2 = v1; i2 = i1; v1 = x; i1 = e; }
            else if (x > v2) { v3 = v2; i3 = i2; v2 = x; i2 = e; }
            else if (x > v3) { v3 = x; i3 = e; } }
        const float e1 = __expf(v1 - v0), e2 = __expf(v2 - v0), e3 = __expf(v3 - v0), inv = 1.0f / (1.0f + e1 + e2 + e3);
        ie[0] = i0; ie[1] = i1; ie[2] = i2; ie[3] = i3; gt[0] = inv; gt[1] = e1 * inv; gt[2] = e2 * inv; gt[3] = e3 * inv;
#pragma unroll
        for (int k = 0; k < 4; ++k) rk[k] = __hip_atomic_fetch_add((LAS unsigned*)&hist[ie[k]], 1u, __ATOMIC_RELAXED, __HIP_MEMORY_SCOPE_WORKGROUP);
    }
    LDS_FENCE();
    if (lane < 32) { const unsigned cnt = hist[lane]; unsigned base = 0u; if (cnt) base = __hip_atomic_fetch_add(CNT + lane, cnt, __ATOMIC_RELAXED, __HIP_MEMORY_SCOPE_AGENT); basel[lane] = base; }
    LDS_FENCE();
    if (lane < 16) { const int t = t0 + lane;
#pragma unroll
        for (int k = 0; k < 4; ++k) { RIDX[t * 4 + k] = ie[k]; RGATE[t * 4 + k] = gt[k]; RPOS[t * 4 + k] = (int)(basel[ie[k]] + rk[k]); } }
    LDS_FENCE();
}

__device__ __forceinline__ void moe_tables(const Ctx& c, const unsigned* __restrict__ CNT, volatile LAS int* tab) {
    if (c.tid < 64) { const int e = c.tid & 31;
        const int n = (int)__hip_atomic_load(CNT + e, __ATOMIC_RELAXED, __HIP_MEMORY_SCOPE_AGENT); const int nb = (n + 255) >> 8;
        int incl = nb;
#pragma unroll
        for (int d = 1; d < 32; d <<= 1) { const int t = __shfl_up(incl, d, 32); if (e >= d) incl += t; }
        if (c.tid < 32) { const int excl = incl - nb; tab[e] = nb; tab[32 + e] = excl; tab[96 + e] = n; if (e == 31) tab[64] = incl;
            for (int i = 0; i < nb; ++i) tab[128 + excl + i] = e; } }
    __syncthreads();
}

__device__ const float INVF[32] = {1.0f, 0.7498942017555237f, 0.5623413324356079f, 0.4216965138912201f, 0.3162277638912201f, 0.23713737726211548f, 0.17782793939113617f, 0.1333521455526352f, 0.10000000149011612f, 0.0749894231557846f, 0.05623413249850273f, 0.04216964915394783f, 0.03162277489900589f, 0.023713737726211548f, 0.017782794311642647f, 0.013335213996469975f, 0.009999999776482582f, 0.007498942315578461f, 0.005623413249850273f, 0.0042169648222625256f, 0.003162277629598975f, 0.0023713738191872835f, 0.0017782794311642647f, 0.0013335214462131262f, 0.0010000000474974513f, 0.0007498941849917173f, 0.000562341301701963f, 0.0004216965171508491f, 0.0003162277571391314f, 0.00023713737027719617f, 0.00017782794020604342f, 0.0001333521504420787f};

struct Args { const void* in[33]; float* out; unsigned char* ws; int ph_lo, ph_hi; };

__global__ void __launch_bounds__(512, 2) mk_fwd(Args a) {
    extern __shared__ __attribute__((aligned(16))) unsigned char lds_raw[];
    Ctx c; c.lds = (LAS unsigned char*)lds_raw; c.tid = threadIdx.x; c.lane = c.tid & 63; c.wave = __builtin_amdgcn_readfirstlane(c.tid >> 6); c.G = gridDim.x;
    { const int bx = blockIdx.x; c.vcu = (c.G % 8 == 0) ? (bx % 8) * (c.G / 8) + bx / 8 : bx; }
    volatile LAS unsigned* MISC = (volatile LAS unsigned*)(c.lds + MISC_OFF);
    for (int u = c.tid; u < 1024; u += 512) MISC[u] = 0u;
    __syncthreads();
    unsigned char* ws = a.ws;
    unsigned* ctl = (unsigned*)(ws + WS_CTL);
    volatile LAS int* tab = (volatile LAS int*)(c.lds + MISC_OFF + 256);
#if MK_N_LAUNCHES == 1
    XcdBarrier bar = xcd_barrier_post(ctl + CW_BAR, MISC);
#define GRID_BAR() xcd_barrier(bar)
#else
#define GRID_BAR() do { } while (0)
#endif
    const int lo = a.ph_lo, hi = a.ph_hi;
#ifndef PHASE_MASK
#define PHASE_MASK 0xFFFF
#endif
#define IN(k) ((((PHASE_MASK) >> (k)) & 1) && lo <= (k) && (k) < hi)
#define BOTH(k) (IN(k) && IN((k) + 1))
#ifndef PROBE_ATT
#ifndef PROBE_ABL
#define PROBE_ABL 0
#endif
#ifndef PROBE_GU
#define PROBE_GU 0
#endif
#define PROBE_ATT 1
#endif
#ifndef PROBE_DUP
#define PROBE_DUP 0
#endif
#define NREP(k) (1 + (((PROBE_DUP) >> (k)) & 1))
#define REP_BEGIN(k) _Pragma("unroll 1") for (int rep_ = 0; rep_ < NREP(k); ++rep_) {
#define REP_END(k) if (rep_ + 1 < NREP(k)) GRID_BAR(); }
    const int gw = c.vcu * 8 + c.wave, NGW = c.G * 8, gtid = c.vcu * 512 + c.tid, NTHR = c.G * 512, lane = c.lane;
    const float* x = (const float*)a.in[0]; const float* cvec = (const float*)a.in[1]; const int* positions = (const int*)a.in[2];
    const float* w_ada = (const float*)a.in[3]; const float* b_ada = (const float*)a.in[4]; const float* norm_mix_g = (const float*)a.in[5]; const float* w_in = (const float*)a.in[6];
    const float* ssm_A_re = (const float*)a.in[7]; const float* ssm_A_im = (const float*)a.in[8]; const float* ssm_B_re = (const float*)a.in[9]; const float* ssm_B_im = (const float*)a.in[10];
    const float* ssm_C_re = (const float*)a.in[11]; const float* ssm_C_im = (const float*)a.in[12]; const float* ssm_D = (const float*)a.in[13]; const float* ssm_log_dt = (const float*)a.in[14];
    const float* q_lat_g = (const float*)a.in[15]; const float* kv_lat_g = (const float*)a.in[16]; const float* w_uq = (const float*)a.in[17]; const float* w_ukv = (const float*)a.in[18];
    const float* q_nope_g = (const float*)a.in[19]; const float* q_rope_g = (const float*)a.in[20]; const float* k_nope_g = (const float*)a.in[21]; const float* k_rope_g = (const float*)a.in[22];
    const float* out_ssm_g = (const float*)a.in[23]; const float* out_mla_g = (const float*)a.in[24]; const float* w_out = (const float*)a.in[25]; const float* norm_ffn_g = (const float*)a.in[26];
    const float* w_router = (const float*)a.in[27]; const float* b_router = (const float*)a.in[28]; const float* w_gate_up = (const float*)a.in[29]; const float* b_gate_up = (const float*)a.in[30];
    const float* w_down = (const float*)a.in[31]; const float* b_down = (const float*)a.in[32];
    float* out = a.out;
    float* MOD = (float*)(ws + WS_MOD); float* FA2 = (float*)(ws + WS_FAB2); float* FB2 = FA2 + 4096;
    float* APOW = (float*)(ws + WS_APOW); float* A64 = (float*)(ws + WS_A64); float* A1024 = (float*)(ws + WS_A1024); float* BB = (float*)(ws + WS_BB); float* KC = (float*)(ws + WS_KC);
    float* COS = (float*)(ws + WS_COS); float* SIN = (float*)(ws + WS_SIN);
    int* RIDX = (int*)(ws + WS_RIDX); float* RGATE = (float*)(ws + WS_RGATE); int* RPOS = (int*)(ws + WS_RPOS); int* SLOT = (int*)(ws + WS_SLOT); float* ROWGATE = (float*)(ws + WS_ROWGATE);
    bf16_t* WRT_HI = (bf16_t*)(ws + WS_WRT); bf16_t* WRT_LO = WRT_HI + 32 * 2048;
    bf16_t* WUQ = (bf16_t*)(ws + WS_WUQ); bf16_t* WUKV = (bf16_t*)(ws + WS_WUKV); bf16_t* WIN = (bf16_t*)(ws + WS_WIN); bf16_t* WOUT = (bf16_t*)(ws + WS_WOUT); bf16_t* WG = (bf16_t*)(ws + WS_WG);
    float* SEND = (float*)(ws + WS_SEND); bf16_t* KR = (bf16_t*)(ws + WS_KR); bf16_t* BTG = (bf16_t*)(ws + WS_BTG); bf16_t* AG = (bf16_t*)(ws + WS_AG); bf16_t* GS = (bf16_t*)(ws + WS_GS);
    bf16_t* Z2 = (bf16_t*)(ws + WS_Z2); bf16_t* H = (bf16_t*)(ws + WS_H); bf16_t* QRAW = (bf16_t*)(ws + WS_QRAW); bf16_t* KVRAW = (bf16_t*)(ws + WS_KVRAW);
    bf16_t* Q = (bf16_t*)(ws + WS_Q); bf16_t* KN = (bf16_t*)(ws + WS_KN); bf16_t* V = (bf16_t*)(ws + WS_V); bf16_t* YS = (bf16_t*)(ws + WS_YS); float* YM = (float*)(ws + WS_YM); bf16_t* MIX = (bf16_t*)(ws + WS_MIX);
    unsigned char* WGU = ws + WS_WGU; unsigned char* WDN = ws + WS_WDN; unsigned char* ACT = ws + WS_ACT; unsigned char* YB = ws + WS_YB; bf16_t* X1B = (bf16_t*)(ws + WS_YM);     unsigned char* XS = ws + WS_XS; unsigned char* H8 = ws + WS_H;
    unsigned* CNT = ctl + CW_CNT;

    if (IN(0)) {
        REP_BEGIN(0)
        for (int it = c.vcu; it < 192; it += c.G) p0_mod_chunk(c, it, cvec, w_ada, b_ada, MOD);
        for (int it = c.vcu; it < 256; it += c.G) p0_kc_item(c, it, ssm_A_re, ssm_A_im, ssm_B_re, ssm_B_im, ssm_C_re, ssm_C_im, ssm_D, ssm_log_dt, KC, BB);
        for (int i = gtid; i < 64 * 65 * 64; i += NTHR) { const int g = i / 4160, k = (i >> 6) % 65, p = i & 63; const float dt = expf(ssm_log_dt[g]), are = ssm_A_re[g * 64 + p], aim = ssm_A_im[g * 64 + p];
            float cs, sn; sincos_d((double)k * (double)dt * (double)aim, cs, sn); const float ex = expf((float)k * dt * are); APOW[2 * (size_t)i] = ex * cs; APOW[2 * (size_t)i + 1] = ex * sn; }
        for (int i = gtid; i < 4096; i += NTHR) { const int g = i >> 6; const float dt = expf(ssm_log_dt[g]), are = ssm_A_re[i], aim = ssm_A_im[i]; float cs, sn;
            sincos_d(64.0 * (double)dt * (double)aim, cs, sn); float ex = expf(64.0f * dt * are); A64[2 * i] = ex * cs; A64[2 * i + 1] = ex * sn;
            sincos_d(1024.0 * (double)dt * (double)aim, cs, sn); ex = expf(1024.0f * dt * are); A1024[2 * i] = ex * cs; A1024[2 * i + 1] = ex * sn; }
        for (int i = gtid; i < NTOK * 32; i += NTHR) { const int t = i >> 5, k = i & 31; const float ang = (float)positions[t] * INVF[k]; float cs, sn; sincos_d((double)ang, cs, sn); COS[i] = cs; SIN[i] = sn; }
        { const u32x4 z4 = {0u, 0u, 0u, 0u};
          u32x4* zw = (u32x4*)(WIN + (size_t)DIN * 2048); for (int i = gtid; i < (DINP - DIN) * 2048 / 8; i += NTHR) zw[i] = z4;
          for (int i = gtid; i < 64 * 128 * 1024 / 8; i += NTHR) { const int g = i >> 14, r = i & 16383; ((u32x4*)(WG + ((size_t)g * 256 + 128) * 1024))[r] = z4; } }
        for (int i = gtid; i < 32 * 2048; i += NTHR) { const int e = i >> 11, k = i & 2047; const float w = w_router[k * 32 + e]; const unsigned short hb = f2bf(w); WRT_HI[i] = hb; WRT_LO[i] = f2bf(w - bf2f(hb)); }
                constexpr int I_IN = 32 * 45, I_UQ = 8 * 24, I_UKV = 4 * 32, I_OUT = 32 * 32;
        constexpr int NIT = I_IN + I_UQ + I_UKV + I_OUT;
        for (int it = gw; it < NIT; it += NGW) {
            int r = it;
            if (r < I_IN) { tr_item<0>(w_in, DIN, nullptr, WIN, 2048, r / 45, r % 45, lane); continue; } r -= I_IN;
#if OUT_FP8
            if (r < I_OUT) { if (r < 16 * 32) { const int kb = r / 32; tr_item8<0>(w_out, 2048, (unsigned char*)WOUT, 2048, kb, r % 32, lane, kb < 8 ? out_ssm_g : out_mla_g - 1024); } continue; } r -= I_OUT;
#else
            if (r < I_OUT) { const int kb = r / 32; tr_item<0>(w_out, 2048, kb < 16 ? out_ssm_g : out_mla_g - 1024, WOUT, 2048, kb, r % 32, lane); continue; } r -= I_OUT;
#endif
            if (r < I_UQ) { tr_item<1>(w_uq, 1536, q_lat_g, WUQ, 1024, r / 24, r % 24, lane); continue; } r -= I_UQ;
            tr_item<0>(w_ukv, 2048, kv_lat_g, WUKV, 1024, r / 32, r % 32, lane);
        }
        REP_END(0)
        if (BOTH(0)) GRID_BAR();
    }
    if (IN(1)) {
        REP_BEGIN(1)
#pragma unroll 1
        for (int b = 0; b < 2; ++b) { f32x4 fa[8], fb[8];
#pragma unroll
            for (int j = 0; j < 8; ++j) { const int col = 8 * lane + 512 * (j >> 1) + 4 * (j & 1); const f32x4 g4 = *(const f32x4*)(norm_mix_g + col), sc4 = *(const f32x4*)(MOD + b * 12288 + 2048 + col); fa[j] = g4 * (1.0f + sc4); fb[j] = *(const f32x4*)(MOD + b * 12288 + col); }
#pragma unroll 1
            for (int row = b * SEQ + gw; row < (b + 1) * SEQ; row += 2 * NGW) { const int row1 = row + NGW; const bool two = row1 < (b + 1) * SEQ;
                const RowRaw ra = hnorm_load(x + (size_t)row * 2048, lane), rb = hnorm_load(x + (size_t)(two ? row1 : row) * 2048, lane);
                (void)hnorm_proc(ra, H + (size_t)row * 2048, fa, fb, lane); if (two) (void)hnorm_proc(rb, H + (size_t)row1 * 2048, fa, fb, lane); } }
        for (int i = gtid; i < 4096; i += NTHR) { const int b = i >> 11, k = i & 2047; FA2[i] = norm_ffn_g[k] * (1.0f + MOD[b * 12288 + 8192 + k]); FB2[i] = MOD[b * 12288 + 6144 + k]; }
        for (int i = gtid; i < 64 * 64 * 16 * 64 * 2; i += NTHR) { const int hh8 = i & 1, j = (i >> 1) & 63, h = (i >> 7) & 15, l = (i >> 11) & 63, g = i >> 17;
            if (j >= 16 * ((l >> 4) + 1)) continue;
            u32x4 w = {0u, 0u, 0u, 0u};
            if (j <= l) { const float* src = KC + ((size_t)(g * 64 + (l - j)) * 16 + h) * 16 + hh8 * 8; const f32x4 k0 = *(const f32x4*)src, k1 = *(const f32x4*)(src + 4);
                w.x = cvt_pk_bf16(k0[0], k0[1]); w.y = cvt_pk_bf16(k0[2], k0[3]); w.z = cvt_pk_bf16(k1[0], k1[1]); w.w = cvt_pk_bf16(k1[2], k1[3]); }
            *(u32x4*)(BTG + ((size_t)(g * 1024 + l * 16 + h)) * AGW + 128 + j * 16 + hh8 * 8) = w; }
        for (int i = gtid; i < 64 * 64 * 16 * 16; i += NTHR) { const int cg = i & 15, h = (i >> 4) & 15, l = (i >> 8) & 63, g = i >> 14, part = cg >> 3, p0 = (cg & 7) * 8; float v[8];
#pragma unroll
            for (int e = 0; e < 8; ++e) { const int p = p0 + e; const float cr = ssm_C_re[(g * 16 + h) * 64 + p], ci = ssm_C_im[(g * 16 + h) * 64 + p]; const float ar = APOW[((size_t)(g * 65 + l + 1) * 64 + p) * 2], ai = APOW[((size_t)(g * 65 + l + 1) * 64 + p) * 2 + 1];
                v[e] = part ? -(cr * ai + ci * ar) : (cr * ar - ci * ai); }
            u32x4 w; w.x = cvt_pk_bf16(v[0], v[1]); w.y = cvt_pk_bf16(v[2], v[3]); w.z = cvt_pk_bf16(v[4], v[5]); w.w = cvt_pk_bf16(v[6], v[7]);
            *(u32x4*)(BTG + ((size_t)(g * 1024 + l * 16 + h)) * AGW + cg * 8) = w; }
        for (int i = gtid; i < 64 * 128 * 64 * 2; i += NTHR) { const int hh8 = i & 1, j = (i >> 1) & 63, prow = (i >> 7) & 127, g = i >> 14, p = prow & 63, part = prow >> 6;
            const float ar = APOW[((size_t)(g * 65 + 63 - j) * 64 + p) * 2], ai = APOW[((size_t)(g * 65 + 63 - j) * 64 + p) * 2 + 1]; float v[8];
#pragma unroll
            for (int e = 0; e < 8; ++e) { const float br = BB[((size_t)(g * 64 + p) * 16 + hh8 * 8 + e) * 2], bi = BB[((size_t)(g * 64 + p) * 16 + hh8 * 8 + e) * 2 + 1]; v[e] = part ? (ar * bi + ai * br) : (ar * br - ai * bi); }
            u32x4 w; w.x = cvt_pk_bf16(v[0], v[1]); w.y = cvt_pk_bf16(v[2], v[3]); w.z = cvt_pk_bf16(v[4], v[5]); w.w = cvt_pk_bf16(v[6], v[7]);
            *(u32x4*)(WG + ((size_t)(g * 256 + prow)) * 1024 + j * 16 + hh8 * 8) = w; }
        REP_END(1)
        if (BOTH(1)) GRID_BAR();
    }
    if (IN(2)) {
        REP_BEGIN(2)
        SchedDense S{(const char*)H, (const char*)WIN, 4096u, 4096u, 128, 12, 32, c.G, (int)blockIdx.x}; EpiZ E{AG, GS, Z2};
        pg8::gemm_phase<EpiZ, SchedDense>(c.lds, 4096u, 4096u, S, E);
        REP_END(2)
        if (BOTH(2)) GRID_BAR();
    }
    if (IN(3)) {
        REP_BEGIN(3)
        SchedP3 S{(const char*)AG, (const char*)WG, (const char*)Z2, (const char*)WUQ, (const char*)WUKV, c.G, (int)blockIdx.x}; EpiP3 E{QRAW, KVRAW, SEND};
        pg8::gemm_phase<EpiP3, SchedP3>(c.lds, (unsigned)(AGW * 2), 2048u, S, E);
        REP_END(3)
        if (BOTH(3)) GRID_BAR();
    }
    if (IN(4)) {
        REP_BEGIN(4)
        for (int it = c.vcu; it < 256; it += c.G) p4_carry_item(c, it, SEND, A64, A1024, AG);
        { const QkGain gn = p4_gains(lane, q_nope_g, q_rope_g, k_nope_g, k_rope_g);
#if ATT_PV8
#pragma unroll 1
          for (int tile = c.vcu; tile < NTOK / 64; tile += c.G) {
#pragma unroll 1
              for (int i = 0; i < 8; i += 2) { const int t = tile * 64 + c.wave * 8 + i;
                  const QkRaw ra = p4_load(t, lane, Z2, QRAW, KVRAW, COS, SIN), rb = p4_load(t + 1, lane, Z2, QRAW, KVRAW, COS, SIN);
                  p4_proc(t, lane, ra, gn, Q, KN, V, KR, c.lds); p4_proc(t + 1, lane, rb, gn, Q, KN, V, KR, c.lds); }
              __syncthreads();
              { const int b = tile >> 8, tl = tile & 255; unsigned char* V8T = (unsigned char*)V;
#pragma unroll
                for (int q = 0; q < 8; ++q) { const int o = (c.tid + 512 * q) * 16, h = o >> 13, within = o & 8191;
                    *(u32x4*)(V8T + ((size_t)((b * NH + h) * 256 + tl)) * 8192 + within) = *(const LAS u32x4*)(c.lds + o); } }
              __syncthreads(); }
#else
#pragma unroll 1
          for (int t = gw; t < NTOK; t += 2 * NGW) { const int t1 = t + NGW; const bool two = t1 < NTOK;
              const QkRaw ra = p4_load(t, lane, Z2, QRAW, KVRAW, COS, SIN), rb = p4_load(two ? t1 : t, lane, Z2, QRAW, KVRAW, COS, SIN);
              p4_proc(t, lane, ra, gn, Q, KN, V, KR, c.lds); if (two) p4_proc(t1, lane, rb, gn, Q, KN, V, KR, c.lds); }
#endif
        }
        REP_END(4)
        if (BOTH(4)) GRID_BAR();
    }
    if (IN(5)) {
        REP_BEGIN(5)
#ifndef NO_SSM
        { SchedSsm S{(const char*)AG, (const char*)BTG, c.G, (int)blockIdx.x}; EpiSsm E{GS, YS};
          pg8::gemm_phase<EpiSsm, SchedSsm>(c.lds, (unsigned)(AGW * 2), (unsigned)(AGW * 2), S, E); }
#endif
        __syncthreads();
#ifndef NO_ATT
        { const bool spread = (c.G % 4 == 0); const bool conv = spread ? ((int)blockIdx.x < (c.G >> 1)) : true;
          if (conv) { const int gwc = spread ? (int)blockIdx.x * 8 + c.wave : gw, NGWC = spread ? (c.G >> 1) * 8 : NGW;
#if MOE_FP8
            constexpr int I_GU = 16 * 64, I_DN = 16 * 32;
#else
            constexpr int I_GU = 32 * 64, I_DN = 32 * 32;
#endif
#pragma unroll 1
            for (int it = gwc; it < 32 * (I_GU + I_DN); it += NGWC) {
                if (it < 32 * I_GU) { const int e = it / I_GU, q = it % I_GU;
#if MOE_FP8
                    tr_item8<2>(w_gate_up + (size_t)e * 2048 * 4096, 4096, WGU + (size_t)e * 4096 * 2048, 2048, q / 64, q % 64, lane);
#else
                    tr_item<2>(w_gate_up + (size_t)e * 2048 * 4096, 4096, nullptr, (bf16_t*)WGU + (size_t)e * 4096 * 2048, 2048, q / 64, q % 64, lane);
#endif
                } else { const int r = it - 32 * I_GU, e = r / I_DN, q = r % I_DN;
#if MOE_FP8
                    tr_item8<0>(w_down + (size_t)e * 2048 * 2048, 2048, WDN + (size_t)e * 2048 * 2048, 2048, q / 32, q % 32, lane);
#else
                    tr_item<0>(w_down + (size_t)e * 2048 * 2048, 2048, nullptr, (bf16_t*)WDN + (size_t)e * 2048 * 2048, 2048, q / 32, q % 32, lane);
#endif
                } } } }
#pragma unroll 1
        for (;;) {
            __syncthreads();
            if (c.tid == 0) MISC[16] = __hip_atomic_fetch_add(ctl + CW_ATT, 1u, __ATOMIC_RELAXED, __HIP_MEMORY_SCOPE_AGENT);
            __syncthreads();
            const unsigned u = MISC[16];
            if (u >= 1024u * PROBE_ATT) break;
            const int uu = (int)(u & 1023u), qb = 63 - (uu >> 4), bh = uu & 15, b = bh >> 3, h = bh & 7;
#if ATT_FP8 && ATT_PV8
#if PROBE_ABL
            if (u >= 1024u) att::attn_block9<PROBE_ABL>((const unsigned char*)Q + ((size_t)(b * NH + h) * SEQ + qb * 256) * 192, (const unsigned char*)KN + (size_t)(b * NH + h) * SEQ * 128, (const unsigned char*)V + (size_t)(b * NH + h) * 256 * 8192, (const unsigned char*)KR + (size_t)b * SEQ * 64,
                             YM + ((size_t)(b * SEQ + qb * 256)) * 1024 + h * 128, qb, (char*)lds_raw); else
#endif
            att::attn_block9((const unsigned char*)Q + ((size_t)(b * NH + h) * SEQ + qb * 256) * 192, (const unsigned char*)KN + (size_t)(b * NH + h) * SEQ * 128, (const unsigned char*)V + (size_t)(b * NH + h) * 256 * 8192, (const unsigned char*)KR + (size_t)b * SEQ * 64,
                             YM + ((size_t)(b * SEQ + qb * 256)) * 1024 + h * 128, qb, (char*)lds_raw);
#elif ATT_FP8
            att::attn_block8((const unsigned char*)Q + ((size_t)(b * NH + h) * SEQ + qb * 256) * 192, (const unsigned char*)KN + (size_t)(b * NH + h) * SEQ * 128, V + (size_t)(b * NH + h) * SEQ * 128, (const unsigned char*)KR + (size_t)b * SEQ * 64,
                             YM + ((size_t)(b * SEQ + qb * 256)) * 1024 + h * 128, qb, (char*)lds_raw);
#else
            att::attn_block(Q + ((size_t)(b * NH + h) * SEQ + qb * 256) * 192, KN + (size_t)(b * NH + h) * SEQ * 128, V + (size_t)(b * NH + h) * SEQ * 128, KR + (size_t)b * SEQ * 64,
                            YM + ((size_t)(b * SEQ + qb * 256)) * 1024 + h * 128, qb, (char*)lds_raw);
#endif
        }
#endif
        REP_END(5)
        if (BOTH(5)) GRID_BAR();
    }
    if (IN(6)) {
        REP_BEGIN(6)
#pragma unroll 1
        for (int t = gw; t < NTOK; t += 4 * NGW) { const int t1 = t + NGW, t2 = t + 2 * NGW, t3 = t + 3 * NGW;
            const MixRaw ra = p6_load(t, lane, YS, YM), rb = p6_load(t1 < NTOK ? t1 : t, lane, YS, YM), rc = p6_load(t2 < NTOK ? t2 : t, lane, YS, YM), rd = p6_load(t3 < NTOK ? t3 : t, lane, YS, YM);
            p6_proc(t, lane, ra, MIX); if (t1 < NTOK) p6_proc(t1, lane, rb, MIX); if (t2 < NTOK) p6_proc(t2, lane, rc, MIX); if (t3 < NTOK) p6_proc(t3, lane, rd, MIX); }
        REP_END(6)
        if (BOTH(6)) GRID_BAR();
    }
    if (IN(7)) {
        REP_BEGIN(7)
        constexpr unsigned OB = OUT_FP8 ? 2048u : 4096u;
        SchedDense S{(const char*)MIX, (const char*)WOUT, OB, OB, 128, 8, OUT_FP8 ? 16 : 32, c.G, (int)blockIdx.x}; EpiOut E{x, X1B, MOD};
        pg8::gemm_phase<EpiOut, SchedDense, OUT_FP8 != 0>(c.lds, OB, OB, S, E);
        REP_END(7)
        if (BOTH(7)) GRID_BAR();
    }
    if (IN(8)) {
        REP_BEGIN(8)
        for (int grp = gw; grp < NTOK / 16; grp += NGW) p8_group(grp, lane, (LAS float*)(c.lds + c.wave * 4096), X1B, FA2, FB2, WRT_HI, WRT_LO, b_router, H8, RIDX, RGATE, RPOS, CNT);
        REP_END(8)
        if (BOTH(8)) GRID_BAR();
    }
    if (IN(9)) {
        REP_BEGIN(9)
        moe_tables(c, CNT, tab);
#pragma unroll 1
        for (int t = gw; t < NTOK; t += NGW) { constexpr int RB = MOE_FP8 ? 2048 : 4096;
            const u32x4 ev = *(const u32x4*)(RIDX + t * 4), pv = *(const u32x4*)(RPOS + t * 4); const f32x4 gv = *(const f32x4*)(RGATE + t * 4);
            const u32x4* src = (const u32x4*)(H8 + (size_t)t * RB); u32x4 vv[RB / 1024];
#pragma unroll
            for (int j = 0; j < RB / 1024; ++j) vv[j] = src[lane + 64 * j];
            const int sl[4] = {tab[32 + (int)ev.x] * 256 + (int)pv.x, tab[32 + (int)ev.y] * 256 + (int)pv.y, tab[32 + (int)ev.z] * 256 + (int)pv.z, tab[32 + (int)ev.w] * 256 + (int)pv.w};
#pragma unroll
            for (int k = 0; k < 4; ++k) { u32x4* dst = (u32x4*)(XS + (size_t)sl[k] * RB);
#pragma unroll
                for (int j = 0; j < RB / 1024; ++j) dst[lane + 64 * j] = vv[j]; }
            if (lane == 0) { ROWGATE[sl[0]] = gv[0]; ROWGATE[sl[1]] = gv[1]; ROWGATE[sl[2]] = gv[2]; ROWGATE[sl[3]] = gv[3]; *(u32x4*)(SLOT + t * 4) = (u32x4){(unsigned)sl[0], (unsigned)sl[1], (unsigned)sl[2], (unsigned)sl[3]}; } }
        for (int it = gw; it < 32 * 256; it += NGW) { const int e = it >> 8, r = it & 255, n = tab[96 + e];
            if (n + r < tab[e] * 256) { const int slot = tab[32 + e] * 256 + n + r; constexpr int RB = MOE_FP8 ? 2048 : 4096; u32x4* dst = (u32x4*)(XS + (size_t)slot * RB); const u32x4 z4 = {0u, 0u, 0u, 0u};
#pragma unroll
                for (int j = 0; j < RB / 1024; ++j) dst[lane + 64 * j] = z4;
                if (lane == 0) ROWGATE[slot] = 0.f; } }
        REP_END(9)
        if (BOTH(9)) GRID_BAR();
    }
    if (IN(10)) {
        REP_BEGIN(10)
        moe_tables(c, CNT, tab);
        constexpr unsigned RB = MOE_FP8 ? 2048u : 4096u;
        SchedMoe S{(const char*)XS, (const char*)WGU, tab, 16, c.G, (int)blockIdx.x, (size_t)4096 * RB, RB, MOE_FP8 ? 16 : 32}; EpiGu E{b_gate_up, ACT};
        pg8::gemm_phase<EpiGu, SchedMoe, MOE_FP8 != 0>(c.lds, RB, RB, S, E);
#if PROBE_GU
        __syncthreads(); pg8::gemm_phase<EpiGu, SchedMoe, MOE_FP8 != 0, PROBE_GU>(c.lds, RB, RB, S, E); __syncthreads();
#endif
        REP_END(10)
        if (BOTH(10)) GRID_BAR();
    }
    if (IN(11)) {
        REP_BEGIN(11)
        moe_tables(c, CNT, tab);
        constexpr unsigned RB = MOE_FP8 ? 2048u : 4096u;
        SchedMoe S{(const char*)ACT, (const char*)WDN, tab, 8, c.G, (int)blockIdx.x, (size_t)2048 * RB, RB, MOE_FP8 ? 16 : 32}; EpiDn E{b_down, ROWGATE, YB};
        pg8::gemm_phase<EpiDn, SchedMoe, MOE_FP8 != 0>(c.lds, RB, RB, S, E);
        REP_END(11)
        if (BOTH(11)) GRID_BAR();
    }
    if (IN(12)) {
        typedef float f32x2_t __attribute__((ext_vector_type(2)));
        u32x4 slq = (gw < NTOK) ? *(const u32x4*)(SLOT + gw * 4) : (u32x4){0u, 0u, 0u, 0u};
#pragma unroll 1
        for (int t = gw; t < NTOK; t += NGW) { const int b = t >> 14; const int s0 = (int)slq[0], s1 = (int)slq[1], s2 = (int)slq[2], s3 = (int)slq[3];
            if (t + NGW < NTOK) slq = *(const u32x4*)(SLOT + (t + NGW) * 4);
#pragma unroll
            for (int j = 0; j < 4; ++j) { const int col = 8 * lane + 512 * j;
                const u32x2 y0 = __builtin_nontemporal_load((const u32x2*)(YB + (size_t)s0 * 2048 + col)), y1 = __builtin_nontemporal_load((const u32x2*)(YB + (size_t)s1 * 2048 + col)), y2 = __builtin_nontemporal_load((const u32x2*)(YB + (size_t)s2 * 2048 + col)), y3 = __builtin_nontemporal_load((const u32x2*)(YB + (size_t)s3 * 2048 + col));
                const f32x4 g0 = *(const f32x4*)(MOD + b * 12288 + 10240 + col) * YB_INV, g1 = *(const f32x4*)(MOD + b * 12288 + 10240 + col + 4) * YB_INV;
                const u32x4 xw = *(const u32x4*)(X1B + (size_t)t * 2048 + col);
                f32x4 o0 = {bflo(xw.x), bfhi(xw.x), bflo(xw.y), bfhi(xw.y)}, o1 = {bflo(xw.z), bfhi(xw.z), bflo(xw.w), bfhi(xw.w)};
#define SUM4(W, HI) (((__builtin_amdgcn_cvt_pk_f32_fp8((int)y0.W, HI) + __builtin_amdgcn_cvt_pk_f32_fp8((int)y1.W, HI)) + __builtin_amdgcn_cvt_pk_f32_fp8((int)y2.W, HI)) + __builtin_amdgcn_cvt_pk_f32_fp8((int)y3.W, HI))
                const f32x2_t a0 = SUM4(x, false), a1 = SUM4(x, true), a2 = SUM4(y, false), a3 = SUM4(y, true);
#undef SUM4
                o0[0] += g0[0] * a0[0]; o0[1] += g0[1] * a0[1]; o0[2] += g0[2] * a1[0]; o0[3] += g0[3] * a1[1];
                o1[0] += g1[0] * a2[0]; o1[1] += g1[1] * a2[1]; o1[2] += g1[2] * a3[0]; o1[3] += g1[3] * a3[1];
                float* op = out + (size_t)t * 2048 + col; __builtin_nontemporal_store(o0, (f32x4*)op); __builtin_nontemporal_store(o1, (f32x4*)(op + 4)); } }
    }
#undef IN
#undef BOTH
#undef GRID_BAR
}

extern "C" void kernel_launch(void* const* d_in, const int* in_sizes, int n_in, void* d_out, int out_size, void* d_ws, size_t ws_size, hipStream_t stream) {
    static int grid = 0;
    if (grid == 0) {
        if (n_in != 33 || out_size != NTOK * DM || ws_size < WS_END) { fprintf(stderr, "kernel_launch: unexpected shapes (n_in %d out %d ws %zu, need ws >= %zu)\n", n_in, out_size, ws_size, (size_t)WS_END); grid = -1; return; }
        int dev = 0, cus = 0, per_cu = 0;
        if (hipGetDevice(&dev) != hipSuccess || hipDeviceGetAttribute(&cus, hipDeviceAttributeMultiprocessorCount, dev) != hipSuccess) { grid = -1; return; }
        if (hipFuncSetAttribute((const void*)mk_fwd, hipFuncAttributeMaxDynamicSharedMemorySize, LDS_BYTES) != hipSuccess) { fprintf(stderr, "kernel_launch: hipFuncSetAttribute failed\n"); grid = -1; return; }
        if (hipOccupancyMaxActiveBlocksPerMultiprocessor(&per_cu, (const void*)mk_fwd, 512, LDS_BYTES) != hipSuccess || per_cu < 1) fprintf(stderr, "kernel_launch: occupancy query reports %d\n", per_cu);
        (void)hipGetLastError();
        grid = cus;
    }
    if (grid < 0) return;
    (void)hipMemsetAsync((char*)d_ws + WS_CTL, 0, CTL_BYTES, stream);
    Args a{};
    for (int i = 0; i < 33; ++i) a.in[i] = d_in[i];
    a.out = (float*)d_out; a.ws = (unsigned char*)d_ws;
#if MK_N_LAUNCHES == 1
    a.ph_lo = 0; a.ph_hi = NPHASE;
    hipLaunchKernelGGL(mk_fwd, dim3(grid), dim3(512), LDS_BYTES, stream, a);
#else
    for (int k = 0; k < NPHASE; ++k) { a.ph_lo = k; a.ph_hi = k + 1; hipLaunchKernelGGL(mk_fwd, dim3(grid), dim3(512), LDS_BYTES, stream, a); }
#endif
    const hipError_t le = hipPeekAtLastError();
    if (le != hipSuccess) fprintf(stderr, "kernel_launch: launch failed: %s\n", hipGetErrorName(le));
}
```
